# Optimizing an MI355X kernel written in HIP

```python
import jax, jax.numpy as jnp
from jax import lax
import numpy as np

D_MODEL = 1024
BATCH = 16
SEQ = 4096
DEPTH = 1

D_MIX = D_MODEL
ATTN_WIDTH = D_MIX // 2
ATTN_HEAD_DIM = 64
ATTN_HEADS = ATTN_WIDTH // ATTN_HEAD_DIM
DILATED_PATTERNS = ((128, 1), (512, 4), (2048, 16))
ATTN_BLOCK = 128
GMLP_WIDTH = D_MIX - ATTN_WIDTH
GMLP_CHUNK = 128
GMLP_GROUP = 128
GMLP_GROUPS = GMLP_WIDTH // GMLP_GROUP
IN_WIDTH = 3 * ATTN_WIDTH + 2 * GMLP_WIDTH
PEER_HEADS = 8
PEER_TOPK = 16
N_KEYS = 128
N_EXPERTS = N_KEYS * N_KEYS
D_KEY = 256
PEER_TOKEN_BLOCK = 128
RMS_EPS = 1e-6
NEG = -1e30

kernel_name = "hymba_dilated_gmlp_peer_layer"


def rms_norm(x, g):
    xf = x.astype(jnp.float32)
    y = xf * lax.rsqrt(jnp.mean(xf * xf, axis=-1, keepdims=True) + RMS_EPS)
    return (y * g.astype(jnp.float32)).astype(x.dtype)


def dilated_window_attention(q, k, v, window, dilation):
    b, s, h, c = q.shape
    n_back = window // dilation
    L = s // dilation
    nb = -(-L // ATTN_BLOCK)
    Lp = nb * ATTN_BLOCK

    def to_residue(t):
        return t.reshape(b, L, dilation, h, c).transpose(0, 2, 1, 3, 4)

    qr, kr, vr = to_residue(q), to_residue(k), to_residue(v)
    qb = jnp.pad(qr, ((0, 0), (0, 0), (0, Lp - L), (0, 0), (0, 0))).reshape(b, dilation, nb, ATTN_BLOCK, h, c)

    def key_blocks(t):
        tp = jnp.pad(t, ((0, 0), (0, 0), (ATTN_BLOCK, Lp - L), (0, 0), (0, 0)))
        tp = tp.reshape(b, dilation, nb + 1, ATTN_BLOCK, h, c)
        return jnp.concatenate([tp[:, :, :-1], tp[:, :, 1:]], axis=3)

    kb, vb = key_blocks(kr), key_blocks(vr)
    scores = jnp.einsum('bdnqhc,bdnkhc->bdnhqk', qb, kb).astype(jnp.float32) * (c ** -0.5)
    qi = jnp.arange(ATTN_BLOCK)[:, None]
    kj = jnp.arange(2 * ATTN_BLOCK)[None, :]
    rel = qi + ATTN_BLOCK - kj
    key_pos = jnp.arange(nb)[:, None, None] * ATTN_BLOCK + kj[None] - ATTN_BLOCK
    mask = (rel >= 0) & (rel <= n_back) & (key_pos >= 0)
    scores = jnp.where(mask[:, None], scores, NEG)
    m = jnp.max(scores, axis=-1, keepdims=True)
    p = jnp.exp(scores - m)
    den = jnp.sum(p, axis=-1, keepdims=True)
    out = jnp.einsum('bdnhqk,bdnkhc->bdnqhc', (p / den).astype(v.dtype), vb)
    lse = (m + jnp.log(den))[..., 0]
    out = out.reshape(b, dilation, Lp, h, c)[:, :, :L].transpose(0, 2, 1, 3, 4).reshape(b, s, h, c)
    lse = lse.transpose(0, 1, 2, 4, 3).reshape(b, dilation, Lp, h)[:, :, :L]
    lse = lse.transpose(0, 2, 1, 3).reshape(b, s, h)
    return out, lse


def dilated_mixture_attention(q, k, v):
    outs, lses = [], []
    for window, dilation in DILATED_PATTERNS:
        o, l = dilated_window_attention(q, k, v, window, dilation)
        outs.append(o)
        lses.append(l)
    wts = jax.nn.softmax(jnp.stack(lses, axis=-1), axis=-1)
    return jnp.einsum('bshpc,bshp->bshc', jnp.stack(outs, axis=3), wts.astype(q.dtype))


def chunked_spatial_gating(u, v, v_norm_g, w_spatial, b_spatial):
    b, s, _ = u.shape
    u = jax.nn.gelu(u, approximate=False)
    v = jax.nn.gelu(v, approximate=False)
    v = v.reshape(b, s // GMLP_CHUNK, GMLP_CHUNK, GMLP_GROUPS, GMLP_GROUP)
    v = rms_norm(v, v_norm_g)
    causal = jnp.tril(jnp.ones((GMLP_CHUNK, GMLP_CHUNK), dtype=bool))
    w = jnp.where(causal, w_spatial, jnp.zeros_like(w_spatial)).astype(v.dtype)
    z = jnp.einsum('gij,bnjgc->bnigc', w, v) + b_spatial.T[:, :, None].astype(v.dtype)
    return u * z.reshape(b, s, GMLP_WIDTH)


def peer_ffn(xn, w_query, sub_keys_a, sub_keys_b, expert_u, expert_v):
    b, s, d = xn.shape
    tokens = xn.reshape(-1, PEER_TOKEN_BLOCK, d)
    half = D_KEY // 2

    def block(xb):
        qh = (xb @ w_query).reshape(-1, PEER_HEADS, D_KEY)
        sa = jnp.einsum('thc,kc->thk', qh[..., :half], sub_keys_a).astype(jnp.float32)
        sb = jnp.einsum('thc,kc->thk', qh[..., half:], sub_keys_b).astype(jnp.float32)
        va, ia = lax.top_k(sa, PEER_TOPK)
        vb, ib = lax.top_k(sb, PEER_TOPK)
        cand = (va[..., :, None] + vb[..., None, :]).reshape(-1, PEER_HEADS, PEER_TOPK * PEER_TOPK)
        cand_idx = (ia[..., :, None] * N_KEYS + ib[..., None, :]).reshape(-1, PEER_HEADS, PEER_TOPK * PEER_TOPK)
        top_s, pos = lax.top_k(cand, PEER_TOPK)
        idx = jnp.take_along_axis(cand_idx, pos, axis=-1)
        gate = jax.nn.softmax(top_s, axis=-1)
        u = expert_u[idx]
        act = jax.nn.gelu(jnp.einsum('thkd,td->thk', u, xb), approximate=False)
        coef = (gate * act.astype(jnp.float32)).astype(xb.dtype)
        return jnp.einsum('thk,thkd->td', coef, expert_v[idx])

    return lax.map(block, tokens).reshape(b, s, d)


def setup_inputs(seed: int = 0) -> dict:
    key = jax.random.key(seed)
    ks = jax.random.split(key, 17)

    def nrm(k, shape, scale):
        return jax.random.normal(k, shape, jnp.float32) * scale

    def gain(k, shape):
        return 1.0 + 0.01 * jax.random.normal(k, shape, jnp.float32)

    return {
        "x": nrm(ks[0], (BATCH, SEQ, D_MODEL), 1.0),
        "mix_norm_g": gain(ks[1], (DEPTH, D_MODEL)),
        "w_in": nrm(ks[2], (DEPTH, D_MODEL, IN_WIDTH), D_MODEL ** -0.5),
        "q_norm_g": gain(ks[3], (DEPTH, ATTN_HEAD_DIM)),
        "k_norm_g": gain(ks[4], (DEPTH, ATTN_HEAD_DIM)),
        "v_gate_norm_g": gain(ks[5], (DEPTH, GMLP_GROUPS, GMLP_GROUP)),
        "w_spatial": nrm(ks[6], (DEPTH, GMLP_GROUPS, GMLP_CHUNK, GMLP_CHUNK), GMLP_CHUNK ** -0.5),
        "b_spatial": 1.0 + nrm(ks[7], (DEPTH, GMLP_GROUPS, GMLP_CHUNK), 0.1),
        "attn_out_g": gain(ks[8], (DEPTH, ATTN_WIDTH)),
        "gate_out_g": gain(ks[9], (DEPTH, GMLP_WIDTH)),
        "w_out": nrm(ks[10], (DEPTH, D_MIX, D_MODEL), D_MIX ** -0.5),
        "ffn_norm_g": gain(ks[11], (DEPTH, D_MODEL)),
        "w_query": nrm(ks[12], (DEPTH, D_MODEL, PEER_HEADS * D_KEY), D_MODEL ** -0.5),
        "sub_keys_a": nrm(ks[13], (DEPTH, N_KEYS, D_KEY // 2), (D_KEY // 2) ** -0.5),
        "sub_keys_b": nrm(ks[14], (DEPTH, N_KEYS, D_KEY // 2), (D_KEY // 2) ** -0.5),
        "expert_u": nrm(ks[15], (DEPTH, N_EXPERTS, D_MODEL), D_MODEL ** -0.5),
        "expert_v": nrm(ks[16], (DEPTH, N_EXPERTS, D_MODEL), PEER_HEADS ** -0.5),
    }


def reference(x, mix_norm_g, w_in, q_norm_g, k_norm_g, v_gate_norm_g, w_spatial, b_spatial,
              attn_out_g, gate_out_g, w_out, ffn_norm_g, w_query, sub_keys_a, sub_keys_b,
              expert_u, expert_v):
    b, s, _ = x.shape
    splits = [ATTN_WIDTH, 2 * ATTN_WIDTH, 3 * ATTN_WIDTH, 3 * ATTN_WIDTH + GMLP_WIDTH]
    for l in range(DEPTH):
        hn = rms_norm(x, mix_norm_g[l])
        proj = hn @ w_in[l]
        q, k, v, gu, gv = jnp.split(proj, splits, axis=-1)
        q = rms_norm(q.reshape(b, s, ATTN_HEADS, ATTN_HEAD_DIM), q_norm_g[l])
        k = rms_norm(k.reshape(b, s, ATTN_HEADS, ATTN_HEAD_DIM), k_norm_g[l])
        v = v.reshape(b, s, ATTN_HEADS, ATTN_HEAD_DIM)
        attn = dilated_mixture_attention(q, k, v).reshape(b, s, ATTN_WIDTH)
        gated = chunked_spatial_gating(gu, gv, v_gate_norm_g[l], w_spatial[l], b_spatial[l])
        merged = jnp.concatenate([rms_norm(attn, attn_out_g[l]), rms_norm(gated, gate_out_g[l])], axis=-1)
        x = x + merged @ w_out[l]
        x = x + peer_ffn(rms_norm(x, ffn_norm_g[l]), w_query[l], sub_keys_a[l], sub_keys_b[l],
                         expert_u[l], expert_v[l])
    return x
```

```cpp
#include <hip/hip_runtime.h>
#include <cstdio>
#include <cstdint>
#include <cmath>
namespace pg8 {
#define PG8_LAS __attribute__((address_space(3)))
typedef unsigned short bf16_t;
typedef short bf16x8 __attribute__((ext_vector_type(8)));
typedef float f32x4 __attribute__((ext_vector_type(4)));
typedef unsigned u32x4 __attribute__((ext_vector_type(4)));
constexpr int BM = 256, BK = 64, HALF = 128, HTB = HALF * BK * 2  , STAGE_BYTES = 8 * HTB, NXCD = 8, WGM = 8;

__host__ __device__ __forceinline__ int lds_byte(int r, int c) { const int st = (r >> 4) * 2 + (c >> 5), rr = r & 15, cc = c & 31, ob = rr * 64 + cc * 2; return st * 1024 + (ob ^ (((ob >> 9) & 1) << 5)); }
__host__ __device__ __forceinline__ void stage_rc(int b, int& R, int& C) { const int st = b / 1024, sb = b % 1024, swz = sb ^ (((sb >> 9) & 1) << 5); R = (st >> 1) * 16 + swz / 64; C = (st & 1) * 32 + (swz % 64) / 2; }
__host__ __device__ __forceinline__ int perm32(int rho) { const int n = rho >> 4, i = rho & 15; return 8 * (i >> 2) + 4 * n + (i & 3); }

struct Unit { int pm, pn; };
struct Gemm { const bf16_t* A; const bf16_t* Bt; int M, N, K; };

struct StaticOrder {
    int nM, nN, nwg, G, c;
    __host__ __device__ void init(int M, int N, int G_, int c_) { nM = M / BM; nN = N / BM; nwg = nM * nN; G = G_; c = c_; }
    __host__ __device__ bool next(int i, Unit& u) const {
        const long L = (long)i * G + c; if (L >= nwg) return false;
        int wgid = (int)L; { const int q = nwg / NXCD, r = nwg % NXCD, xcd = wgid % NXCD, off = wgid / NXCD; wgid = (xcd < r ? xcd * (q + 1) : r * (q + 1) + (xcd - r) * q) + off; }
        const int nig = WGM * nN, gid = wgid / nig, fm = gid * WGM, gsz = (nM - fm) < WGM ? (nM - fm) : WGM;
        u.pm = fm + ((wgid % nig) % gsz); u.pn = (wgid % nig) / gsz; return true;
    }
    __device__ __forceinline__ void a_ready(const Unit&) const {}
    __device__ __forceinline__ void done(const Unit&) const {}
};

__device__ __forceinline__ unsigned cvt_pk_bf16(float lo, float hi) { unsigned r; asm volatile("v_cvt_pk_bf16_f32 %0, %1, %2" : "=v"(r) : "v"(lo), "v"(hi)); return r; }
typedef float f32x2 __attribute__((ext_vector_type(2)));
__device__ __forceinline__ f32x2 gelu_pk(f32x2 v) {
    const f32x2 av = __builtin_elementwise_abs(v), d = av * 0.2316418882f + 1.0f;
    f32x2 t; t.x = __builtin_amdgcn_rcpf(d.x); t.y = __builtin_amdgcn_rcpf(d.y);
    f32x2 q = t * 0.5307027145f + (-0.7265760135f); q = q * t + 0.7107068705f; q = q * t + (-0.142248368f); q = q * t + 0.127414796f; q = q * t;
    const f32x2 s = (v * v) * (-0.72134752044f);
    f32x2 e; e.x = __builtin_amdgcn_exp2f(s.x); e.y = __builtin_amdgcn_exp2f(s.y);
    const f32x2 m = v * (q * e), r = v - m;
    f32x2 o; o.x = v.x < 0.f ? m.x : r.x; o.y = v.y < 0.f ? m.y : r.y; return o;
}

template <class Epi, class Sched, bool ALIGN_EPI = false, bool SP2 = false>
__device__ __forceinline__ void gemm_phase(PG8_LAS unsigned char* lds, const Gemm g, const Sched& S, const Epi& E) {
    const int tid = threadIdx.x, wid = __builtin_amdgcn_readfirstlane(tid >> 6), lane = tid & 63, wr = wid >> 2, wc = wid & 3, fr = lane & 15, fq = lane >> 4;
    const int K = g.K, nt = K / BK;
    unsigned voffA[2], voffB[2];
#pragma unroll
    for (int i = 0; i < 2; ++i) { int R, C; stage_rc(tid * 16 + i * 8192, R, C); const int Rb = Epi::PERM ? ((R & ~31) + perm32(R & 31)) : R;
        voffA[i] = (unsigned)(R * K + C) * 2u; voffB[i] = (unsigned)(Rb * K + C) * 2u; }
    const size_t kstep = (size_t)(BK * 2);
    const size_t hstep = (size_t)HALF * K * 2;
    const size_t tstep = 2 * hstep;
    const unsigned ldsw = (unsigned)wid * 1024u;
    const int aoff = lds_byte(wr * 64 + fr, fq * 8), boff = lds_byte(wc * 32 + fr, fq * 8);
#define PG8_SA(b, h) (((b) * 2 + (h)) * HTB)
#define PG8_SB(b, h) ((4 + (b) * 2 + (h)) * HTB)
#define PG8_STAGE(bufoff, gbase, voff) do { _Pragma("unroll") for (int _i = 0; _i < 2; ++_i) \
        __builtin_amdgcn_global_load_lds((const unsigned*)((const char*)(gbase) + (voff)[_i]), (PG8_LAS unsigned*)(lds + (bufoff) + ldsw + _i * 8192), 16, 0, 0); } while (0)
#define PG8_LDA(dst, b, h) do { _Pragma("unroll") for (int m = 0; m < 4; ++m) _Pragma("unroll") for (int k = 0; k < 2; ++k) dst[m][k] = *(const PG8_LAS bf16x8*)(lds + PG8_SA(b, h) + aoff + m * 2048 + k * 1024); } while (0)
#define PG8_LDB(dst, b, h) do { _Pragma("unroll") for (int n = 0; n < 2; ++n) _Pragma("unroll") for (int k = 0; k < 2; ++k) dst[n][k] = *(const PG8_LAS bf16x8*)(lds + PG8_SB(b, h) + boff + n * 2048 + k * 1024); } while (0)
#define PG8_MMA(ai, bj, At, Bt) do { __builtin_amdgcn_s_setprio(1); _Pragma("unroll") for (int m = 0; m < 4; ++m) _Pragma("unroll") for (int n = 0; n < 2; ++n) _Pragma("unroll") for (int k = 0; k < 2; ++k) \
        acc[ai][bj][m][n] = __builtin_amdgcn_mfma_f32_16x16x32_bf16(Bt[n][k], At[m][k], acc[ai][bj][m][n], 0, 0, 0); __builtin_amdgcn_s_setprio(0); } while (0)
#define PG8_WAIT_V(n) asm volatile("s_waitcnt vmcnt(" #n ")" ::: "memory")
#define PG8_WAIT_L(n) asm volatile("s_waitcnt lgkmcnt(" #n ")" ::: "memory")
#define PG8_BAR __builtin_amdgcn_s_barrier()
#define PG8_SCHED __builtin_amdgcn_sched_barrier(0)
    Unit cur, nxt; int ui = 0;
    if (!S.next(0, cur)) return;
    f32x4 acc[2][2][4][2];
#pragma unroll
    for (int a = 0; a < 2; ++a)
#pragma unroll
        for (int b = 0; b < 2; ++b)
#pragma unroll
            for (int m = 0; m < 4; ++m)
#pragma unroll
                for (int n = 0; n < 2; ++n) acc[a][b][m][n] = (f32x4){0.f, 0.f, 0.f, 0.f};
    bf16x8 At[4][2], B0[2][2], B1[2][2];
    const char* cA = (const char*)g.A + (size_t)cur.pm * tstep; const char* cB = (const char*)g.Bt + (size_t)cur.pn * tstep;
    S.a_ready(cur);
    if constexpr (SP2) {
        PG8_STAGE(PG8_SB(0, 0), cB, voffB); PG8_STAGE(PG8_SB(0, 1), cB + hstep, voffB); PG8_STAGE(PG8_SA(0, 0), cA, voffA); PG8_STAGE(PG8_SA(0, 1), cA + hstep, voffA);
        if (wr == 1) PG8_BAR;
        PG8_WAIT_V(2); PG8_BAR;
        PG8_STAGE(PG8_SB(1, 0), cB + kstep, voffB); PG8_STAGE(PG8_SA(1, 0), cA + kstep, voffA); PG8_STAGE(PG8_SB(1, 1), cB + hstep + kstep, voffB);
        PG8_WAIT_V(6); PG8_BAR;
    } else {
        PG8_STAGE(PG8_SB(0, 0), cB, voffB); PG8_STAGE(PG8_SA(0, 0), cA, voffA); PG8_STAGE(PG8_SB(0, 1), cB + hstep, voffB); PG8_STAGE(PG8_SA(0, 1), cA + hstep, voffA);
        if (wr == 1) PG8_BAR;
        PG8_WAIT_V(4); PG8_BAR;
        PG8_STAGE(PG8_SB(1, 0), cB + kstep, voffB); PG8_STAGE(PG8_SA(1, 0), cA + kstep, voffA); PG8_STAGE(PG8_SB(1, 1), cB + hstep + kstep, voffB);
        PG8_WAIT_V(6); PG8_BAR;
    }
    for (;;) {
        const bool has_next = S.next(ui + 1, nxt);
        const char* nA = has_next ? (const char*)g.A + (size_t)nxt.pm * tstep : cA; const char* nB = has_next ? (const char*)g.Bt + (size_t)nxt.pn * tstep : cB;
        for (int t = 0; t < nt; t += 2) {
            const bool last = (t == nt - 2);
            const char* a1 = cA + (size_t)(t + 1) * kstep;
            const char* a2 = last ? nA : cA + (size_t)(t + 2) * kstep; const char* b2 = last ? nB : cB + (size_t)(t + 2) * kstep;
            const char* a3 = a2 + kstep; const char* b3 = b2 + kstep;
            if (last && has_next) S.a_ready(nxt);
            if constexpr (SP2) {
            PG8_LDB(B0, 0, 0); PG8_LDB(B1, 0, 1); PG8_SCHED; PG8_LDA(At, 0, 0); PG8_STAGE(PG8_SA(1, 1), a1 + hstep, voffA);
            PG8_WAIT_V(8); PG8_WAIT_L(0); PG8_BAR; PG8_MMA(0, 0, At, B0); PG8_MMA(0, 1, At, B1); PG8_BAR; PG8_SCHED;
            PG8_LDA(At, 0, 1); PG8_STAGE(PG8_SB(0, 0), b2, voffB); PG8_STAGE(PG8_SB(0, 1), b2 + hstep, voffB); PG8_STAGE(PG8_SA(0, 0), a2, voffA);
            PG8_WAIT_V(8); PG8_WAIT_L(0); PG8_BAR; PG8_MMA(1, 0, At, B0); PG8_MMA(1, 1, At, B1); PG8_BAR; PG8_SCHED;
            PG8_LDB(B0, 1, 0); PG8_LDB(B1, 1, 1); PG8_SCHED; PG8_LDA(At, 1, 0); PG8_STAGE(PG8_SA(0, 1), a2 + hstep, voffA);
            PG8_WAIT_V(8); PG8_WAIT_L(0); PG8_BAR; PG8_MMA(0, 0, At, B0); PG8_MMA(0, 1, At, B1); PG8_BAR; PG8_SCHED;
            PG8_LDA(At, 1, 1); PG8_STAGE(PG8_SB(1, 0), b3, voffB); PG8_STAGE(PG8_SB(1, 1), b3 + hstep, voffB); PG8_STAGE(PG8_SA(1, 0), a3, voffA);
            PG8_WAIT_V(8); PG8_WAIT_L(0); PG8_BAR; PG8_MMA(1, 0, At, B0); PG8_MMA(1, 1, At, B1); PG8_BAR; PG8_SCHED;
            } else {
            PG8_LDB(B0, 0, 0); PG8_SCHED; PG8_LDA(At, 0, 0); PG8_STAGE(PG8_SA(1, 1), a1 + hstep, voffA);
            PG8_WAIT_L(8); PG8_BAR; PG8_WAIT_L(0); PG8_MMA(0, 0, At, B0); PG8_BAR; PG8_SCHED;
            PG8_LDB(B1, 0, 1); PG8_STAGE(PG8_SB(0, 0), b2, voffB);
            PG8_BAR; PG8_WAIT_L(0); PG8_MMA(0, 1, At, B1); PG8_BAR;
            PG8_LDA(At, 0, 1); PG8_STAGE(PG8_SA(0, 0), a2, voffA);
            PG8_BAR; PG8_WAIT_L(0); PG8_MMA(1, 0, At, B0); PG8_BAR; PG8_SCHED;
            PG8_STAGE(PG8_SB(0, 1), b2 + hstep, voffB);
            PG8_WAIT_V(6); PG8_BAR; PG8_MMA(1, 1, At, B1); PG8_BAR;
            PG8_LDB(B0, 1, 0); PG8_SCHED; PG8_LDA(At, 1, 0); PG8_STAGE(PG8_SA(0, 1), a2 + hstep, voffA);
            PG8_WAIT_L(8); PG8_BAR; PG8_WAIT_L(0); PG8_MMA(0, 0, At, B0); PG8_BAR; PG8_SCHED;
            PG8_LDB(B1, 1, 1); PG8_STAGE(PG8_SB(1, 0), b3, voffB);
            PG8_BAR; PG8_WAIT_L(0); PG8_MMA(0, 1, At, B1); PG8_BAR;
            PG8_LDA(At, 1, 1); PG8_STAGE(PG8_SA(1, 0), a3, voffA);
            PG8_BAR; PG8_WAIT_L(0); PG8_MMA(1, 0, At, B0); PG8_BAR; PG8_SCHED;
            PG8_STAGE(PG8_SB(1, 1), b3 + hstep, voffB);
            PG8_WAIT_V(6); PG8_BAR; PG8_MMA(1, 1, At, B1); PG8_BAR;
            }
        }
        if constexpr (ALIGN_EPI) { if (wr == 0) PG8_BAR; }
        if constexpr (!Epi::AFTER_DRAIN) { E(acc, cur, wr, wc, fr, fq); S.done(cur); }
        if (!has_next) break;
#pragma unroll
        for (int a = 0; a < 2; ++a)
#pragma unroll
            for (int b = 0; b < 2; ++b)
#pragma unroll
                for (int m = 0; m < 4; ++m)
#pragma unroll
                    for (int n = 0; n < 2; ++n) acc[a][b][m][n] = (f32x4){0.f, 0.f, 0.f, 0.f};
        cur = nxt; cA = nA; cB = nB; ++ui;
        if constexpr (ALIGN_EPI) { if (wr == 1) PG8_BAR; }
    }
    PG8_WAIT_V(0);
    if constexpr (!ALIGN_EPI) { if (wr == 0) PG8_BAR; }
    PG8_BAR;
    if constexpr (Epi::AFTER_DRAIN) { E.fused(acc, cur, wr, wc, fr, fq, lds, wid, lane); S.done(cur); }
#undef PG8_SA
#undef PG8_SB
#undef PG8_STAGE
#undef PG8_LDA
#undef PG8_LDB
#undef PG8_MMA
#undef PG8_WAIT_V
#undef PG8_WAIT_L
#undef PG8_BAR
#undef PG8_SCHED
}
}

constexpr int BATCH = 16, SEQ = 4096, D = 1024, T = BATCH * SEQ;
constexpr int AW = 512, NH = 8, HD = 64, GWID = 512, INW = 2560;
constexpr int NKEYS = 128, NEXP = 16384, PH = 8, TOPK = 16, NSEL = PH * TOPK;
constexpr float EPS = 1e-6f;
constexpr float QSCALE = 0.125f * 1.4426950408889634f;
constexpr int NWAVES = 8, NTHR = 512;

constexpr size_t MiB = 1u << 20;
constexpr size_t WS_CTL = 0, CTL_ZERO_BYTES = 1 * MiB;
constexpr size_t WS_WIN = 2 * MiB;
constexpr size_t WS_WOUT = 8 * MiB;
constexpr size_t WS_WQK = 10 * MiB;
constexpr size_t WS_WSP = 14 * MiB;
constexpr size_t WS_PART = 15 * MiB;
constexpr size_t WS_EU = 20 * MiB;
constexpr size_t WS_EV = 52 * MiB;
constexpr size_t WS_HN = 84 * MiB;
constexpr size_t WS_X1B = 212 * MiB;
constexpr size_t WS_Q = 340 * MiB, WS_K = 404 * MiB, WS_V = 468 * MiB, WS_GU = 532 * MiB, WS_GV = 596 * MiB;
constexpr size_t WS_PO = 660 * MiB;
constexpr size_t WS_LSE = 852 * MiB;
constexpr size_t WS_SC = 340 * MiB;
constexpr size_t WS_IDX = 860 * MiB;
constexpr size_t WS_GATE = 892 * MiB;
constexpr size_t WS_END = 924 * MiB;
constexpr int CW_BAR = 4096;

constexpr int LDS_BYTES = 163840 - 2048;
constexpr int MISC_OFF = 160 * 1024 - 2048 - 256;

#define GAS __attribute__((address_space(1)))
#define LAS __attribute__((address_space(3)))
typedef unsigned short bf16;
typedef unsigned v4u __attribute__((ext_vector_type(4)));
typedef unsigned v2u __attribute__((ext_vector_type(2)));
typedef float f32x4 __attribute__((ext_vector_type(4)));
typedef float f32x16 __attribute__((ext_vector_type(16)));
typedef short bf16x8 __attribute__((ext_vector_type(8)));
typedef short s16x4 __attribute__((ext_vector_type(4)));
typedef short v4i16_t __attribute__((ext_vector_type(4)));
typedef __bf16 bf16x2_t __attribute__((ext_vector_type(2)));

__device__ __forceinline__ unsigned f2bf(float f) { unsigned u = __builtin_bit_cast(unsigned, f); return (u + 0x7fffu + ((u >> 16) & 1u)) >> 16; }
__device__ __forceinline__ unsigned pk2(float lo, float hi) { return f2bf(lo) | (f2bf(hi) << 16); }
__device__ __forceinline__ float bflo(unsigned u) { return __uint_as_float(u << 16); }
__device__ __forceinline__ float bfhi(unsigned u) { return __uint_as_float(u & 0xffff0000u); }
__device__ __forceinline__ float wave_sum(float v) {
#pragma unroll
    for (int o = 1; o < 64; o <<= 1) v += __shfl_xor(v, o);
    return v;
}
__device__ __forceinline__ int crow(int r, int hi) { return (r & 3) + 8 * (r >> 2) + 4 * hi; }
__device__ __forceinline__ float gelu_exact(float v) { return 0.5f * v * (1.0f + erff(v * 0.70710678118654752f)); }

struct Ptrs {
    const float *x, *mix_g, *w_in, *q_g, *k_g, *vg_g, *w_sp, *b_sp, *ao_g, *go_g, *w_out, *ffn_g, *w_query, *keys_a, *keys_b, *exp_u, *exp_v;
    float* out; unsigned char* ws;
};
struct Args { Ptrs p; int ph_lo, ph_hi; };

__device__ __forceinline__ void p0_transpose_item(const float* W, int K, int N, bf16* WT, bool perm, LAS float* scr, int item, int lane) {
    const int nblk = N / 32, kb = item / nblk, nb = item % nblk, k0 = 64 * kb, n0 = 32 * nb;
    int pn0 = n0;
    if (perm) { const int tile = n0 >> 8, lb = (n0 & 255) >> 5; pn0 = (tile << 8) + 32 * (4 * (lb & 1) + (lb >> 1)); }
#pragma unroll 8
    for (int i = 0; i < 32; ++i) { const int kk = 2 * i + (lane >> 5); scr[kk * 33 + (lane & 31)] = W[(size_t)(k0 + kk) * N + n0 + (lane & 31)]; }
    asm volatile("s_waitcnt lgkmcnt(0)" ::: "memory");
    const int c = lane & 7;
#pragma unroll
    for (int j = 0; j < 4; ++j) { const int n = (lane >> 3) + 8 * j; const LAS float* s = scr + (8 * c) * 33 + n;
        v4u o; o.x = pk2(s[0 * 33], s[1 * 33]); o.y = pk2(s[2 * 33], s[3 * 33]); o.z = pk2(s[4 * 33], s[5 * 33]); o.w = pk2(s[6 * 33], s[7 * 33]);
        *(v4u*)(WT + (size_t)(pn0 + n) * K + k0 + 8 * c) = o; }
    asm volatile("s_waitcnt lgkmcnt(0)" ::: "memory");
}

__device__ __forceinline__ void p0_fold_item(const Ptrs& p, LAS unsigned char* lds, int it, int tid) {
    const int h = it >> 5, half = (it >> 4) & 1, d0 = (it & 15) * 64;
    LAS float* A = (LAS float*)lds;
    LAS float* Kt = (LAS float*)(lds + 33280);
    const float* wq = p.w_query + h * 256 + half * 128;
    for (int i = tid; i < 8192; i += NTHR) { const int dd = i >> 7, c = i & 127; A[dd * 129 + c] = wq[(size_t)(d0 + dd) * 2048 + c]; }
    const float* keys = half ? p.keys_b : p.keys_a;
    for (int i = tid; i < 16384; i += NTHR) Kt[i] = keys[i];
    __syncthreads();
    const int dd = tid & 63, kg = tid >> 6;
    float acc[16];
#pragma unroll
    for (int kk = 0; kk < 16; ++kk) acc[kk] = 0.f;
    for (int c = 0; c < 128; ++c) { const float a = A[dd * 129 + c];
#pragma unroll
        for (int kk = 0; kk < 16; ++kk) acc[kk] += a * Kt[(kg * 16 + kk) * 128 + c]; }
    const float g = p.ffn_g[d0 + dd];
    bf16* WQK = (bf16*)(p.ws + WS_WQK);
#pragma unroll
    for (int kk = 0; kk < 16; ++kk) WQK[(size_t)(h * 256 + half * 128 + kg * 16 + kk) * 1024 + d0 + dd] = (bf16)f2bf(acc[kk] * g);
    __syncthreads();
}

__device__ __forceinline__ void p0_prologue(const Ptrs& p, LAS unsigned char* lds, int tid, int lane, int wave, int vcu, int G) {
    for (int it = blockIdx.x; it < 256; it += G) p0_fold_item(p, lds, it, tid);
    __syncthreads();
    const int gw = vcu * NWAVES + wave, NGW = G * NWAVES;
    LAS float* scr = (LAS float*)(lds + wave * 16384);
    constexpr int I_IN = (D / 64) * (INW / 32), I_OUT = (D / 64) * (D / 32);
    bf16* WIN = (bf16*)(p.ws + WS_WIN); bf16* WOUT = (bf16*)(p.ws + WS_WOUT);
    for (int it = gw; it < I_IN + I_OUT; it += NGW) {
        if (it < I_IN) p0_transpose_item(p.w_in, D, INW, WIN, true, scr, it, lane);
        else p0_transpose_item(p.w_out, D, D, WOUT, false, scr, it - I_IN, lane);
    }
    const int gt = gw * 64 + lane, NGT = NGW * 64;
    v4u* EU = (v4u*)(p.ws + WS_EU); v4u* EV = (v4u*)(p.ws + WS_EV);
    for (int i = gt; i < NEXP * D / 8; i += NGT) {
        const int d = (i & 127) * 8;
        const f32x4 a = *(const f32x4*)(p.exp_u + (size_t)i * 8), b = *(const f32x4*)(p.exp_u + (size_t)i * 8 + 4);
        const f32x4 g0 = *(const f32x4*)(p.ffn_g + d), g1 = *(const f32x4*)(p.ffn_g + d + 4);
        v4u o; o.x = pk2(a.x * g0.x, a.y * g0.y); o.y = pk2(a.z * g0.z, a.w * g0.w); o.z = pk2(b.x * g1.x, b.y * g1.y); o.w = pk2(b.z * g1.z, b.w * g1.w);
        EU[i] = o;
        const f32x4 c = *(const f32x4*)(p.exp_v + (size_t)i * 8), e = *(const f32x4*)(p.exp_v + (size_t)i * 8 + 4);
        v4u q; q.x = pk2(c.x, c.y); q.y = pk2(c.z, c.w); q.z = pk2(e.x, e.y); q.w = pk2(e.z, e.w);
        EV[i] = q;
    }
    bf16* WSP = (bf16*)(p.ws + WS_WSP);
    for (int i = gt; i < 4 * 128 * 128; i += NGT) {
        const int pj = i & 127, ii = (i >> 7) & 127, g = i >> 14;
        const int ks = pj >> 4, hi = (pj >> 3) & 1, jj = pj & 7, j = 16 * ks + 4 * hi + (jj & 3) + 8 * (jj >> 2);
        WSP[i] = (bf16)((j <= ii) ? f2bf(p.w_sp[(g * 128 + ii) * 128 + j]) : 0u);
    }
    bf16* HN = (bf16*)(p.ws + WS_HN);
    for (int m = gw; m < T; m += NGW) {
        const f32x4* xr = (const f32x4*)(p.x + (size_t)m * D) + lane;
        f32x4 v[4]; float s = 0.f;
#pragma unroll
        for (int j = 0; j < 4; ++j) { v[j] = xr[64 * j]; s += (v[j].x * v[j].x + v[j].y * v[j].y) + (v[j].z * v[j].z + v[j].w * v[j].w); }
        const float r = rsqrtf(wave_sum(s) * (1.f / D) + EPS);
        v2u* o8 = (v2u*)(HN + (size_t)m * D) + lane;
#pragma unroll
        for (int j = 0; j < 4; ++j) { const f32x4 g = *((const f32x4*)p.mix_g + lane + 64 * j); v2u o; o.x = pk2(v[j].x * r * g.x, v[j].y * r * g.y); o.y = pk2(v[j].z * r * g.z, v[j].w * r * g.w); o8[64 * j] = o; }
    }
}

struct EpiProj {
    static constexpr bool PERM = true, AFTER_DRAIN = false;
    bf16 *Q, *K, *V, *GU, *GV; const float *qg, *kg;
    __device__ __forceinline__ void operator()(const pg8::f32x4 (&acc)[2][2][4][2], const pg8::Unit& u, int wr, int wc, int fr, int fq) const {
        const int type = u.pn >> 1;
        bf16* base = type == 0 ? Q : type == 1 ? K : type == 2 ? V : type == 3 ? GU : GV;
        const int ct = (u.pn & 1) * 256 + wc * 64 + 8 * fq;
        const int row0 = u.pm * 256 + wr * 64 + fr;
        if (type <= 1) {
            const float* g = type == 0 ? qg : kg; const float sc = type == 0 ? QSCALE : 1.f;
            f32x4 gv[2][2];
#pragma unroll
            for (int bj = 0; bj < 2; ++bj)
#pragma unroll
                for (int n = 0; n < 2; ++n) gv[bj][n] = *(const f32x4*)(g + 32 * bj + 8 * fq + 4 * n);
#pragma unroll
            for (int ai = 0; ai < 2; ++ai)
#pragma unroll
                for (int m = 0; m < 4; ++m) {
                    float ss = 0.f;
#pragma unroll
                    for (int bj = 0; bj < 2; ++bj)
#pragma unroll
                        for (int n = 0; n < 2; ++n) { const f32x4 v = acc[ai][bj][m][n]; ss += (v[0] * v[0] + v[1] * v[1]) + (v[2] * v[2] + v[3] * v[3]); }
                    ss += __shfl_xor(ss, 16); ss += __shfl_xor(ss, 32);
                    const float r = rsqrtf(ss * (1.f / 64.f) + EPS) * sc;
                    bf16* rowp = base + (size_t)(row0 + ai * 128 + m * 16) * 512 + ct;
#pragma unroll
                    for (int bj = 0; bj < 2; ++bj) { const f32x4 v0 = acc[ai][bj][m][0] * gv[bj][0] * r, v1 = acc[ai][bj][m][1] * gv[bj][1] * r;
                        v4u w; w.x = pk2(v0[0], v0[1]); w.y = pk2(v0[2], v0[3]); w.z = pk2(v1[0], v1[1]); w.w = pk2(v1[2], v1[3]);
                        *(v4u*)(rowp + 32 * bj) = w; }
                }
        } else {
#pragma unroll
            for (int ai = 0; ai < 2; ++ai)
#pragma unroll
                for (int m = 0; m < 4; ++m) {
                    bf16* rowp = base + (size_t)(row0 + ai * 128 + m * 16) * 512 + ct;
#pragma unroll
                    for (int bj = 0; bj < 2; ++bj) { f32x4 v0 = acc[ai][bj][m][0], v1 = acc[ai][bj][m][1];
                        if (type >= 3) { pg8::f32x2 a = pg8::gelu_pk((pg8::f32x2){v0[0], v0[1]}), b = pg8::gelu_pk((pg8::f32x2){v0[2], v0[3]}), c = pg8::gelu_pk((pg8::f32x2){v1[0], v1[1]}), d = pg8::gelu_pk((pg8::f32x2){v1[2], v1[3]});
                            v0 = (f32x4){a.x, a.y, b.x, b.y}; v1 = (f32x4){c.x, c.y, d.x, d.y}; }
                        v4u w; w.x = pk2(v0[0], v0[1]); w.y = pk2(v0[2], v0[3]); w.z = pk2(v1[0], v1[1]); w.w = pk2(v1[2], v1[3]);
                        *(v4u*)(rowp + 32 * bj) = w; }
                }
        }
    }
};
struct EpiOut {
    static constexpr bool PERM = false, AFTER_DRAIN = false;
    const float* X; float* OUT; bf16* X1B; float* PART;
    __device__ __forceinline__ void operator()(const pg8::f32x4 (&acc)[2][2][4][2], const pg8::Unit& u, int wr, int wc, int fr, int fq) const {
        const int row0 = u.pm * 256 + wr * 64 + fr, col0 = u.pn * 256 + wc * 32 + 4 * fq;
#pragma unroll
        for (int ai = 0; ai < 2; ++ai)
#pragma unroll
            for (int m = 0; m < 4; ++m) {
                const int row = row0 + ai * 128 + m * 16; float ss = 0.f;
#pragma unroll
                for (int bj = 0; bj < 2; ++bj)
#pragma unroll
                    for (int n = 0; n < 2; ++n) { const size_t off = (size_t)row * D + col0 + bj * 128 + n * 16;
                        const f32x4 o = *(const f32x4*)(X + off) + acc[ai][bj][m][n];
                        *(f32x4*)(OUT + off) = o; ss += (o[0] * o[0] + o[1] * o[1]) + (o[2] * o[2] + o[3] * o[3]);
                        v2u w; w.x = pk2(o[0], o[1]); w.y = pk2(o[2], o[3]); *(v2u*)(X1B + off) = w; }
                ss += __shfl_xor(ss, 16); ss += __shfl_xor(ss, 32);
                if (fq == 0) PART[(size_t)row * 16 + u.pn * 4 + wc] = ss;
            }
    }
};
struct EpiF32 {
    static constexpr bool PERM = false, AFTER_DRAIN = false;
    float* C; int ldc;
    __device__ __forceinline__ void operator()(const pg8::f32x4 (&acc)[2][2][4][2], const pg8::Unit& u, int wr, int wc, int fr, int fq) const {
        const int row0 = u.pm * 256 + wr * 64 + fr, col0 = u.pn * 256 + wc * 32 + 4 * fq;
#pragma unroll
        for (int ai = 0; ai < 2; ++ai)
#pragma unroll
            for (int m = 0; m < 4; ++m) { float* rowp = C + (size_t)(row0 + ai * 128 + m * 16) * ldc + col0;
#pragma unroll
                for (int bj = 0; bj < 2; ++bj)
#pragma unroll
                    for (int n = 0; n < 2; ++n) *(f32x4*)(rowp + bj * 128 + n * 16) = acc[ai][bj][m][n]; }
    }
};

constexpr int A_K = 0, A_V = 49152, A_WS = 98304, A_ST = 100352;
__device__ __forceinline__ void attn_unit(const Ptrs& p, LAS unsigned char* lds, int unit, int tid, int lane, int w) {
    const int bh = unit / 48, rem = unit % 48, pat = rem >> 4, k16 = rem & 15;
    const int b = bh >> 3, h = bh & 7, dl = 1 << (2 * pat), nb = 16 >> (2 * pat), r = k16 / nb, qb = k16 % nb;
    const int m0 = qb * 256, r32 = lane & 31, hi = lane >> 5;
    const bf16* Qp = (const bf16*)(p.ws + WS_Q); const bf16* Kp = (const bf16*)(p.ws + WS_K); const bf16* Vp = (const bf16*)(p.ws + WS_V);
    bf16* PO = (bf16*)(p.ws + WS_PO) + (size_t)pat * T * 512; float* LSE = (float*)(p.ws + WS_LSE) + (size_t)pat * T * 8;
    const size_t rowbase = (size_t)b * SEQ + r;
    const int jlo = (qb == 0) ? 2 : 0;
    for (int j = jlo; j < 6; ++j) {
        const int mk = m0 - 128 + 64 * j;
        const v4u kv = *(const v4u*)(Kp + (rowbase + (size_t)(mk + lane) * dl) * 512 + h * 64 + w * 8);
        *(LAS v4u*)(lds + A_K + j * 8192 + w * 1024 + lane * 16) = kv;
        const v4u vv = *(const v4u*)(Vp + (rowbase + (size_t)(mk + 16 * (w & 3) + (lane >> 2)) * dl) * 512 + h * 64 + 32 * (w >> 2) + 8 * (lane & 3));
        *(LAS v4u*)(lds + A_V + j * 8192 + w * 1024 + lane * 16) = vv;
    }
    const size_t qrow = rowbase + (size_t)(m0 + 32 * w + r32) * dl;
    bf16x8 qr[4];
#pragma unroll
    for (int d0 = 0; d0 < 4; ++d0) qr[d0] = *(const bf16x8*)(Qp + qrow * 512 + h * 64 + d0 * 16 + hi * 8);
    __syncthreads();
    f32x16 s0[3], s1[3];
    const int thr = 32 * (w & 1) + r32;
    const float NEGINF = -INFINITY;
#pragma unroll
    for (int t = 0; t < 3; ++t) {
        const int j = (w >> 1) + t;
        f32x16 a0 = {}, a1 = {};
        if (j >= jlo) {
            const LAS unsigned char* kb = lds + A_K + j * 8192 + hi * 1024 + r32 * 16;
#pragma unroll
            for (int d0 = 0; d0 < 4; ++d0) {
                const bf16x8 k0 = *(const LAS bf16x8*)(kb + d0 * 2048), k1 = *(const LAS bf16x8*)(kb + d0 * 2048 + 512);
                a0 = __builtin_amdgcn_mfma_f32_32x32x16_bf16(k0, qr[d0], a0, 0, 0, 0);
                a1 = __builtin_amdgcn_mfma_f32_32x32x16_bf16(k1, qr[d0], a1, 0, 0, 0);
            }
        }
#pragma unroll
        for (int rr = 0; rr < 16; ++rr) {
            const int kk = crow(rr, hi);
            bool v0 = (j >= jlo), v1 = v0;
            if (t == 0) { v0 = v0 && (kk >= thr); v1 = v1 && (kk + 32 >= thr); }
            if (t == 2) { v0 = v0 && (kk <= thr); v1 = v1 && (kk + 32 <= thr); }
            a0[rr] = v0 ? a0[rr] : NEGINF; a1[rr] = v1 ? a1[rr] : NEGINF;
        }
        s0[t] = a0; s1[t] = a1;
    }
    float mx = NEGINF;
#pragma unroll
    for (int t = 0; t < 3; ++t)
#pragma unroll
        for (int rr = 0; rr < 16; ++rr) mx = fmaxf(mx, fmaxf(s0[t][rr], s1[t][rr]));
    mx = fmaxf(mx, __shfl_xor(mx, 32));
    float l = 0.f;
#pragma unroll
    for (int t = 0; t < 3; ++t)
#pragma unroll
        for (int rr = 0; rr < 16; ++rr) { s0[t][rr] = __builtin_amdgcn_exp2f(s0[t][rr] - mx); s1[t][rr] = __builtin_amdgcn_exp2f(s1[t][rr] - mx); l += s0[t][rr] + s1[t][rr]; }
    l += __shfl_xor(l, 32);
    f32x16 o[2]; o[0] = (f32x16){}; o[1] = (f32x16){};
    const int vlane = ((lane >> 4) & 1) * 32 + (lane & 3) * 8 + (4 * hi + ((lane & 15) >> 2)) * 64;
#pragma unroll
    for (int t = 0; t < 3; ++t) {
        const int j = (w >> 1) + t;
        if (j >= jlo) {
            const LAS unsigned char* vb = lds + A_V + j * 8192 + vlane;
#pragma unroll
            for (int ks = 0; ks < 4; ++ks) {
                v4u pw;
                if (ks < 2) { const int bq = 8 * ks; pw.x = pk2(s0[t][bq], s0[t][bq + 1]); pw.y = pk2(s0[t][bq + 2], s0[t][bq + 3]); pw.z = pk2(s0[t][bq + 4], s0[t][bq + 5]); pw.w = pk2(s0[t][bq + 6], s0[t][bq + 7]); }
                else { const int bq = 8 * (ks - 2); pw.x = pk2(s1[t][bq], s1[t][bq + 1]); pw.y = pk2(s1[t][bq + 2], s1[t][bq + 3]); pw.z = pk2(s1[t][bq + 4], s1[t][bq + 5]); pw.w = pk2(s1[t][bq + 6], s1[t][bq + 7]); }
                const bf16x8 pa = __builtin_bit_cast(bf16x8, pw);
#pragma unroll
                for (int d0 = 0; d0 < 2; ++d0) {
                    const s16x4 lo = __builtin_bit_cast(s16x4, __builtin_amdgcn_ds_read_tr16_b64_v4i16((LAS v4i16_t*)(vb + d0 * 4096 + ks * 1024)));
                    const s16x4 hh = __builtin_bit_cast(s16x4, __builtin_amdgcn_ds_read_tr16_b64_v4i16((LAS v4i16_t*)(vb + d0 * 4096 + ks * 1024 + 512)));
                    const bf16x8 vf = (bf16x8){lo[0], lo[1], lo[2], lo[3], hh[0], hh[1], hh[2], hh[3]};
                    o[d0] = __builtin_amdgcn_mfma_f32_32x32x16_bf16(pa, vf, o[d0], 0, 0, 0);
                }
            }
        }
    }
    LAS float* wsf = (LAS float*)(lds + A_WS) + w * 64;
    if (hi == 0) { wsf[r32] = l; LSE[qrow * 8 + h] = mx + __builtin_amdgcn_logf(l); }
    asm volatile("s_waitcnt lgkmcnt(0)" ::: "memory");
    LAS bf16* stg = (LAS bf16*)(lds + A_ST) + w * 2048;
#pragma unroll
    for (int rr = 0; rr < 16; ++rr) { const int orow = crow(rr, hi); const float rl = __builtin_amdgcn_rcpf(wsf[orow]);
        stg[orow * 64 + r32] = (bf16)f2bf(o[0][rr] * rl); stg[orow * 64 + 32 + r32] = (bf16)f2bf(o[1][rr] * rl); }
    asm volatile("s_waitcnt lgkmcnt(0)" ::: "memory");
#pragma unroll
    for (int i = 0; i < 4; ++i) { const int row = i * 8 + (lane >> 3), ch = lane & 7; const v4u v = *(const LAS v4u*)(stg + row * 64 + ch * 8);
        *(v4u*)(PO + (rowbase + (size_t)(m0 + 32 * w + row) * dl) * 512 + h * 64 + ch * 8) = v; }
    __syncthreads();
}

__device__ __forceinline__ void gmlp_unit(const Ptrs& p, LAS unsigned char* lds, int unit, int tid, int lane, int w) {
    const size_t rowbase = (size_t)unit * 128;
    const bf16* GU = (const bf16*)(p.ws + WS_GU); const bf16* GV = (const bf16*)(p.ws + WS_GV); const bf16* WSP = (const bf16*)(p.ws + WS_WSP);
    bf16* MG = (bf16*)(p.ws + WS_HN);
    const int r32 = lane & 31, hi = lane >> 5;
    {
        const int g = lane >> 4; f32x4 ga = *(const f32x4*)(p.vg_g + g * 128 + (lane & 15) * 8), gb = *(const f32x4*)(p.vg_g + g * 128 + (lane & 15) * 8 + 4);
#pragma unroll 4
        for (int it = 0; it < 16; ++it) {
            const int j = it * 8 + w;
            const v4u raw = *(const v4u*)(GV + (rowbase + j) * 512 + lane * 8);
            float v[8] = {bflo(raw.x), bfhi(raw.x), bflo(raw.y), bfhi(raw.y), bflo(raw.z), bfhi(raw.z), bflo(raw.w), bfhi(raw.w)};
            float ss = 0.f;
#pragma unroll
            for (int i = 0; i < 8; ++i) ss += v[i] * v[i];
            ss += __shfl_xor(ss, 1); ss += __shfl_xor(ss, 2); ss += __shfl_xor(ss, 4); ss += __shfl_xor(ss, 8);
            const float rn = rsqrtf(ss * (1.f / 128.f) + EPS);
            v4u o; o.x = pk2(v[0] * rn * ga.x, v[1] * rn * ga.y); o.y = pk2(v[2] * rn * ga.z, v[3] * rn * ga.w); o.z = pk2(v[4] * rn * gb.x, v[5] * rn * gb.y); o.w = pk2(v[6] * rn * gb.z, v[7] * rn * gb.w);
            *(LAS v4u*)(lds + ((lane >> 2) * 8 + (j >> 4)) * 1024 + (j & 15) * 64 + (lane & 3) * 16) = o;
        }
    }
    __syncthreads();
    const int ib = w & 3, gp = w >> 2;
    f32x16 acc[8];
#pragma unroll
    for (int i = 0; i < 8; ++i) acc[i] = (f32x16){};
    const int vlane = ((lane >> 4) & 1) * 32 + (lane & 3) * 8 + (4 * hi + ((lane & 15) >> 2)) * 64;
#pragma unroll
    for (int g2 = 0; g2 < 2; ++g2) {
        const int g = 2 * gp + g2;
        for (int ks = 0; ks < 2 * ib + 2; ++ks) {
            const bf16x8 af = *(const bf16x8*)(WSP + (size_t)((g * 128 + 32 * ib + r32) * 128 + 16 * ks + 8 * hi));
#pragma unroll
            for (int ct = 0; ct < 4; ++ct) {
                const LAS unsigned char* vb = lds + ((g * 4 + ct) * 8 + ks) * 1024 + vlane;
                const s16x4 lo = __builtin_bit_cast(s16x4, __builtin_amdgcn_ds_read_tr16_b64_v4i16((LAS v4i16_t*)(vb)));
                const s16x4 hh = __builtin_bit_cast(s16x4, __builtin_amdgcn_ds_read_tr16_b64_v4i16((LAS v4i16_t*)(vb + 512)));
                const bf16x8 vf = (bf16x8){lo[0], lo[1], lo[2], lo[3], hh[0], hh[1], hh[2], hh[3]};
                acc[g2 * 4 + ct] = __builtin_amdgcn_mfma_f32_32x32x16_bf16(af, vf, acc[g2 * 4 + ct], 0, 0, 0);
            }
        }
    }
    __syncthreads();
#pragma unroll
    for (int g2 = 0; g2 < 2; ++g2) {
        const int g = 2 * gp + g2;
#pragma unroll
        for (int rr = 0; rr < 16; ++rr) {
            const int i = 32 * ib + crow(rr, hi); const float bias = p.b_sp[g * 128 + i];
#pragma unroll
            for (int ct = 0; ct < 4; ++ct) {
                const int c = g * 128 + ct * 32 + r32;
                const float gu = bflo((unsigned)GU[(rowbase + i) * 512 + c]);
                *(LAS bf16*)(lds + (i * 512 + c) * 2) = (bf16)f2bf(gu * (acc[g2 * 4 + ct][rr] + bias));
            }
        }
    }
    __syncthreads();
    {
        const f32x4 ga = *(const f32x4*)(p.go_g + lane * 8), gb = *(const f32x4*)(p.go_g + lane * 8 + 4);
#pragma unroll 4
        for (int ii = 0; ii < 16; ++ii) {
            const int i = 16 * w + ii;
            const v4u raw = *(const LAS v4u*)(lds + (i * 512 + lane * 8) * 2);
            float v[8] = {bflo(raw.x), bfhi(raw.x), bflo(raw.y), bfhi(raw.y), bflo(raw.z), bfhi(raw.z), bflo(raw.w), bfhi(raw.w)};
            float ss = 0.f;
#pragma unroll
            for (int k = 0; k < 8; ++k) ss += v[k] * v[k];
            const float rn = rsqrtf(wave_sum(ss) * (1.f / 512.f) + EPS);
            v4u o; o.x = pk2(v[0] * rn * ga.x, v[1] * rn * ga.y); o.y = pk2(v[2] * rn * ga.z, v[3] * rn * ga.w); o.z = pk2(v[4] * rn * gb.x, v[5] * rn * gb.y); o.w = pk2(v[6] * rn * gb.z, v[7] * rn * gb.w);
            *(v4u*)(MG + (rowbase + i) * 1024 + 512 + lane * 8) = o;
        }
    }
    __syncthreads();
}

__device__ __forceinline__ void combine_row(const Ptrs& p, size_t row, int lane) {
    const bf16* PO = (const bf16*)(p.ws + WS_PO); const float* LSE = (const float*)(p.ws + WS_LSE); bf16* MG = (bf16*)(p.ws + WS_HN);
    const int h = lane >> 3;
    const float l0 = LSE[row * 8 + h], l1 = LSE[(size_t)T * 8 + row * 8 + h], l2 = LSE[(size_t)2 * T * 8 + row * 8 + h];
    const float mx = fmaxf(l0, fmaxf(l1, l2));
    float w0 = __builtin_amdgcn_exp2f(l0 - mx), w1 = __builtin_amdgcn_exp2f(l1 - mx), w2 = __builtin_amdgcn_exp2f(l2 - mx);
    const float inv = 1.f / (w0 + w1 + w2); w0 *= inv; w1 *= inv; w2 *= inv;
    const v4u a = *(const v4u*)(PO + row * 512 + lane * 8), b = *(const v4u*)(PO + (size_t)T * 512 + row * 512 + lane * 8), c = *(const v4u*)(PO + (size_t)2 * T * 512 + row * 512 + lane * 8);
    float v[8];
    v[0] = w0 * bflo(a.x) + w1 * bflo(b.x) + w2 * bflo(c.x); v[1] = w0 * bfhi(a.x) + w1 * bfhi(b.x) + w2 * bfhi(c.x);
    v[2] = w0 * bflo(a.y) + w1 * bflo(b.y) + w2 * bflo(c.y); v[3] = w0 * bfhi(a.y) + w1 * bfhi(b.y) + w2 * bfhi(c.y);
    v[4] = w0 * bflo(a.z) + w1 * bflo(b.z) + w2 * bflo(c.z); v[5] = w0 * bfhi(a.z) + w1 * bfhi(b.z) + w2 * bfhi(c.z);
    v[6] = w0 * bflo(a.w) + w1 * bflo(b.w) + w2 * bflo(c.w); v[7] = w0 * bfhi(a.w) + w1 * bfhi(b.w) + w2 * bfhi(c.w);
    float ss = 0.f;
#pragma unroll
    for (int k = 0; k < 8; ++k) ss += v[k] * v[k];
    const float rn = rsqrtf(wave_sum(ss) * (1.f / 512.f) + EPS);
    const f32x4 ga = *(const f32x4*)(p.ao_g + lane * 8), gb = *(const f32x4*)(p.ao_g + lane * 8 + 4);
    v4u o; o.x = pk2(v[0] * rn * ga.x, v[1] * rn * ga.y); o.y = pk2(v[2] * rn * ga.z, v[3] * rn * ga.w); o.z = pk2(v[4] * rn * gb.x, v[5] * rn * gb.y); o.w = pk2(v[6] * rn * gb.z, v[7] * rn * gb.w);
    *(v4u*)(MG + row * 1024 + lane * 8) = o;
}

constexpr int TK_L = 135168;
__device__ __forceinline__ void ins16(float (&l)[16], float x) {
#pragma unroll
    for (int i = 15; i >= 1; --i) l[i] = __builtin_amdgcn_fmed3f(l[i - 1], l[i], x);
    l[0] = fmaxf(l[0], x);
}
__device__ __forceinline__ void topk_unit(const Ptrs& p, LAS unsigned char* lds, int unit, int tid) {
    const float* SC = (const float*)(p.ws + WS_SC); const float* PART = (const float*)(p.ws + WS_PART);
    int* IDX = (int*)(p.ws + WS_IDX); float* GATE = (float*)(p.ws + WS_GATE);
    const size_t t0 = (size_t)unit * 16;
    LAS float* S = (LAS float*)lds; LAS unsigned* L = (LAS unsigned*)(lds + TK_L);
#pragma unroll 4
    for (int it = 0; it < 16; ++it) { const int q = tid + NTHR * it, tk = q >> 9, cc = q & 511, hh = cc >> 5, c4 = cc & 31;
        *(LAS f32x4*)(S + (tk * 16 + hh) * 132 + c4 * 4) = *(const f32x4*)(SC + (t0 + tk) * 2048 + cc * 4); }
    __syncthreads();
    if (tid < 256) {
        float l[16];
#pragma unroll
        for (int i = 0; i < 16; ++i) l[i] = -INFINITY;
        const LAS float* row = S + tid * 132;
        for (int c4 = 0; c4 < 32; ++c4) { const f32x4 v = *(const LAS f32x4*)(row + c4 * 4);
#pragma unroll
            for (int e = 0; e < 4; ++e) ins16(l, __uint_as_float((__float_as_uint(v[e]) & ~0x7fu) | (unsigned)(c4 * 4 + e))); }
#pragma unroll
        for (int i = 0; i < 16; ++i) L[tid * 16 + i] = __float_as_uint(l[i]);
    }
    __syncthreads();
    if (tid < 128) {
        const int tk = tid >> 3, hd = tid & 7; const size_t t = t0 + tk;
        const LAS unsigned* La = L + (tk * 16 + hd * 2) * 16; const LAS unsigned* Lb = La + 16;
        float fa[16], fb[16];
#pragma unroll
        for (int i = 0; i < 16; ++i) { fa[i] = __uint_as_float(La[i] & ~0x7fu); fb[i] = __uint_as_float(Lb[i] & ~0x7fu); }
        float l[16];
#pragma unroll
        for (int i = 0; i < 16; ++i) l[i] = -INFINITY;
#pragma unroll
        for (int i = 0; i < 16; ++i)
#pragma unroll
            for (int j = 0; j < 16; ++j) if ((i + 1) * (j + 1) <= 16) ins16(l, __uint_as_float((__float_as_uint(fa[i] + fb[j]) & ~0xffu) | (unsigned)(i * 16 + j)));
        float ss = 0.f;
        { const f32x4* pp = (const f32x4*)(PART + t * 16); const f32x4 a = pp[0], b = pp[1], c = pp[2], d = pp[3];
          ss = ((a[0] + a[1]) + (a[2] + a[3])) + ((b[0] + b[1]) + (b[2] + b[3])) + ((c[0] + c[1]) + (c[2] + c[3])) + ((d[0] + d[1]) + (d[2] + d[3])); }
        const float rt = rsqrtf(ss * (1.f / D) + EPS) * 1.4426950408889634f;
        float sv[16], den = 0.f; const float s0 = __uint_as_float(__float_as_uint(l[0]) & ~0xffu);
#pragma unroll
        for (int k = 0; k < 16; ++k) { sv[k] = __builtin_amdgcn_exp2f((__uint_as_float(__float_as_uint(l[k]) & ~0xffu) - s0) * rt); den += sv[k]; }
        const float inv = 1.f / den;
#pragma unroll
        for (int k = 0; k < 16; ++k) { const unsigned code = __float_as_uint(l[k]) & 0xffu; const unsigned ia = La[code >> 4] & 0x7fu, ibb = Lb[code & 15u] & 0x7fu;
            IDX[t * 128 + hd * 16 + k] = (int)(ia * 128u + ibb); GATE[t * 128 + hd * 16 + k] = sv[k] * inv; }
    }
    __syncthreads();
}

__device__ __forceinline__ float dot2bf(unsigned u, unsigned x, float acc) { return __builtin_amdgcn_fdot2_f32_bf16(__builtin_bit_cast(bf16x2_t, u), __builtin_bit_cast(bf16x2_t, x), acc, false); }
__device__ __forceinline__ float dot16(const v4u& ua, const v4u& ub, const v4u& xa, const v4u& xb) {
    float acc = 0.f;
    acc = dot2bf(ua.x, xa.x, acc); acc = dot2bf(ua.y, xa.y, acc); acc = dot2bf(ua.z, xa.z, acc); acc = dot2bf(ua.w, xa.w, acc);
    acc = dot2bf(ub.x, xb.x, acc); acc = dot2bf(ub.y, xb.y, acc); acc = dot2bf(ub.z, xb.z, acc); acc = dot2bf(ub.w, xb.w, acc);
    return acc;
}
__device__ __forceinline__ void peer_token(const Ptrs& p, size_t t, int lane) {
    const bf16* X1B = (const bf16*)(p.ws + WS_X1B); const float* PART = (const float*)(p.ws + WS_PART);
    const int* IDX = (const int*)(p.ws + WS_IDX); const float* GATE = (const float*)(p.ws + WS_GATE);
    const bf16* EU = (const bf16*)(p.ws + WS_EU); const bf16* EV = (const bf16*)(p.ws + WS_EV);
    const v4u xa = *(const v4u*)(X1B + t * 1024 + lane * 8), xb = *(const v4u*)(X1B + t * 1024 + 512 + lane * 8);
    float ss;
    { const f32x4* pp = (const f32x4*)(PART + t * 16); const f32x4 a = pp[0], b = pp[1], c = pp[2], d = pp[3];
      ss = ((a[0] + a[1]) + (a[2] + a[3])) + ((b[0] + b[1]) + (b[2] + b[3])) + ((c[0] + c[1]) + (c[2] + c[3])) + ((d[0] + d[1]) + (d[2] + d[3])); }
    const float rt = rsqrtf(ss * (1.f / D) + EPS);
    const int i0 = IDX[t * 128 + lane], i1 = IDX[t * 128 + 64 + lane];
    const float g0 = GATE[t * 128 + lane], g1 = GATE[t * 128 + 64 + lane];
    float a0 = 0.f, a1 = 0.f;
    for (int k = 0; k < 64; k += 4) {
        float d[8];
#pragma unroll
        for (int q = 0; q < 4; ++q) {
            const int e0 = __builtin_amdgcn_readlane(i0, k + q), e1 = __builtin_amdgcn_readlane(i1, k + q);
            const v4u ua = *(const v4u*)(EU + (size_t)e0 * 1024 + lane * 8), ub = *(const v4u*)(EU + (size_t)e0 * 1024 + 512 + lane * 8);
            const v4u uc = *(const v4u*)(EU + (size_t)e1 * 1024 + lane * 8), ud = *(const v4u*)(EU + (size_t)e1 * 1024 + 512 + lane * 8);
            d[q] = dot16(ua, ub, xa, xb); d[4 + q] = dot16(uc, ud, xa, xb);
        }
#pragma unroll
        for (int q = 0; q < 8; ++q) d[q] = wave_sum(d[q]);
#pragma unroll
        for (int q = 0; q < 4; ++q) { if (lane == k + q) { a0 = d[q]; a1 = d[4 + q]; } }
    }
    const float c0 = g0 * gelu_exact(a0 * rt), c1 = g1 * gelu_exact(a1 * rt);
    float acc[16];
#pragma unroll
    for (int i = 0; i < 16; ++i) acc[i] = 0.f;
    for (int k = 0; k < 64; k += 2) {
#pragma unroll
        for (int q = 0; q < 2; ++q) {
#pragma unroll
            for (int hf = 0; hf < 2; ++hf) {
                const int e = __builtin_amdgcn_readlane(hf ? i1 : i0, k + q);
                const float cf = __builtin_bit_cast(float, __builtin_amdgcn_readlane(__builtin_bit_cast(int, hf ? c1 : c0), k + q));
                const v4u va = *(const v4u*)(EV + (size_t)e * 1024 + lane * 8), vb = *(const v4u*)(EV + (size_t)e * 1024 + 512 + lane * 8);
                acc[0] += cf * bflo(va.x); acc[1] += cf * bfhi(va.x); acc[2] += cf * bflo(va.y); acc[3] += cf * bfhi(va.y);
                acc[4] += cf * bflo(va.z); acc[5] += cf * bfhi(va.z); acc[6] += cf * bflo(va.w); acc[7] += cf * bfhi(va.w);
                acc[8] += cf * bflo(vb.x); acc[9] += cf * bfhi(vb.x); acc[10] += cf * bflo(vb.y); acc[11] += cf * bfhi(vb.y);
                acc[12] += cf * bflo(vb.z); acc[13] += cf * bfhi(vb.z); acc[14] += cf * bflo(vb.w); acc[15] += cf * bfhi(vb.w);
            }
        }
    }
    float* o = p.out + t * 1024;
    f32x4 x0 = *(const f32x4*)(o + lane * 8), x1 = *(const f32x4*)(o + lane * 8 + 4), x2 = *(const f32x4*)(o + 512 + lane * 8), x3 = *(const f32x4*)(o + 512 + lane * 8 + 4);
    x0 += (f32x4){acc[0], acc[1], acc[2], acc[3]}; x1 += (f32x4){acc[4], acc[5], acc[6], acc[7]}; x2 += (f32x4){acc[8], acc[9], acc[10], acc[11]}; x3 += (f32x4){acc[12], acc[13], acc[14], acc[15]};
    *(f32x4*)(o + lane * 8) = x0; *(f32x4*)(o + lane * 8 + 4) = x1; *(f32x4*)(o + 512 + lane * 8) = x2; *(f32x4*)(o + 512 + lane * 8 + 4) = x3;
}

constexpr int N_PHASES = 8;
__global__ void __launch_bounds__(NTHR, 2) hymba_fwd(Args args) {
    extern __shared__ __attribute__((aligned(16))) unsigned char lds_raw[];
    LAS unsigned char* lds = (LAS unsigned char*)lds_raw;
    const Ptrs& p = args.p;
    const int tid = threadIdx.x, lane = tid & 63, wave = __builtin_amdgcn_readfirstlane(tid >> 6);
    const int G = gridDim.x, bx = blockIdx.x, vcu = (G % 8 == 0) ? (bx % 8) * (G / 8) + bx / 8 : bx;
    const int gw = vcu * NWAVES + wave, NGW = G * NWAVES;
    const int lo = args.ph_lo, hi = args.ph_hi;
#define IN(k) (lo <= (k) && (k) < hi)
    if (IN(0)) p0_prologue(p, lds, tid, lane, wave, vcu, G);
    if (IN(1)) {
        pg8::Gemm g{(const bf16*)(p.ws + WS_HN), (const bf16*)(p.ws + WS_WIN), T, INW, D}; pg8::StaticOrder S; S.init(T, INW, G, bx);
        EpiProj E{(bf16*)(p.ws + WS_Q), (bf16*)(p.ws + WS_K), (bf16*)(p.ws + WS_V), (bf16*)(p.ws + WS_GU), (bf16*)(p.ws + WS_GV), p.q_g, p.k_g};
        pg8::gemm_phase<EpiProj, pg8::StaticOrder, true, true>(lds, g, S, E);
    }
    if (IN(2)) { for (int u = vcu; u < BATCH * NH * 48; u += G) attn_unit(p, lds, u, tid, lane, wave); }
    if (IN(3)) {
        for (int u = vcu; u < T / 128; u += G) gmlp_unit(p, lds, u, tid, lane, wave);
        for (int m = gw; m < T; m += NGW) combine_row(p, (size_t)m, lane);
    }
    if (IN(4)) {
        pg8::Gemm g{(const bf16*)(p.ws + WS_HN), (const bf16*)(p.ws + WS_WOUT), T, D, D}; pg8::StaticOrder S; S.init(T, D, G, bx);
        EpiOut E{p.x, p.out, (bf16*)(p.ws + WS_X1B), (float*)(p.ws + WS_PART)};
        pg8::gemm_phase<EpiOut, pg8::StaticOrder, true, true>(lds, g, S, E);
    }
    if (IN(5)) {
        pg8::Gemm g{(const bf16*)(p.ws + WS_X1B), (const bf16*)(p.ws + WS_WQK), T, 2048, D}; pg8::StaticOrder S; S.init(T, 2048, G, bx);
        EpiF32 E{(float*)(p.ws + WS_SC), 2048};
        pg8::gemm_phase<EpiF32, pg8::StaticOrder, true, true>(lds, g, S, E);
    }
    if (IN(6)) { for (int u = vcu; u < T / 16; u += G) topk_unit(p, lds, u, tid); }
    if (IN(7)) { for (int m = gw; m < T; m += NGW) peer_token(p, (size_t)m, lane); }
#undef IN
}

extern "C" void kernel_launch(void* const* d_in, const int* in_sizes, int n_in, void* d_out, int out_size, void* d_ws, size_t ws_size, hipStream_t stream) {
    static int grid = 0;
    if (grid == 0) {
        if (n_in != 17 || in_sizes[0] != T * D || out_size != T * D || ws_size < WS_END) { fprintf(stderr, "kernel_launch: unexpected shapes (n_in %d, in0 %d, out %d, ws %zu); nothing launched\n", n_in, n_in > 0 ? in_sizes[0] : -1, out_size, ws_size); grid = -1; return; }
        int dev = 0, cus = 0, per_cu = 0;
        if (hipGetDevice(&dev) != hipSuccess || hipDeviceGetAttribute(&cus, hipDeviceAttributeMultiprocessorCount, dev) != hipSuccess) { grid = -1; return; }
        if (hipFuncSetAttribute((const void*)hymba_fwd, hipFuncAttributeMaxDynamicSharedMemorySize, LDS_BYTES) != hipSuccess) { fprintf(stderr, "kernel_launch: hipFuncSetAttribute failed\n"); grid = -1; return; }
        if (hipOccupancyMaxActiveBlocksPerMultiprocessor(&per_cu, (const void*)hymba_fwd, NTHR, LDS_BYTES) != hipSuccess || per_cu < 1) fprintf(stderr, "kernel_launch: occupancy query reports %d\n", per_cu);
        (void)hipGetLastError();
        grid = cus;
    }
    if (grid < 0) return;
    Args a{};
    const float** pp = (const float**)&a.p;
    for (int i = 0; i < 17; ++i) pp[i] = (const float*)d_in[i];
    a.p.out = (float*)d_out; a.p.ws = (unsigned char*)d_ws;
    for (int ph = 0; ph < N_PHASES; ++ph) { a.ph_lo = ph; a.ph_hi = ph + 1; hipLaunchKernelGGL(hymba_fwd, dim3(grid), dim3(NTHR), LDS_BYTES, stream, a); }
}
```

```cpp
#include <hip/hip_runtime.h>
#include <cstdio>
#include <cstdint>
#include <cmath>
namespace pg8 {
#define PG8_LAS __attribute__((address_space(3)))
typedef unsigned short bf16_t;
typedef short bf16x8 __attribute__((ext_vector_type(8)));
typedef float f32x4 __attribute__((ext_vector_type(4)));
typedef unsigned u32x4 __attribute__((ext_vector_type(4)));
typedef int i32x4 __attribute__((ext_vector_type(4)));
typedef int i32x8 __attribute__((ext_vector_type(8)));
constexpr int BM = 256, BK = 64, HALF = 128, HTB = HALF * BK * 2  , STAGE_BYTES = 8 * HTB, NXCD = 8, WGM = 8;

__host__ __device__ __forceinline__ int lds_byte(int r, int c) { const int st = (r >> 4) * 2 + (c >> 5), rr = r & 15, cc = c & 31, ob = rr * 64 + cc * 2; return st * 1024 + (ob ^ (((ob >> 9) & 1) << 5)); }
__host__ __device__ __forceinline__ void stage_rc(int b, int& R, int& C) { const int st = b / 1024, sb = b % 1024, swz = sb ^ (((sb >> 9) & 1) << 5); R = (st >> 1) * 16 + swz / 64; C = (st & 1) * 32 + (swz % 64) / 2; }
__host__ __device__ __forceinline__ int perm32(int rho) { const int n = rho >> 4, i = rho & 15; return 8 * (i >> 2) + 4 * n + (i & 3); }

struct Unit { int pm, pn; };
struct Gemm { const bf16_t* A; const bf16_t* Bt; int M, N, K; };

struct StaticOrder {
    int nM, nN, nwg, G, c;
    __host__ __device__ void init(int M, int N, int G_, int c_) { nM = M / BM; nN = N / BM; nwg = nM * nN; G = G_; c = c_; }
    __host__ __device__ bool next(int i, Unit& u) const {
        const long L = (long)i * G + c; if (L >= nwg) return false;
        int wgid = (int)L; { const int q = nwg / NXCD, r = nwg % NXCD, xcd = wgid % NXCD, off = wgid / NXCD; wgid = (xcd < r ? xcd * (q + 1) : r * (q + 1) + (xcd - r) * q) + off; }
        const int nig = WGM * nN, gid = wgid / nig, fm = gid * WGM, gsz = (nM - fm) < WGM ? (nM - fm) : WGM;
        u.pm = fm + ((wgid % nig) % gsz); u.pn = (wgid % nig) / gsz; return true;
    }
    __device__ __forceinline__ void a_ready(const Unit&) const {}
    __device__ __forceinline__ void done(const Unit&) const {}
};

__device__ __forceinline__ unsigned cvt_pk_bf16(float lo, float hi) { unsigned r; asm volatile("v_cvt_pk_bf16_f32 %0, %1, %2" : "=v"(r) : "v"(lo), "v"(hi)); return r; }
typedef float f32x2 __attribute__((ext_vector_type(2)));
__device__ __forceinline__ f32x2 gelu_pk(f32x2 v) {
    const f32x2 av = __builtin_elementwise_abs(v), d = av * 0.2316418882f + 1.0f;
    f32x2 t; t.x = __builtin_amdgcn_rcpf(d.x); t.y = __builtin_amdgcn_rcpf(d.y);
    f32x2 q = t * 0.5307027145f + (-0.7265760135f); q = q * t + 0.7107068705f; q = q * t + (-0.142248368f); q = q * t + 0.127414796f; q = q * t;
    const f32x2 s = (v * v) * (-0.72134752044f);
    f32x2 e; e.x = __builtin_amdgcn_exp2f(s.x); e.y = __builtin_amdgcn_exp2f(s.y);
    const f32x2 m = v * (q * e), r = v - m;
    f32x2 o; o.x = v.x < 0.f ? m.x : r.x; o.y = v.y < 0.f ? m.y : r.y; return o;
}

template <class Epi, class Sched, bool ALIGN_EPI = false, bool SP2 = false, bool FP8 = false>
__device__ __forceinline__ void gemm_phase(PG8_LAS unsigned char* lds, const Gemm g, const Sched& S, const Epi& E) {
    const int tid = threadIdx.x, wid = __builtin_amdgcn_readfirstlane(tid >> 6), lane = tid & 63, wr = wid >> 2, wc = wid & 3, fr = lane & 15, fq = lane >> 4;
    const int K = g.K, nt = K / BK;
    unsigned voffA[2], voffB[2];
#pragma unroll
    for (int i = 0; i < 2; ++i) { int R, C; stage_rc(tid * 16 + i * 8192, R, C); const int Rb = Epi::PERM ? ((R & ~31) + perm32(R & 31)) : R;
        voffA[i] = (unsigned)(R * K + C) * 2u; voffB[i] = (unsigned)(Rb * K + C) * 2u; }
    const size_t kstep = (size_t)(BK * 2);
    const size_t hstep = (size_t)HALF * K * 2;
    const size_t tstep = 2 * hstep;
    const unsigned ldsw = (unsigned)wid * 1024u;
    const int aoff = lds_byte(wr * 64 + fr, fq * 8), boff = lds_byte(wc * 32 + fr, fq * 8);
#define PG8_SA(b, h) (((b) * 2 + (h)) * HTB)
#define PG8_SB(b, h) ((4 + (b) * 2 + (h)) * HTB)
#define PG8_STAGE(bufoff, gbase, voff) do { _Pragma("unroll") for (int _i = 0; _i < 2; ++_i) \
        __builtin_amdgcn_global_load_lds((const unsigned*)((const char*)(gbase) + (voff)[_i]), (PG8_LAS unsigned*)(lds + (bufoff) + ldsw + _i * 8192), 16, 0, 0); } while (0)
#define PG8_LD8(p_) __builtin_shufflevector(*(const PG8_LAS i32x4*)(p_), *(const PG8_LAS i32x4*)((p_) + 1024), 0, 1, 2, 3, 4, 5, 6, 7)
#define PG8_LDA(dst, b, h) do { if constexpr (FP8) { _Pragma("unroll") for (int m = 0; m < 4; ++m) dst##8[m] = PG8_LD8(lds + PG8_SA(b, h) + aoff + m * 2048); } \
        else { _Pragma("unroll") for (int m = 0; m < 4; ++m) _Pragma("unroll") for (int k = 0; k < 2; ++k) dst[m][k] = *(const PG8_LAS bf16x8*)(lds + PG8_SA(b, h) + aoff + m * 2048 + k * 1024); } } while (0)
#define PG8_LDB(dst, b, h) do { if constexpr (FP8) { _Pragma("unroll") for (int n = 0; n < 2; ++n) dst##8[n] = PG8_LD8(lds + PG8_SB(b, h) + boff + n * 2048); } \
        else { _Pragma("unroll") for (int n = 0; n < 2; ++n) _Pragma("unroll") for (int k = 0; k < 2; ++k) dst[n][k] = *(const PG8_LAS bf16x8*)(lds + PG8_SB(b, h) + boff + n * 2048 + k * 1024); } } while (0)
#define PG8_MMA(ai, bj, At, Bt) do { __builtin_amdgcn_s_setprio(1); \
        if constexpr (FP8) { _Pragma("unroll") for (int m = 0; m < 4; ++m) _Pragma("unroll") for (int n = 0; n < 2; ++n) \
            asm volatile("v_mfma_f32_16x16x128_f8f6f4 %0, %1, %2, %0" : "+v"(acc[ai][bj][m][n]) : "v"(Bt##8[n]), "v"(At##8[m])); }   \
        else { _Pragma("unroll") for (int m = 0; m < 4; ++m) _Pragma("unroll") for (int n = 0; n < 2; ++n) _Pragma("unroll") for (int k = 0; k < 2; ++k) \
            acc[ai][bj][m][n] = __builtin_amdgcn_mfma_f32_16x16x32_bf16(Bt[n][k], At[m][k], acc[ai][bj][m][n], 0, 0, 0); } \
        __builtin_amdgcn_s_setprio(0); } while (0)
#define PG8_WAIT_V(n) asm volatile("s_waitcnt vmcnt(" #n ")" ::: "memory")
#define PG8_WAIT_L(n) asm volatile("s_waitcnt lgkmcnt(" #n ")" ::: "memory")
#define PG8_BAR __builtin_amdgcn_s_barrier()
#define PG8_SCHED __builtin_amdgcn_sched_barrier(0)
    Unit cur, nxt; int ui = 0;
    if (!S.next(0, cur)) return;
    f32x4 acc[2][2][4][2];
#pragma unroll
    for (int a = 0; a < 2; ++a)
#pragma unroll
        for (int b = 0; b < 2; ++b)
#pragma unroll
            for (int m = 0; m < 4; ++m)
#pragma unroll
                for (int n = 0; n < 2; ++n) acc[a][b][m][n] = (f32x4){0.f, 0.f, 0.f, 0.f};
    bf16x8 At[4][2], B0[2][2], B1[2][2];
    i32x8 At8[4], B08[2], B18[2];
    const char* cA = (const char*)g.A + (size_t)cur.pm * tstep; const char* cB = (const char*)g.Bt + (size_t)cur.pn * tstep;
    S.a_ready(cur);
    if constexpr (SP2) {
        PG8_STAGE(PG8_SB(0, 0), cB, voffB); PG8_STAGE(PG8_SB(0, 1), cB + hstep, voffB); PG8_STAGE(PG8_SA(0, 0), cA, voffA); PG8_STAGE(PG8_SA(0, 1), cA + hstep, voffA);
        if (wr == 1) PG8_BAR;
        PG8_WAIT_V(2); PG8_BAR;
        PG8_STAGE(PG8_SB(1, 0), cB + kstep, voffB); PG8_STAGE(PG8_SA(1, 0), cA + kstep, voffA); PG8_STAGE(PG8_SB(1, 1), cB + hstep + kstep, voffB);
        PG8_WAIT_V(6); PG8_BAR;
    } else {
        PG8_STAGE(PG8_SB(0, 0), cB, voffB); PG8_STAGE(PG8_SA(0, 0), cA, voffA); PG8_STAGE(PG8_SB(0, 1), cB + hstep, voffB); PG8_STAGE(PG8_SA(0, 1), cA + hstep, voffA);
        if (wr == 1) PG8_BAR;
        PG8_WAIT_V(4); PG8_BAR;
        PG8_STAGE(PG8_SB(1, 0), cB + kstep, voffB); PG8_STAGE(PG8_SA(1, 0), cA + kstep, voffA); PG8_STAGE(PG8_SB(1, 1), cB + hstep + kstep, voffB);
        PG8_WAIT_V(6); PG8_BAR;
    }
    for (;;) {
        const bool has_next = S.next(ui + 1, nxt);
        const char* nA = has_next ? (const char*)g.A + (size_t)nxt.pm * tstep : cA; const char* nB = has_next ? (const char*)g.Bt + (size_t)nxt.pn * tstep : cB;
        for (int t = 0; t < nt; t += 2) {
            const bool last = (t == nt - 2);
            const char* a1 = cA + (size_t)(t + 1) * kstep;
            const char* a2 = last ? nA : cA + (size_t)(t + 2) * kstep; const char* b2 = last ? nB : cB + (size_t)(t + 2) * kstep;
            const char* a3 = a2 + kstep; const char* b3 = b2 + kstep;
            if (last && has_next) S.a_ready(nxt);
            if constexpr (SP2) {
            PG8_LDB(B0, 0, 0); PG8_LDB(B1, 0, 1); PG8_SCHED; PG8_LDA(At, 0, 0); PG8_STAGE(PG8_SA(1, 1), a1 + hstep, voffA);
            PG8_WAIT_V(8); PG8_WAIT_L(0); PG8_BAR; PG8_MMA(0, 0, At, B0); PG8_MMA(0, 1, At, B1); PG8_BAR; PG8_SCHED;
            PG8_LDA(At, 0, 1); PG8_STAGE(PG8_SB(0, 0), b2, voffB); PG8_STAGE(PG8_SB(0, 1), b2 + hstep, voffB); PG8_STAGE(PG8_SA(0, 0), a2, voffA);
            PG8_WAIT_V(8); PG8_WAIT_L(0); PG8_BAR; PG8_MMA(1, 0, At, B0); PG8_MMA(1, 1, At, B1); PG8_BAR; PG8_SCHED;
            PG8_LDB(B0, 1, 0); PG8_LDB(B1, 1, 1); PG8_SCHED; PG8_LDA(At, 1, 0); PG8_STAGE(PG8_SA(0, 1), a2 + hstep, voffA);
            PG8_WAIT_V(8); PG8_WAIT_L(0); PG8_BAR; PG8_MMA(0, 0, At, B0); PG8_MMA(0, 1, At, B1); PG8_BAR; PG8_SCHED;
            PG8_LDA(At, 1, 1); PG8_STAGE(PG8_SB(1, 0), b3, voffB); PG8_STAGE(PG8_SB(1, 1), b3 + hstep, voffB); PG8_STAGE(PG8_SA(1, 0), a3, voffA);
            PG8_WAIT_V(8); PG8_WAIT_L(0); PG8_BAR; PG8_MMA(1, 0, At, B0); PG8_MMA(1, 1, At, B1); PG8_BAR; PG8_SCHED;
            } else {
            PG8_LDB(B0, 0, 0); PG8_SCHED; PG8_LDA(At, 0, 0); PG8_STAGE(PG8_SA(1, 1), a1 + hstep, voffA);
            PG8_WAIT_L(8); PG8_BAR; PG8_WAIT_L(0); PG8_MMA(0, 0, At, B0); PG8_BAR; PG8_SCHED;
            PG8_LDB(B1, 0, 1); PG8_STAGE(PG8_SB(0, 0), b2, voffB);
            PG8_BAR; PG8_WAIT_L(0); PG8_MMA(0, 1, At, B1); PG8_BAR;
            PG8_LDA(At, 0, 1); PG8_STAGE(PG8_SA(0, 0), a2, voffA);
            PG8_BAR; PG8_WAIT_L(0); PG8_MMA(1, 0, At, B0); PG8_BAR; PG8_SCHED;
            PG8_STAGE(PG8_SB(0, 1), b2 + hstep, voffB);
            PG8_WAIT_V(6); PG8_BAR; PG8_MMA(1, 1, At, B1); PG8_BAR;
            PG8_LDB(B0, 1, 0); PG8_SCHED; PG8_LDA(At, 1, 0); PG8_STAGE(PG8_SA(0, 1), a2 + hstep, voffA);
            PG8_WAIT_L(8); PG8_BAR; PG8_WAIT_L(0); PG8_MMA(0, 0, At, B0); PG8_BAR; PG8_SCHED;
            PG8_LDB(B1, 1, 1); PG8_STAGE(PG8_SB(1, 0), b3, voffB);
            PG8_BAR; PG8_WAIT_L(0); PG8_MMA(0, 1, At, B1); PG8_BAR;
            PG8_LDA(At, 1, 1); PG8_STAGE(PG8_SA(1, 0), a3, voffA);
            PG8_BAR; PG8_WAIT_L(0); PG8_MMA(1, 0, At, B0); PG8_BAR; PG8_SCHED;
            PG8_STAGE(PG8_SB(1, 1), b3 + hstep, voffB);
            PG8_WAIT_V(6); PG8_BAR; PG8_MMA(1, 1, At, B1); PG8_BAR;
            }
        }
        if constexpr (ALIGN_EPI) { if (wr == 0) PG8_BAR; }
        if constexpr (FP8) { asm volatile("s_nop 15\n\ts_nop 15" ::: "memory"); }
        if constexpr (!Epi::AFTER_DRAIN) { E(acc, cur, wr, wc, fr, fq); S.done(cur); }
        if (!has_next) break;
#pragma unroll
        for (int a = 0; a < 2; ++a)
#pragma unroll
            for (int b = 0; b < 2; ++b)
#pragma unroll
                for (int m = 0; m < 4; ++m)
#pragma unroll
                    for (int n = 0; n < 2; ++n) acc[a][b][m][n] = (f32x4){0.f, 0.f, 0.f, 0.f};
        cur = nxt; cA = nA; cB = nB; ++ui;
        if constexpr (ALIGN_EPI) { if (wr == 1) PG8_BAR; }
    }
    PG8_WAIT_V(0);
    if constexpr (!ALIGN_EPI) { if (wr == 0) PG8_BAR; }
    PG8_BAR;
    if constexpr (Epi::AFTER_DRAIN) { E.fused(acc, cur, wr, wc, fr, fq, lds, wid, lane); S.done(cur); }
#undef PG8_SA
#undef PG8_SB
#undef PG8_STAGE
#undef PG8_LD8
#undef PG8_LDA
#undef PG8_LDB
#undef PG8_MMA
#undef PG8_WAIT_V
#undef PG8_WAIT_L
#undef PG8_BAR
#undef PG8_SCHED
}
}

constexpr int BATCH = 16, SEQ = 4096, D = 1024, T = BATCH * SEQ;
constexpr int AW = 512, NH = 8, HD = 64, GWID = 512, INW = 2560;
constexpr int NKEYS = 128, NEXP = 16384, PH = 8, TOPK = 16, NSEL = PH * TOPK;
constexpr float EPS = 1e-6f;
constexpr float QSCALE = 0.125f * 1.4426950408889634f;
constexpr int NWAVES = 8, NTHR = 512;

constexpr size_t MiB = 1u << 20;
constexpr size_t WS_CTL = 0, CTL_ZERO_BYTES = 1 * MiB;
constexpr size_t WS_WIN = 2 * MiB;
constexpr size_t WS_WOUT = 8 * MiB;
constexpr size_t WS_WQK = 10 * MiB;
constexpr size_t WS_WSP = 14 * MiB;
constexpr size_t WS_PART = 15 * MiB;
constexpr size_t WS_EU = 20 * MiB;
constexpr size_t WS_EV = 52 * MiB;
constexpr size_t WS_SU = 36 * MiB, WS_SV = 37 * MiB;
constexpr size_t WS_HN = 84 * MiB;
constexpr size_t WS_X1B = 212 * MiB;
constexpr size_t WS_Q = 340 * MiB, WS_K = 404 * MiB, WS_V = 468 * MiB, WS_GU = 532 * MiB, WS_GV = 596 * MiB;
constexpr size_t WS_PO = 660 * MiB;
constexpr size_t WS_LSE = 852 * MiB;
constexpr size_t WS_SC = 340 * MiB;
constexpr size_t WS_IDX = 860 * MiB;
constexpr size_t WS_PACT = 340 * MiB;
constexpr size_t WS_COEF = 924 * MiB;
constexpr size_t WS_CS = 940 * MiB;
constexpr size_t WS_WQK8 = 1010 * MiB;
constexpr size_t WS_CSC = 1012 * MiB;
constexpr size_t WS_RN = 941 * MiB;
constexpr size_t WS_GATE = 892 * MiB;
constexpr size_t WS_XF8 = 944 * MiB;
constexpr size_t WS_END = 1013 * MiB;
constexpr int NSLICE = 4, SLW = D / NSLICE;
constexpr int CW_BAR = 4096;

constexpr int LDS_BYTES = 163840 - 2048;
constexpr int MISC_OFF = 160 * 1024 - 2048 - 256;

#define GAS __attribute__((address_space(1)))
#define LAS __attribute__((address_space(3)))
typedef unsigned short bf16;
typedef unsigned v4u __attribute__((ext_vector_type(4)));
typedef unsigned v2u __attribute__((ext_vector_type(2)));
typedef float f32x4 __attribute__((ext_vector_type(4)));
typedef float f32x16 __attribute__((ext_vector_type(16)));
typedef short bf16x8 __attribute__((ext_vector_type(8)));
typedef short s16x4 __attribute__((ext_vector_type(4)));
typedef short v4i16_t __attribute__((ext_vector_type(4)));
typedef __bf16 bf16x2_t __attribute__((ext_vector_type(2)));

typedef float f32x2_t __attribute__((ext_vector_type(2)));
__device__ __forceinline__ unsigned pk2(float lo, float hi) { const f32x2_t v = {lo, hi}; const bf16x2_t b = __builtin_convertvector(v, bf16x2_t); return __builtin_bit_cast(unsigned, b); }
__device__ __forceinline__ unsigned f2bf(float f) { return pk2(f, f) & 0xffffu; }
__device__ __forceinline__ float bflo(unsigned u) { return __uint_as_float(u << 16); }
__device__ __forceinline__ float bfhi(unsigned u) { return __uint_as_float(u & 0xffff0000u); }
#define DPPV(v, ctrl) __builtin_bit_cast(float, __builtin_amdgcn_update_dpp(0, __builtin_bit_cast(int, (v)), (ctrl), 0xF, 0xF, true))
__device__ __forceinline__ void swap16(float& a, float& b) { const v2u s = __builtin_amdgcn_permlane16_swap(__float_as_uint(a), __float_as_uint(b), false, false); const unsigned x = s.x, y = s.y; a = __uint_as_float(x); b = __uint_as_float(y); }
__device__ __forceinline__ void swap32(float& a, float& b) { const v2u s = __builtin_amdgcn_permlane32_swap(__float_as_uint(a), __float_as_uint(b), false, false); const unsigned x = s.x, y = s.y; a = __uint_as_float(x); b = __uint_as_float(y); }
__device__ __forceinline__ float sum_x16(float v) { float a = v, b = v; swap16(a, b); return a + b; }
__device__ __forceinline__ float sum_x32(float v) { float a = v, b = v; swap32(a, b); return a + b; }
__device__ __forceinline__ float max_x16(float v) { float a = v, b = v; swap16(a, b); return fmaxf(a, b); }
__device__ __forceinline__ float max_x32(float v) { float a = v, b = v; swap32(a, b); return fmaxf(a, b); }
__device__ __forceinline__ float row_sum16(float v) { float a = v; a += DPPV(a, 0xB1); a += DPPV(a, 0x4E); a += DPPV(a, 0x141); a += DPPV(a, 0x140); return a; }
__device__ __forceinline__ float row_max16(float v) { float a = v; a = fmaxf(a, DPPV(a, 0xB1)); a = fmaxf(a, DPPV(a, 0x4E)); a = fmaxf(a, DPPV(a, 0x141)); a = fmaxf(a, DPPV(a, 0x140)); return a; }
__device__ __forceinline__ float wave_sum(float v) { return sum_x32(sum_x16(row_sum16(v))); }
__device__ __forceinline__ float wave_max(float v) { return max_x32(max_x16(row_max16(v))); }
__device__ __forceinline__ int crow(int r, int hi) { return (r & 3) + 8 * (r >> 2) + 4 * hi; }
__device__ __forceinline__ float gelu_exact(float v) { return 0.5f * v * (1.0f + erff(v * 0.70710678118654752f)); }

#define CE16(l, a, b) { const float hi_ = fmaxf(l[a], l[b]), lo_ = fminf(l[a], l[b]); l[a] = hi_; l[b] = lo_; }
#define SORT16_DESC(l) do { CE16(l,0,1) CE16(l,2,3) CE16(l,0,2) CE16(l,1,3) CE16(l,1,2) CE16(l,4,5) CE16(l,6,7) CE16(l,4,6) CE16(l,5,7) CE16(l,5,6) CE16(l,0,4) CE16(l,2,6) CE16(l,2,4) CE16(l,1,5) CE16(l,3,7) CE16(l,3,5) CE16(l,1,2) CE16(l,3,4) CE16(l,5,6) CE16(l,8,9) CE16(l,10,11) CE16(l,8,10) CE16(l,9,11) CE16(l,9,10) CE16(l,12,13) CE16(l,14,15) CE16(l,12,14) CE16(l,13,15) CE16(l,13,14) CE16(l,8,12) CE16(l,10,14) CE16(l,10,12) CE16(l,9,13) CE16(l,11,15) CE16(l,11,13) CE16(l,9,10) CE16(l,11,12) CE16(l,13,14) CE16(l,0,8) CE16(l,4,12) CE16(l,4,8) CE16(l,2,10) CE16(l,6,14) CE16(l,6,10) CE16(l,2,4) CE16(l,6,8) CE16(l,10,12) CE16(l,1,9) CE16(l,5,13) CE16(l,5,9) CE16(l,3,11) CE16(l,7,15) CE16(l,7,11) CE16(l,3,5) CE16(l,7,9) CE16(l,11,13) CE16(l,1,2) CE16(l,3,4) CE16(l,5,6) CE16(l,7,8) CE16(l,9,10) CE16(l,11,12) CE16(l,13,14) } while (0)
#define BITONIC16_DESC(l) do { _Pragma("unroll") for (int d_ = 8; d_ >= 1; d_ >>= 1) _Pragma("unroll") for (int i_ = 0; i_ < 16; ++i_) if ((i_ & d_) == 0) { const float hi_ = fmaxf(l[i_], l[i_ + d_]), lo_ = fminf(l[i_], l[i_ + d_]); l[i_] = hi_; l[i_ + d_] = lo_; } } while (0)
#define MERGE16_REG(l, o) do { _Pragma("unroll") for (int i_ = 0; i_ < 16; ++i_) l[i_] = fmaxf(l[i_], o[15 - i_]); BITONIC16_DESC(l); } while (0)
#define MERGE16_XOR(l, mask) do { float o_[16]; _Pragma("unroll") for (int i_ = 0; i_ < 16; ++i_) o_[i_] = __shfl_xor(l[i_], (mask)); MERGE16_REG(l, o_); } while (0)

struct Ptrs {
    const float *x, *mix_g, *w_in, *q_g, *k_g, *vg_g, *w_sp, *b_sp, *ao_g, *go_g, *w_out, *ffn_g, *w_query, *keys_a, *keys_b, *exp_u, *exp_v;
    float* out; unsigned char* ws;
};
struct Args { Ptrs p; int ph_lo, ph_hi, probe, pad; };

__device__ __forceinline__ void p0_transpose_item(const float* W, int K, int N, bf16* WT, bool perm, LAS float* scr, int item, int lane) {
    const int nblk = N / 32, kb = item / nblk, nb = item % nblk, k0 = 64 * kb, n0 = 32 * nb;
    int pn0 = n0;
    if (perm) { const int tile = n0 >> 8, lb = (n0 & 255) >> 5; pn0 = (tile << 8) + 32 * (4 * (lb & 1) + (lb >> 1)); }
#pragma unroll 8
    for (int i = 0; i < 32; ++i) { const int kk = 2 * i + (lane >> 5); scr[kk * 33 + (lane & 31)] = W[(size_t)(k0 + kk) * N + n0 + (lane & 31)]; }
    asm volatile("s_waitcnt lgkmcnt(0)" ::: "memory");
    const int c = lane & 7;
#pragma unroll
    for (int j = 0; j < 4; ++j) { const int n = (lane >> 3) + 8 * j; const LAS float* s = scr + (8 * c) * 33 + n;
        v4u o; o.x = pk2(s[0 * 33], s[1 * 33]); o.y = pk2(s[2 * 33], s[3 * 33]); o.z = pk2(s[4 * 33], s[5 * 33]); o.w = pk2(s[6 * 33], s[7 * 33]);
        *(v4u*)(WT + (size_t)(pn0 + n) * K + k0 + 8 * c) = o; }
    asm volatile("s_waitcnt lgkmcnt(0)" ::: "memory");
}

__device__ __forceinline__ void p0_fold_item(const Ptrs& p, LAS unsigned char* lds, int it, int tid) {
    const int h = it >> 5, half = (it >> 4) & 1, d0 = (it & 15) * 64;
    LAS float* A = (LAS float*)lds;
    LAS float* Kt = (LAS float*)(lds + 33280);
    const float* wq = p.w_query + h * 256 + half * 128;
    for (int i = tid; i < 8192; i += NTHR) { const int dd = i >> 7, c = i & 127; A[dd * 129 + c] = wq[(size_t)(d0 + dd) * 2048 + c]; }
    const float* keys = half ? p.keys_b : p.keys_a;
    for (int i = tid; i < 16384; i += NTHR) Kt[i] = keys[i];
    __syncthreads();
    const int dd = tid & 63, kg = tid >> 6;
    float acc[16];
#pragma unroll
    for (int kk = 0; kk < 16; ++kk) acc[kk] = 0.f;
    for (int c = 0; c < 128; ++c) { const float a = A[dd * 129 + c];
#pragma unroll
        for (int kk = 0; kk < 16; ++kk) acc[kk] += a * Kt[(kg * 16 + kk) * 128 + c]; }
    const float g = p.ffn_g[d0 + dd];
    bf16* WQK = (bf16*)(p.ws + WS_WQK);
#pragma unroll
    for (int kk = 0; kk < 16; ++kk) { const int key = kg * 16 + kk, wcq = 2 * half + (key >> 6), kidx = key & 63;
        const int prow = 128 * (kidx >> 5) + 32 * wcq + 16 * ((kidx >> 4) & 1) + 4 * ((kidx >> 2) & 3) + (kidx & 3);
        WQK[(size_t)(h * 256 + prow) * 1024 + d0 + dd] = (bf16)f2bf(acc[kk] * g); }
    __syncthreads();
}

__device__ __forceinline__ void p0_prologue(const Ptrs& p, LAS unsigned char* lds, int tid, int lane, int wave, int vcu, int G) {
    for (int it = blockIdx.x; it < 256; it += G) p0_fold_item(p, lds, it, tid);
    __syncthreads();
    const int gw = vcu * NWAVES + wave, NGW = G * NWAVES;
    LAS float* scr = (LAS float*)(lds + wave * 16384);
    constexpr int I_IN = (D / 64) * (INW / 32), I_OUT = (D / 64) * (D / 32);
    bf16* WIN = (bf16*)(p.ws + WS_WIN); bf16* WOUT = (bf16*)(p.ws + WS_WOUT);
    for (int it = gw; it < I_IN + I_OUT; it += NGW) {
        if (it < I_IN) p0_transpose_item(p.w_in, D, INW, WIN, true, scr, it, lane);
        else p0_transpose_item(p.w_out, D, D, WOUT, false, scr, it - I_IN, lane);
    }
    const int gt = gw * 64 + lane, NGT = NGW * 64;
    {
        unsigned char* EU4 = p.ws + WS_EU; unsigned char* EV4 = p.ws + WS_EV; float* SU = (float*)(p.ws + WS_SU); float* SV = (float*)(p.ws + WS_SV);
        f32x4 gf[4];
#pragma unroll
        for (int j = 0; j < 4; ++j) gf[j] = *(const f32x4*)(p.ffn_g + lane * 16 + 4 * j);
        f32x4 nv[4];
        if (gw < 2 * NEXP) { const float* src0 = ((gw & 1) ? p.exp_v : p.exp_u) + (size_t)(gw >> 1) * D + lane * 16;
#pragma unroll
            for (int j = 0; j < 4; ++j) nv[j] = *(const f32x4*)(src0 + 4 * j); }
        for (int r = gw; r < 2 * NEXP; r += NGW) {
            const int e = r >> 1, tb = r & 1;
            f32x4 v[4]; float ss = 0.f;
#pragma unroll
            for (int j = 0; j < 4; ++j) v[j] = nv[j];
            { const int rn = (r + NGW < 2 * NEXP) ? r + NGW : r; const float* srcn = ((rn & 1) ? p.exp_v : p.exp_u) + (size_t)(rn >> 1) * D + lane * 16;
#pragma unroll
              for (int j = 0; j < 4; ++j) nv[j] = *(const f32x4*)(srcn + 4 * j); }
#pragma unroll
            for (int j = 0; j < 4; ++j) { if (!tb) v[j] = v[j] * gf[j];
                ss += (v[j][0] * v[j][0] + v[j][1] * v[j][1]) + (v[j][2] * v[j][2] + v[j][3] * v[j][3]); }
            ss = wave_sum(ss);
            const float sc = (ss > 0.f) ? 0.5f * sqrtf(ss * (1.f / D)) : 1.f, inv = 1.f / sc;
            unsigned wlo = 0u, whi = 0u;
#pragma unroll
            for (int j = 0; j < 4; ++j)
#pragma unroll
                for (int i = 0; i < 4; ++i) { const float y = v[j][i] * inv, a = fabsf(y);
                    const unsigned code = (unsigned)(a > 0.25f) + (unsigned)(a > 0.75f) + (unsigned)(a > 1.25f) + (unsigned)(a > 1.75f) + (unsigned)(a > 2.5f) + (unsigned)(a > 3.5f) + (unsigned)(a > 5.0f) + ((y < 0.f) ? 8u : 0u);
                    const int n = 4 * j + i; if (n < 8) wlo |= code << (4 * n); else whi |= code << (4 * (n - 8)); }
            unsigned char* dst = (tb ? EV4 : EU4) + ((size_t)(lane >> 4) * NEXP + e) * 128 + (lane & 15) * 8;
            if (tb) {
                LAS unsigned* cs4 = (LAS unsigned*)scr;
                cs4[lane * 2] = wlo; cs4[lane * 2 + 1] = whi;
                asm volatile("s_waitcnt lgkmcnt(0)" ::: "memory");
                const int q = lane & 15, sl = lane >> 4; unsigned tlo = 0u, thi = 0u;
#pragma unroll
                for (int n = 0; n < 16; ++n) { const int m = 4 * (n & 3);
                    const unsigned w = cs4[(sl * 16 + 4 * (q & 3) + (n >> 2)) * 2 + (m >> 3)]; const unsigned code = (w >> (4 * ((m & 7) + (q >> 2)))) & 0xfu;
                    if (n < 8) tlo |= code << (4 * n); else thi |= code << (4 * (n - 8)); }
                asm volatile("s_waitcnt lgkmcnt(0)" ::: "memory");
                wlo = tlo; whi = thi;
            }
            *(v2u*)dst = (v2u){wlo, whi};
            if (lane == 0) (tb ? SV : SU)[e] = sc;
        }
    }
    bf16* WSP = (bf16*)(p.ws + WS_WSP);
    for (int i = gt; i < 4 * 128 * 128; i += NGT) {
        const int pj = i & 127, ii = (i >> 7) & 127, g = i >> 14;
        const int ks = pj >> 4, hi = (pj >> 3) & 1, jj = pj & 7, j = 16 * ks + 4 * hi + (jj & 3) + 8 * (jj >> 2);
        WSP[i] = (bf16)((j <= ii) ? f2bf(p.w_sp[(g * 128 + ii) * 128 + j]) : 0u);
    }
    bf16* HN = (bf16*)(p.ws + WS_HN);
    {
        f32x4 g4[4];
#pragma unroll
        for (int j = 0; j < 4; ++j) g4[j] = *((const f32x4*)p.mix_g + lane + 64 * j);
        f32x4 nx[4];
        if (gw < T) {
#pragma unroll
            for (int j = 0; j < 4; ++j) nx[j] = ((const f32x4*)(p.x + (size_t)gw * D) + lane)[64 * j]; }
        for (int m = gw; m < T; m += NGW) {
            f32x4 v[4]; float s = 0.f;
#pragma unroll
            for (int j = 0; j < 4; ++j) v[j] = nx[j];
            const int mn = (m + NGW < T) ? m + NGW : m;
#pragma unroll
            for (int j = 0; j < 4; ++j) nx[j] = ((const f32x4*)(p.x + (size_t)mn * D) + lane)[64 * j];
#pragma unroll
            for (int j = 0; j < 4; ++j) s += (v[j].x * v[j].x + v[j].y * v[j].y) + (v[j].z * v[j].z + v[j].w * v[j].w);
            const float r = rsqrtf(wave_sum(s) * (1.f / D) + EPS);
            v2u* o8 = (v2u*)(HN + (size_t)m * D) + lane;
#pragma unroll
            for (int j = 0; j < 4; ++j) { const f32x4 g = g4[j]; v2u o; o.x = pk2(v[j].x * r * g.x, v[j].y * r * g.y); o.y = pk2(v[j].z * r * g.z, v[j].w * r * g.w); o8[64 * j] = o; }
        }
    }
}

struct EpiProj {
    static constexpr bool PERM = true, AFTER_DRAIN = false;
    bf16 *Q, *K, *V, *GU, *GV; const float *qg, *kg;
    __device__ __forceinline__ void operator()(const pg8::f32x4 (&acc)[2][2][4][2], const pg8::Unit& u, int wr, int wc, int fr, int fq) const {
        const int type = u.pn >> 1;
        bf16* base = type == 0 ? Q : type == 1 ? K : type == 2 ? V : type == 3 ? GU : GV;
        const int ct = (u.pn & 1) * 256 + wc * 64 + 8 * fq;
        const int row0 = u.pm * 256 + wr * 64 + fr;
        if (type <= 1) {
            const float* g = type == 0 ? qg : kg; const float sc = type == 0 ? QSCALE : 1.f;
            f32x4 gv[2][2];
#pragma unroll
            for (int bj = 0; bj < 2; ++bj)
#pragma unroll
                for (int n = 0; n < 2; ++n) gv[bj][n] = *(const f32x4*)(g + 32 * bj + 8 * fq + 4 * n);
#pragma unroll
            for (int ai = 0; ai < 2; ++ai)
#pragma unroll
                for (int m = 0; m < 4; ++m) {
                    float ss = 0.f;
#pragma unroll
                    for (int bj = 0; bj < 2; ++bj)
#pragma unroll
                        for (int n = 0; n < 2; ++n) { const f32x4 v = acc[ai][bj][m][n]; ss += (v[0] * v[0] + v[1] * v[1]) + (v[2] * v[2] + v[3] * v[3]); }
                    ss = sum_x32(sum_x16(ss));
                    const float r = rsqrtf(ss * (1.f / 64.f) + EPS) * sc;
                    bf16* rowp = base + (size_t)(row0 + ai * 128 + m * 16) * 512 + ct;
#pragma unroll
                    for (int bj = 0; bj < 2; ++bj) { const f32x4 v0 = acc[ai][bj][m][0] * gv[bj][0] * r, v1 = acc[ai][bj][m][1] * gv[bj][1] * r;
                        v4u w; w.x = pk2(v0[0], v0[1]); w.y = pk2(v0[2], v0[3]); w.z = pk2(v1[0], v1[1]); w.w = pk2(v1[2], v1[3]);
                        *(v4u*)(rowp + 32 * bj) = w; }
                }
        } else {
#pragma unroll
            for (int ai = 0; ai < 2; ++ai)
#pragma unroll
                for (int m = 0; m < 4; ++m) {
                    bf16* rowp = base + (size_t)(row0 + ai * 128 + m * 16) * 512 + ct;
#pragma unroll
                    for (int bj = 0; bj < 2; ++bj) { f32x4 v0 = acc[ai][bj][m][0], v1 = acc[ai][bj][m][1];
                        if (type >= 3) { pg8::f32x2 a = pg8::gelu_pk((pg8::f32x2){v0[0], v0[1]}), b = pg8::gelu_pk((pg8::f32x2){v0[2], v0[3]}), c = pg8::gelu_pk((pg8::f32x2){v1[0], v1[1]}), d = pg8::gelu_pk((pg8::f32x2){v1[2], v1[3]});
                            v0 = (f32x4){a.x, a.y, b.x, b.y}; v1 = (f32x4){c.x, c.y, d.x, d.y}; }
                        v4u w; w.x = pk2(v0[0], v0[1]); w.y = pk2(v0[2], v0[3]); w.z = pk2(v1[0], v1[1]); w.w = pk2(v1[2], v1[3]);
                        *(v4u*)(rowp + 32 * bj) = w; }
                }
        }
    }
};
struct EpiOut {
    static constexpr bool PERM = true, AFTER_DRAIN = false;
    const float* X; float* OUT; bf16* X1B; float* PART; unsigned char* XF8;
    __device__ __forceinline__ void operator()(const pg8::f32x4 (&acc)[2][2][4][2], const pg8::Unit& u, int wr, int wc, int fr, int fq) const {
        const int row0 = u.pm * 256 + wr * 64 + fr, col0 = u.pn * 256 + wc * 32 + 8 * fq;
#pragma unroll
        for (int ai = 0; ai < 2; ++ai) {
            f32x4 xv[4][2][2];
#pragma unroll
            for (int m = 0; m < 4; ++m)
#pragma unroll
                for (int bj = 0; bj < 2; ++bj)
#pragma unroll
                    for (int n = 0; n < 2; ++n) xv[m][bj][n] = *(const f32x4*)(X + (size_t)(row0 + ai * 128 + m * 16) * D + col0 + bj * 128 + n * 4);
#pragma unroll
            for (int m = 0; m < 4; ++m) {
                const int row = row0 + ai * 128 + m * 16; float ss = 0.f;
#pragma unroll
                for (int bj = 0; bj < 2; ++bj) { const size_t off = (size_t)row * D + col0 + bj * 128;
                    const f32x4 o0 = xv[m][bj][0] + acc[ai][bj][m][0], o1 = xv[m][bj][1] + acc[ai][bj][m][1];
                    ss += ((o0[0] * o0[0] + o0[1] * o0[1]) + (o0[2] * o0[2] + o0[3] * o0[3])) + ((o1[0] * o1[0] + o1[1] * o1[1]) + (o1[2] * o1[2] + o1[3] * o1[3]));
                    v4u w; w.x = pk2(o0[0], o0[1]); w.y = pk2(o0[2], o0[3]); w.z = pk2(o1[0], o1[1]); w.w = pk2(o1[2], o1[3]); *(v4u*)(X1B + off) = w;
                    int lo = 0, hi = 0;
                    lo = __builtin_amdgcn_cvt_pk_fp8_f32(o0[0] * 8.f, o0[1] * 8.f, lo, false); lo = __builtin_amdgcn_cvt_pk_fp8_f32(o0[2] * 8.f, o0[3] * 8.f, lo, true);
                    hi = __builtin_amdgcn_cvt_pk_fp8_f32(o1[0] * 8.f, o1[1] * 8.f, hi, false); hi = __builtin_amdgcn_cvt_pk_fp8_f32(o1[2] * 8.f, o1[3] * 8.f, hi, true);
                    *(v2u*)(XF8 + off) = (v2u){(unsigned)lo, (unsigned)hi}; }
                ss = sum_x32(sum_x16(ss));
                if (fq == 0) PART[(size_t)row * 16 + u.pn * 4 + wc] = ss;
            }
        }
    }
};
struct EpiF32 {
    static constexpr bool PERM = false, AFTER_DRAIN = false;
    float* C; int ldc;
    __device__ __forceinline__ void operator()(const pg8::f32x4 (&acc)[2][2][4][2], const pg8::Unit& u, int wr, int wc, int fr, int fq) const {
        const int row0 = u.pm * 256 + wr * 64 + fr, col0 = u.pn * 256 + wc * 32 + 4 * fq;
#pragma unroll
        for (int ai = 0; ai < 2; ++ai)
#pragma unroll
            for (int m = 0; m < 4; ++m) { float* rowp = C + (size_t)(row0 + ai * 128 + m * 16) * ldc + col0;
#pragma unroll
                for (int bj = 0; bj < 2; ++bj)
#pragma unroll
                    for (int n = 0; n < 2; ++n) *(f32x4*)(rowp + bj * 128 + n * 16) = acc[ai][bj][m][n]; }
    }
};

struct EpiTopk {
    static constexpr bool PERM = false, AFTER_DRAIN = false;
    float* TOPW;
    __device__ __forceinline__ void operator()(const pg8::f32x4 (&acc)[2][2][4][2], const pg8::Unit& u, int wr, int wc, int fr, int fq) const {
        const int row0 = u.pm * 256 + wr * 64 + fr; unsigned kb = 64u * (wc & 1) + 4u * fq;
        asm volatile("" : "+v"(kb));
#pragma unroll
        for (int ai = 0; ai < 2; ++ai) {
            float x[16], y[16], r[16];
#define TOPK_PACK(dst, m) do { _Pragma("unroll") for (int bj = 0; bj < 2; ++bj) _Pragma("unroll") for (int n = 0; n < 2; ++n) _Pragma("unroll") for (int i = 0; i < 4; ++i) \
                dst[8 * bj + 4 * n + i] = __uint_as_float(((__float_as_uint(acc[ai][bj][m][n][i]) & ~0x7fu) | kb) | (32u * bj + 16u * n + i));   \
                SORT16_DESC(dst); } while (0)
            TOPK_PACK(x, 0); TOPK_PACK(r, 1);
#pragma unroll
            for (int i = 0; i < 16; ++i) swap16(x[i], r[i]);
            MERGE16_REG(x, r);
            __builtin_amdgcn_sched_barrier(0);
            TOPK_PACK(y, 2); TOPK_PACK(r, 3);
#pragma unroll
            for (int i = 0; i < 16; ++i) swap16(y[i], r[i]);
            MERGE16_REG(y, r);
            __builtin_amdgcn_sched_barrier(0);
#pragma unroll
            for (int i = 0; i < 16; ++i) { r[i] = y[i]; swap32(x[i], r[i]); }
            MERGE16_REG(x, r);
#undef TOPK_PACK
            f32x4* o = (f32x4*)(TOPW + (((size_t)(row0 + ai * 128 + fq * 16) * 8 + u.pn) * 4 + wc) * 16);
            o[0] = (f32x4){x[0], x[1], x[2], x[3]}; o[1] = (f32x4){x[4], x[5], x[6], x[7]}; o[2] = (f32x4){x[8], x[9], x[10], x[11]}; o[3] = (f32x4){x[12], x[13], x[14], x[15]};
        }
    }
};

constexpr int A_K = 0, A_V = 49152, A_ST = 98304, A_STW = 32 * 144;
struct AttnU { int h, pat, dl, m0, jlo; size_t rowbase; };
__device__ __forceinline__ AttnU attn_decode(int unit) {
    AttnU u; const int bh = unit / 48, rem = unit % 48, k16 = rem & 15; u.pat = rem >> 4;
    const int b = bh >> 3, nb = 16 >> (2 * u.pat), r = k16 / nb, qb = k16 % nb;
    u.h = bh & 7; u.dl = 1 << (2 * u.pat); u.m0 = qb * 256; u.jlo = (qb == 0) ? 2 : 0; u.rowbase = (size_t)b * SEQ + r; return u;
}
__device__ __forceinline__ long attn_off(const AttnU& u, int m) { return (((long)u.rowbase + (long)m * u.dl) * 512 + u.h * 64) * 2; }
__device__ __forceinline__ void attn_dma_k(const Ptrs& p, LAS unsigned char* lds, const AttnU& u, int lane, int w) {
    const unsigned char* kb = p.ws + WS_K + attn_off(u, u.m0 - 128) + w * 16; const unsigned voff = (unsigned)(lane * u.dl) * 1024u;
#pragma unroll
    for (int j = 0; j < 6; ++j) if (j >= u.jlo)
        __builtin_amdgcn_global_load_lds((const unsigned*)(kb + (size_t)(j * 64 * u.dl) * 1024 + voff), (LAS unsigned*)(lds + A_K + j * 8192 + w * 1024), 16, 0, 0);
}
__device__ __forceinline__ void attn_dma_v(const Ptrs& p, LAS unsigned char* lds, const AttnU& u, int lane, int w) {
    const unsigned char* vb = p.ws + WS_V + attn_off(u, u.m0 - 128 + 16 * (w & 3)) + 64 * (w >> 2); const unsigned voff = (unsigned)((lane >> 2) * u.dl) * 1024u + (lane & 3) * 16u;
#pragma unroll
    for (int j = 0; j < 6; ++j) if (j >= u.jlo)
        __builtin_amdgcn_global_load_lds((const unsigned*)(vb + (size_t)(j * 64 * u.dl) * 1024 + voff), (LAS unsigned*)(lds + A_V + j * 8192 + w * 1024), 16, 0, 0);
}
__device__ __forceinline__ void attn_load_q(bf16x8 (&q)[4], const Ptrs& p, const AttnU& u, int lane, int w) {
    const unsigned char* qb = p.ws + WS_Q + attn_off(u, u.m0 + 32 * w); const unsigned voff = (unsigned)((lane & 31) * u.dl) * 1024u + (lane >> 5) * 16u;
#pragma unroll
    for (int d0 = 0; d0 < 4; ++d0) q[d0] = *(const bf16x8*)(qb + voff + d0 * 32);
}
#define ATT_BAR_VM() do { asm volatile("s_waitcnt vmcnt(0) lgkmcnt(0)" ::: "memory"); __builtin_amdgcn_s_barrier(); asm volatile("" ::: "memory"); } while (0)
#define ATT_BAR_LDS() do { asm volatile("s_waitcnt lgkmcnt(0)" ::: "memory"); __builtin_amdgcn_s_barrier(); asm volatile("" ::: "memory"); } while (0)
template <bool FIRST>
__device__ __forceinline__ void attn_pv_tile(f32x16 (&o)[2], const f32x16& zacc, const v4u (&pwi)[2], const LAS unsigned char* vb) {
#pragma unroll
    for (int ks = 0; ks < 2; ++ks) {
        const bf16x8 pa = __builtin_bit_cast(bf16x8, pwi[ks]);
#pragma unroll
        for (int d0 = 0; d0 < 2; ++d0) {
            const s16x4 lo = __builtin_bit_cast(s16x4, __builtin_amdgcn_ds_read_tr16_b64_v4i16((LAS v4i16_t*)(vb + d0 * 4096 + ks * 1024)));
            const s16x4 hh = __builtin_bit_cast(s16x4, __builtin_amdgcn_ds_read_tr16_b64_v4i16((LAS v4i16_t*)(vb + d0 * 4096 + ks * 1024 + 512)));
            const bf16x8 vf = (bf16x8){lo[0], lo[1], lo[2], lo[3], hh[0], hh[1], hh[2], hh[3]};
            if (FIRST && ks == 0) o[d0] = __builtin_amdgcn_mfma_f32_32x32x16_bf16(vf, pa, zacc, 0, 0, 0);
            else o[d0] = __builtin_amdgcn_mfma_f32_32x32x16_bf16(vf, pa, o[d0], 0, 0, 0);
        }
    }
}
__device__ __forceinline__ void attn_compute(const Ptrs& p, LAS unsigned char* lds, const AttnU& u, const AttnU& un, bool has_next, bf16x8 (&qr)[4], int lane, int w) {
    const int r32 = lane & 31, hi = lane >> 5, glo = 2 * u.jlo;
    const float NEGINF = -INFINITY;
    f32x16 zacc = {}; asm volatile("" : "+v"(zacc));
    f32x16 sc[5];
#pragma unroll
    for (int i = 0; i < 5; ++i) {
        const int g = w + i;
        f32x16 a;
        if (g >= glo) {
            const LAS unsigned char* kb = lds + A_K + (g >> 1) * 8192 + hi * 1024 + ((g & 1) * 32 + r32) * 16;
            a = __builtin_amdgcn_mfma_f32_32x32x16_bf16(*(const LAS bf16x8*)(kb), qr[0], zacc, 0, 0, 0);
#pragma unroll
            for (int d0 = 1; d0 < 4; ++d0) a = __builtin_amdgcn_mfma_f32_32x32x16_bf16(*(const LAS bf16x8*)(kb + d0 * 2048), qr[d0], a, 0, 0, 0);
            if (i == 0) {
#pragma unroll
                for (int rr = 0; rr < 16; ++rr) a[rr] = (crow(rr, hi) >= r32) ? a[rr] : NEGINF; }
            if (i == 4) {
#pragma unroll
                for (int rr = 0; rr < 16; ++rr) a[rr] = (crow(rr, hi) <= r32) ? a[rr] : NEGINF; }
        } else {
#pragma unroll
            for (int rr = 0; rr < 16; ++rr) a[rr] = NEGINF; }
        sc[i] = a;
    }
    ATT_BAR_LDS();
    if (has_next) { attn_dma_k(p, lds, un, lane, w); attn_load_q(qr, p, un, lane, w); }
    float mx = NEGINF;
#pragma unroll
    for (int i = 0; i < 5; ++i)
#pragma unroll
        for (int rr = 0; rr < 16; ++rr) mx = fmaxf(mx, sc[i][rr]);
    mx = max_x32(mx);
    const f32x2_t mx2 = {mx, mx};
    f32x2_t l2 = {0.f, 0.f};
    v4u pw[5][2];
#pragma unroll
    for (int i = 0; i < 5; ++i) {
        unsigned pk[8];
#pragma unroll
        for (int r2 = 0; r2 < 8; ++r2) { const f32x2_t d = (f32x2_t){sc[i][2 * r2], sc[i][2 * r2 + 1]} - mx2; const f32x2_t e = {__builtin_amdgcn_exp2f(d.x), __builtin_amdgcn_exp2f(d.y)}; l2 += e; pk[r2] = pk2(e.x, e.y); }
        pw[i][0] = (v4u){pk[0], pk[1], pk[2], pk[3]};
        pw[i][1] = (v4u){pk[4], pk[5], pk[6], pk[7]};
    }
    float l = l2.x + l2.y;
    l = sum_x32(l);
    f32x16 o[2];
    const int vlane = ((lane >> 4) & 1) * 32 + (lane & 3) * 8 + (4 * hi + ((lane & 15) >> 2)) * 64;
    { const int g = w + 4; attn_pv_tile<true>(o, zacc, pw[4], lds + A_V + (g >> 1) * 8192 + (g & 1) * 2048 + vlane); }
#pragma unroll
    for (int i = 0; i < 4; ++i) {
        const int g = w + i;
        if (g >= glo) attn_pv_tile<false>(o, zacc, pw[i], lds + A_V + (g >> 1) * 8192 + (g & 1) * 2048 + vlane);
    }
    ATT_BAR_LDS();
    if (has_next) attn_dma_v(p, lds, un, lane, w);
    const float rl = __builtin_amdgcn_rcpf(l);
    if (hi == 0) *(float*)(p.ws + WS_LSE + ((size_t)u.pat * T * 8 + (u.rowbase + (size_t)(u.m0 + 32 * w) * u.dl) * 8 + u.h) * 4 + (unsigned)(r32 * u.dl) * 32u) = mx + __builtin_amdgcn_logf(l);
    LAS unsigned char* stw = lds + A_ST + w * A_STW;
    LAS unsigned char* stg = stw + r32 * 144 + hi * 8;
#pragma unroll
    for (int d0 = 0; d0 < 2; ++d0)
#pragma unroll
        for (int q4 = 0; q4 < 4; ++q4)
            *(LAS v2u*)(stg + d0 * 64 + q4 * 16) = (v2u){pk2(o[d0][4 * q4] * rl, o[d0][4 * q4 + 1] * rl), pk2(o[d0][4 * q4 + 2] * rl, o[d0][4 * q4 + 3] * rl)};
    asm volatile("s_waitcnt lgkmcnt(0)" ::: "memory");
    unsigned char* pob = p.ws + WS_PO + (size_t)u.pat * T * 1024 + attn_off(u, u.m0 + 32 * w); const unsigned pvoff = (unsigned)((lane >> 3) * u.dl) * 1024u + (lane & 7) * 16u;
#pragma unroll
    for (int i = 0; i < 4; ++i) { const v4u v = *(const LAS v4u*)(stw + (i * 8 + (lane >> 3)) * 144 + (lane & 7) * 16);
        *(v4u*)(pob + (size_t)(i * 8 * u.dl) * 1024 + pvoff) = v; }
}
__device__ __forceinline__ void attn_phase(const Ptrs& p, LAS unsigned char* lds, int vcu, int G, int lane, int w) {
    const int NU = BATCH * NH * 48;
    if (vcu >= NU) return;
    AttnU u = attn_decode(vcu);
    bf16x8 qr[4];
    attn_dma_k(p, lds, u, lane, w); attn_dma_v(p, lds, u, lane, w); attn_load_q(qr, p, u, lane, w);
    for (int unit = vcu; unit < NU; unit += G) {
        const bool has_next = unit + G < NU;
        const AttnU un = attn_decode(has_next ? unit + G : unit);
        ATT_BAR_VM();
        attn_compute(p, lds, u, un, has_next, qr, lane, w);
        u = un;
    }
    ATT_BAR_VM();
}

__device__ __forceinline__ void gmlp_unit(const Ptrs& p, LAS unsigned char* lds, int unit, int tid, int lane, int w) {
    const size_t rowbase = (size_t)unit * 128;
    const bf16* GU = (const bf16*)(p.ws + WS_GU); const bf16* GV = (const bf16*)(p.ws + WS_GV); const bf16* WSP = (const bf16*)(p.ws + WS_WSP);
    bf16* MG = (bf16*)(p.ws + WS_HN);
    const int r32 = lane & 31, hi = lane >> 5;
    {
        const int g = lane >> 4; f32x4 ga = *(const f32x4*)(p.vg_g + g * 128 + (lane & 15) * 8), gb = *(const f32x4*)(p.vg_g + g * 128 + (lane & 15) * 8 + 4);
#pragma unroll 4
        for (int it = 0; it < 16; ++it) {
            const int j = it * 8 + w;
            const v4u raw = *(const v4u*)(GV + (rowbase + j) * 512 + lane * 8);
            float v[8] = {bflo(raw.x), bfhi(raw.x), bflo(raw.y), bfhi(raw.y), bflo(raw.z), bfhi(raw.z), bflo(raw.w), bfhi(raw.w)};
            float ss = 0.f;
#pragma unroll
            for (int i = 0; i < 8; ++i) ss += v[i] * v[i];
            ss = row_sum16(ss);
            const float rn = rsqrtf(ss * (1.f / 128.f) + EPS);
            v4u o; o.x = pk2(v[0] * rn * ga.x, v[1] * rn * ga.y); o.y = pk2(v[2] * rn * ga.z, v[3] * rn * ga.w); o.z = pk2(v[4] * rn * gb.x, v[5] * rn * gb.y); o.w = pk2(v[6] * rn * gb.z, v[7] * rn * gb.w);
            *(LAS v4u*)(lds + ((lane >> 2) * 8 + (j >> 4)) * 1024 + (j & 15) * 64 + (lane & 3) * 16) = o;
        }
    }
    __syncthreads();
    const int ib = w & 3, gp = w >> 2;
    f32x16 acc[8];
#pragma unroll
    for (int i = 0; i < 8; ++i) acc[i] = (f32x16){};
    const int vlane = ((lane >> 4) & 1) * 32 + (lane & 3) * 8 + (4 * hi + ((lane & 15) >> 2)) * 64;
#pragma unroll
    for (int g2 = 0; g2 < 2; ++g2) {
        const int g = 2 * gp + g2;
        for (int ks = 0; ks < 2 * ib + 2; ++ks) {
            const bf16x8 af = *(const bf16x8*)(WSP + (size_t)((g * 128 + 32 * ib + r32) * 128 + 16 * ks + 8 * hi));
#pragma unroll
            for (int ct = 0; ct < 4; ++ct) {
                const LAS unsigned char* vb = lds + ((g * 4 + ct) * 8 + ks) * 1024 + vlane;
                const s16x4 lo = __builtin_bit_cast(s16x4, __builtin_amdgcn_ds_read_tr16_b64_v4i16((LAS v4i16_t*)(vb)));
                const s16x4 hh = __builtin_bit_cast(s16x4, __builtin_amdgcn_ds_read_tr16_b64_v4i16((LAS v4i16_t*)(vb + 512)));
                const bf16x8 vf = (bf16x8){lo[0], lo[1], lo[2], lo[3], hh[0], hh[1], hh[2], hh[3]};
                acc[g2 * 4 + ct] = __builtin_amdgcn_mfma_f32_32x32x16_bf16(af, vf, acc[g2 * 4 + ct], 0, 0, 0);
            }
        }
    }
    __syncthreads();
#pragma unroll
    for (int g2 = 0; g2 < 2; ++g2) {
        const int g = 2 * gp + g2;
#pragma unroll
        for (int rr = 0; rr < 16; ++rr) {
            const int i = 32 * ib + crow(rr, hi); const float bias = p.b_sp[g * 128 + i];
#pragma unroll
            for (int ct = 0; ct < 4; ++ct) {
                const int c = g * 128 + ct * 32 + r32;
                *(LAS bf16*)(lds + (i * 512 + c) * 2) = (bf16)f2bf(acc[g2 * 4 + ct][rr] + bias);
            }
        }
    }
    __syncthreads();
    {
        const f32x4 ga = *(const f32x4*)(p.go_g + lane * 8), gb = *(const f32x4*)(p.go_g + lane * 8 + 4);
#pragma unroll 4
        for (int ii = 0; ii < 16; ++ii) {
            const int i = 16 * w + ii;
            const v4u raw = *(const LAS v4u*)(lds + (i * 512 + lane * 8) * 2);
            const v4u gur = *(const v4u*)(GU + (rowbase + i) * 512 + lane * 8);
            const unsigned z0 = raw.x, z1 = raw.y, z2 = raw.z, z3 = raw.w, u0 = gur.x, u1 = gur.y, u2 = gur.z, u3 = gur.w;
            float v[8] = {bflo(z0) * bflo(u0), bfhi(z0) * bfhi(u0), bflo(z1) * bflo(u1), bfhi(z1) * bfhi(u1), bflo(z2) * bflo(u2), bfhi(z2) * bfhi(u2), bflo(z3) * bflo(u3), bfhi(z3) * bfhi(u3)};
            float ss = 0.f;
#pragma unroll
            for (int k = 0; k < 8; ++k) ss += v[k] * v[k];
            const float rn = rsqrtf(wave_sum(ss) * (1.f / 512.f) + EPS);
            v4u o; o.x = pk2(v[0] * rn * ga.x, v[1] * rn * ga.y); o.y = pk2(v[2] * rn * ga.z, v[3] * rn * ga.w); o.z = pk2(v[4] * rn * gb.x, v[5] * rn * gb.y); o.w = pk2(v[6] * rn * gb.z, v[7] * rn * gb.w);
            *(v4u*)(MG + (rowbase + i) * 1024 + 512 + lane * 8) = o;
        }
    }
    __syncthreads();
}

struct CombIn { v4u a, b, c; float l0, l1, l2; };
__device__ __forceinline__ CombIn combine_load(const Ptrs& p, size_t row, int lane) {
    const bf16* PO = (const bf16*)(p.ws + WS_PO); const float* LSE = (const float*)(p.ws + WS_LSE); const int h = lane >> 3;
    CombIn k; k.l0 = LSE[row * 8 + h]; k.l1 = LSE[(size_t)T * 8 + row * 8 + h]; k.l2 = LSE[(size_t)2 * T * 8 + row * 8 + h];
    k.a = *(const v4u*)(PO + row * 512 + lane * 8); k.b = *(const v4u*)(PO + (size_t)T * 512 + row * 512 + lane * 8); k.c = *(const v4u*)(PO + (size_t)2 * T * 512 + row * 512 + lane * 8); return k;
}
__device__ __forceinline__ void combine_row(const Ptrs& p, const CombIn& k, const f32x4 ga, const f32x4 gb, size_t row, int lane) {
    bf16* MG = (bf16*)(p.ws + WS_HN);
    const float l0 = k.l0, l1 = k.l1, l2 = k.l2; const v4u a = k.a, b = k.b, c = k.c;
    const float mx = fmaxf(l0, fmaxf(l1, l2));
    float w0 = __builtin_amdgcn_exp2f(l0 - mx), w1 = __builtin_amdgcn_exp2f(l1 - mx), w2 = __builtin_amdgcn_exp2f(l2 - mx);
    const float inv = 1.f / (w0 + w1 + w2); w0 *= inv; w1 *= inv; w2 *= inv;
    const unsigned a0 = a.x, a1 = a.y, a2 = a.z, a3 = a.w, b0 = b.x, b1 = b.y, b2 = b.z, b3 = b.w, c0 = c.x, c1 = c.y, c2 = c.z, c3 = c.w;
    float v[8];
    v[0] = w0 * bflo(a0) + w1 * bflo(b0) + w2 * bflo(c0); v[1] = w0 * bfhi(a0) + w1 * bfhi(b0) + w2 * bfhi(c0);
    v[2] = w0 * bflo(a1) + w1 * bflo(b1) + w2 * bflo(c1); v[3] = w0 * bfhi(a1) + w1 * bfhi(b1) + w2 * bfhi(c1);
    v[4] = w0 * bflo(a2) + w1 * bflo(b2) + w2 * bflo(c2); v[5] = w0 * bfhi(a2) + w1 * bfhi(b2) + w2 * bfhi(c2);
    v[6] = w0 * bflo(a3) + w1 * bflo(b3) + w2 * bflo(c3); v[7] = w0 * bfhi(a3) + w1 * bfhi(b3) + w2 * bfhi(c3);
    float ss = 0.f;
#pragma unroll
    for (int q = 0; q < 8; ++q) ss += v[q] * v[q];
    const float rn = rsqrtf(wave_sum(ss) * (1.f / 512.f) + EPS);
    v4u o; o.x = pk2(v[0] * rn * ga.x, v[1] * rn * ga.y); o.y = pk2(v[2] * rn * ga.z, v[3] * rn * ga.w); o.z = pk2(v[4] * rn * gb.x, v[5] * rn * gb.y); o.w = pk2(v[6] * rn * gb.z, v[7] * rn * gb.w);
    *(v4u*)(MG + row * 1024 + lane * 8) = o;
}
__device__ __forceinline__ void combine_phase(const Ptrs& p, int gw, int NGW, int lane) {
    if (gw >= T) return;
    const f32x4 ga = *(const f32x4*)(p.ao_g + lane * 8), gb = *(const f32x4*)(p.ao_g + lane * 8 + 4);
    CombIn nx = combine_load(p, (size_t)gw, lane);
    for (int m = gw; m < T; m += NGW) {
        const CombIn cur = nx;
        nx = combine_load(p, (size_t)((m + NGW < T) ? m + NGW : m), lane);
        combine_row(p, cur, ga, gb, (size_t)m, lane);
    }
}

__device__ __forceinline__ void wqk_rowmax(const Ptrs& p, int gw, int NGW, int lane) {
    const bf16* WQK = (const bf16*)(p.ws + WS_WQK); float* RMAX = (float*)(p.ws + WS_CSC);
    for (int r = gw; r < 2048; r += NGW) {
        const v4u a = *(const v4u*)(WQK + (size_t)r * 1024 + lane * 16), b = *(const v4u*)(WQK + (size_t)r * 1024 + lane * 16 + 8);
        const unsigned w0 = a.x, w1 = a.y, w2 = a.z, w3 = a.w, w4 = b.x, w5 = b.y, w6 = b.z, w7 = b.w;
        float m = fmaxf(fmaxf(fmaxf(fabsf(bflo(w0)), fabsf(bfhi(w0))), fmaxf(fabsf(bflo(w1)), fabsf(bfhi(w1)))), fmaxf(fmaxf(fabsf(bflo(w2)), fabsf(bfhi(w2))), fmaxf(fabsf(bflo(w3)), fabsf(bfhi(w3)))));
        m = fmaxf(m, fmaxf(fmaxf(fmaxf(fabsf(bflo(w4)), fabsf(bfhi(w4))), fmaxf(fabsf(bflo(w5)), fabsf(bfhi(w5)))), fmaxf(fmaxf(fabsf(bflo(w6)), fabsf(bfhi(w6))), fmaxf(fabsf(bflo(w7)), fabsf(bfhi(w7))))));
        m = wave_max(m);
        if (lane == 0) RMAX[r] = m;
    }
}
__device__ __forceinline__ void wqk_to_fp8(const Ptrs& p, int gw, int NGW, int lane) {
    const bf16* WQK = (const bf16*)(p.ws + WS_WQK); unsigned char* W8 = p.ws + WS_WQK8; const float* RMAX = (const float*)(p.ws + WS_CSC);
    if (gw >= 2048) return;
    float m = 0.f;
#pragma unroll
    for (int q = 0; q < 8; ++q) { const f32x4 v = *(const f32x4*)(RMAX + q * 256 + lane * 4); m = fmaxf(m, fmaxf(fmaxf(v[0], v[1]), fmaxf(v[2], v[3]))); }
    m = wave_max(m);
    const int ex = (int)((__float_as_uint(m) >> 23) & 0xffu);
    const bool ok = ex > 16 && ex < 250;
    const float S = ok ? __uint_as_float((unsigned)(127 + 7 + 127 - ex) << 23) : 1.f, Si = ok ? __uint_as_float((unsigned)(ex - 7 - 3) << 23) : 0.125f;
    if (gw == 0 && lane == 0) ((float*)(p.ws + WS_CSC))[2048] = Si;
    for (int r = gw; r < 2048; r += NGW) {
        const v4u a = *(const v4u*)(WQK + (size_t)r * 1024 + lane * 16), b = *(const v4u*)(WQK + (size_t)r * 1024 + lane * 16 + 8);
        const unsigned w0 = a.x, w1 = a.y, w2 = a.z, w3 = a.w, w4 = b.x, w5 = b.y, w6 = b.z, w7 = b.w;
        const float v[16] = {bflo(w0), bfhi(w0), bflo(w1), bfhi(w1), bflo(w2), bfhi(w2), bflo(w3), bfhi(w3), bflo(w4), bfhi(w4), bflo(w5), bfhi(w5), bflo(w6), bfhi(w6), bflo(w7), bfhi(w7)};
        unsigned wd[4];
#pragma unroll
        for (int q = 0; q < 4; ++q) { int pk = 0; pk = __builtin_amdgcn_cvt_pk_fp8_f32(v[4 * q] * S, v[4 * q + 1] * S, pk, false); pk = __builtin_amdgcn_cvt_pk_fp8_f32(v[4 * q + 2] * S, v[4 * q + 3] * S, pk, true); wd[q] = (unsigned)pk; }
        *(v4u*)(W8 + (size_t)r * 1024 + lane * 16) = (v4u){wd[0], wd[1], wd[2], wd[3]};
    }
}

__device__ __forceinline__ void ins16(float (&l)[16], float x) {
#pragma unroll
    for (int i = 15; i >= 1; --i) l[i] = __builtin_amdgcn_fmed3f(l[i - 1], l[i], x);
    l[0] = fmaxf(l[0], x);
}
#define DPP_F(v, ctrl) __builtin_bit_cast(float, __builtin_amdgcn_update_dpp(0, __builtin_bit_cast(int, (v)), (ctrl), 0xF, 0xF, true))
__device__ __forceinline__ void topk_ld16(float (&d)[16], const f32x4* q) { const f32x4 a = q[0], b = q[1], c = q[2], e = q[3];
    d[0] = a[0]; d[1] = a[1]; d[2] = a[2]; d[3] = a[3]; d[4] = b[0]; d[5] = b[1]; d[6] = b[2]; d[7] = b[3]; d[8] = c[0]; d[9] = c[1]; d[10] = c[2]; d[11] = c[3]; d[12] = e[0]; d[13] = e[1]; d[14] = e[2]; d[15] = e[3]; }
__device__ __forceinline__ void topk_phase(const Ptrs& p, LAS unsigned char* lds, int vcu, int G, int tid) {
    const float* TOPW = (const float*)(p.ws + WS_SC); const float* PART = (const float*)(p.ws + WS_PART);
    unsigned short* IDX = (unsigned short*)(p.ws + WS_IDX); unsigned short* GATE = (unsigned short*)(p.ws + WS_GATE);
    LAS unsigned* L = (LAS unsigned*)lds + tid * 32;
    const int NU = T / 64, tk = tid >> 3, hd = tid & 7;
    for (int unit = vcu; unit < NU; unit += G) {
        const size_t t = (size_t)unit * 64 + tk;
        float ss;
        { const f32x4* pp = (const f32x4*)(PART + t * 16); const f32x4 a = pp[0], b = pp[1], c = pp[2], d = pp[3];
          ss = ((a[0] + a[1]) + (a[2] + a[3])) + ((b[0] + b[1]) + (b[2] + b[3])) + ((c[0] + c[1]) + (c[2] + c[3])) + ((d[0] + d[1]) + (d[2] + d[3])); }
        const float rn = rsqrtf(ss * (1.f / D) + EPS);
        if (hd == 0) ((float*)(p.ws + WS_RN))[t] = rn;
        const f32x4* tp = (const f32x4*)(TOPW + ((t * 8 + hd) * 4) * 16);
        float la[16], lb[16], lo_[16];
        topk_ld16(la, tp); topk_ld16(lo_, tp + 4); MERGE16_REG(la, lo_);
        topk_ld16(lb, tp + 8); topk_ld16(lo_, tp + 12); MERGE16_REG(lb, lo_);
#pragma unroll
        for (int i = 0; i < 16; ++i) { L[i] = __float_as_uint(la[i]); L[16 + i] = __float_as_uint(lb[i]); }
        float fa[16], fb[16];
#pragma unroll
        for (int i = 0; i < 16; ++i) { fa[i] = __uint_as_float(__float_as_uint(la[i]) & ~0x7fu); fb[i] = __uint_as_float(__float_as_uint(lb[i]) & ~0x7fu); }
        float l[16];
#pragma unroll
        for (int j = 0; j < 16; ++j) l[j] = __uint_as_float((__float_as_uint(fa[0] + fb[j]) & ~0xffu) | (unsigned)(255 - j));
#pragma unroll
        for (int i = 1; i < 16; ++i)
#pragma unroll
            for (int j = 0; j < 16; ++j) if ((i + 1) * (j + 1) <= 16) ins16(l, __uint_as_float((__float_as_uint(fa[i] + fb[j]) & ~0xffu) | (unsigned)(255 - (i * 16 + j))));
        const float rt = rn * 1.4426950408889634f * ((const float*)(p.ws + WS_CSC))[2048];
        float sv[16], den = 0.f; const float s0 = __uint_as_float(__float_as_uint(l[0]) & ~0xffu);
#pragma unroll
        for (int k = 0; k < 16; ++k) { sv[k] = __builtin_amdgcn_exp2f((__uint_as_float(__float_as_uint(l[k]) & ~0xffu) - s0) * rt); den += sv[k]; }
        const float inv = 1.f / den;
        unsigned ids[16];
#pragma unroll
        for (int k = 0; k < 16; ++k) { const unsigned code = 255u - (__float_as_uint(l[k]) & 0xffu); ids[k] = (L[code >> 4] & 0x7fu) * 128u + (L[16 + (code & 15u)] & 0x7fu); sv[k] *= inv; }
        v4u* ip = (v4u*)(IDX + t * 128 + hd * 16);
        ip[0] = (v4u){ids[0] | (ids[1] << 16), ids[2] | (ids[3] << 16), ids[4] | (ids[5] << 16), ids[6] | (ids[7] << 16)};
        ip[1] = (v4u){ids[8] | (ids[9] << 16), ids[10] | (ids[11] << 16), ids[12] | (ids[13] << 16), ids[14] | (ids[15] << 16)};
        v4u* gp = (v4u*)(GATE + t * 128 + hd * 16);
        gp[0] = (v4u){pk2(sv[0], sv[1]), pk2(sv[2], sv[3]), pk2(sv[4], sv[5]), pk2(sv[6], sv[7])}; gp[1] = (v4u){pk2(sv[8], sv[9]), pk2(sv[10], sv[11]), pk2(sv[12], sv[13]), pk2(sv[14], sv[15])};
    }
}

__device__ __forceinline__ float dot2bf(unsigned u, unsigned x, float acc) { return __builtin_amdgcn_fdot2_f32_bf16(__builtin_bit_cast(bf16x2_t, u), __builtin_bit_cast(bf16x2_t, x), acc, false); }
#define DPP_ADD(v, ctrl) ((v) + __builtin_bit_cast(float, __builtin_amdgcn_update_dpp(0, __builtin_bit_cast(int, (v)), (ctrl), 0xF, 0xF, true)))
__device__ __forceinline__ float red8(float v) {
    float a = v; a = DPP_ADD(a, 0xB1); a = DPP_ADD(a, 0x4E); a = DPP_ADD(a, 0x141); return a;
}
constexpr int PB_ROW = 144, PB_WAVE = 128 * PB_ROW;
typedef int v8i __attribute__((ext_vector_type(8)));
struct TokI { v4u ia, ib; };
struct TokX { v4u xa, xb; };
__device__ __forceinline__ TokI peer_tokI(const unsigned short* IDX, int t, int lane) {
    TokI k; const unsigned short* ip = IDX + (size_t)t * 128 + (lane >> 3) * 16; k.ia = *(const v4u*)ip; k.ib = *(const v4u*)(ip + 8); return k;
}
__device__ __forceinline__ TokX peer_tokX(const unsigned char* XF8, int t, int s, int lane) {
    TokX k; const v4u z = {0u, 0u, 0u, 0u};
    if ((lane & 15) < 2) { const unsigned char* xp = XF8 + (size_t)t * 1024 + s * SLW + (lane & 15) * 128 + (lane >> 4) * 16; k.xa = *(const v4u*)xp; k.xb = *(const v4u*)(xp + 64); } else { k.xa = z; k.xb = z; }
    return k;
}
__device__ __forceinline__ void peer_gather(v4u (&u)[16], const v4u ia, const v4u ib, const unsigned char* base, unsigned coff) {
    const unsigned i0 = ia.x, i1 = ia.y, i2 = ia.z, i3 = ia.w, i4 = ib.x, i5 = ib.y, i6 = ib.z, i7 = ib.w;
#define PG_LD(j, w) u[2 * (j)] = *(const v4u*)(base + (((w) & 0xffffu) * 128u + coff)); u[2 * (j) + 1] = *(const v4u*)(base + (((w) >> 16) * 128u + coff))
    PG_LD(0, i0); PG_LD(1, i1); PG_LD(2, i2); PG_LD(3, i3); PG_LD(4, i4); PG_LD(5, i5); PG_LD(6, i6); PG_LD(7, i7);
#undef PG_LD
}
struct DotRes { float v0[16], v1[16]; };
__device__ __forceinline__ void peer_dot_store(const DotRes& r, unsigned short* dst, int lane) {
    if ((lane & 15) == 0) {
        v4u* o = (v4u*)(dst + (lane >> 4) * 32);
#pragma unroll
        for (int q = 0; q < 2; ++q) { o[q] = (v4u){pk2(r.v0[8 * q], r.v0[8 * q + 1]), pk2(r.v0[8 * q + 2], r.v0[8 * q + 3]), pk2(r.v0[8 * q + 4], r.v0[8 * q + 5]), pk2(r.v0[8 * q + 6], r.v0[8 * q + 7])};
            o[2 + q] = (v4u){pk2(r.v1[8 * q], r.v1[8 * q + 1]), pk2(r.v1[8 * q + 2], r.v1[8 * q + 3]), pk2(r.v1[8 * q + 4], r.v1[8 * q + 5]), pk2(r.v1[8 * q + 6], r.v1[8 * q + 7])}; } }
}
__device__ __forceinline__ void peer_tile_write(const v4u (&u)[16], LAS unsigned char* tb, int lane) {
    const int g = lane >> 3, c = lane & 7;
#pragma unroll
    for (int i = 0; i < 16; ++i) *(LAS v4u*)(tb + (8 * i + g) * PB_ROW + 16 * c) = u[i];
    asm volatile("s_waitcnt lgkmcnt(0)" ::: "memory");
}
__device__ __forceinline__ void peer_mfma(DotRes& r, const v4u xa, const v4u xb, LAS unsigned char* tb, int lane) {
    const v8i bop = {(int)xa.x, (int)xa.y, (int)xa.z, (int)xa.w, (int)xb.x, (int)xb.y, (int)xb.z, (int)xb.w};
    const LAS unsigned char* ra = tb + ((lane & 15) >> 1) * PB_ROW + (lane & 1) * 64 + (lane >> 4) * 16;
#pragma unroll
    for (int i = 0; i < 16; ++i) { const v4u w = *(const LAS v4u*)(ra + i * 8 * PB_ROW); const v8i aop = {(int)w.x, (int)w.y, (int)w.z, (int)w.w, 0, 0, 0, 0};
        const f32x4 z = {0.f, 0.f, 0.f, 0.f};
        const f32x4 a = __builtin_amdgcn_mfma_scale_f32_16x16x128_f8f6f4(aop, bop, z, 4  , 0  , 0, 0, 0, 0);
        const float a0 = a[0], a1 = a[1], a2 = a[2], a3 = a[3];
        r.v0[i] = a0 + DPP_F(a1, 0xB1); r.v1[i] = a2 + DPP_F(a3, 0xB1); }
    asm volatile("s_waitcnt lgkmcnt(0)" ::: "memory");
}
__device__ __forceinline__ void peer_dots(const Ptrs& p, LAS unsigned char* lds, int bx, int G, int wave, int lane) {
    const unsigned char* XF8 = p.ws + WS_XF8; const unsigned short* IDX = (const unsigned short*)(p.ws + WS_IDX);
    unsigned short* PACT = (unsigned short*)(p.ws + WS_PACT);
    const int s = (bx & 7) >> 1, wx = ((bx >> 3) * NWAVES + wave) * 2 + (bx & 1), NWX = (G >> 3) * NWAVES * 2;
    const int NT = (T - wx + NWX - 1) / NWX;
    const unsigned char* eus = p.ws + WS_EU + (size_t)s * NEXP * 128; const unsigned coff = (lane & 7) * 16; unsigned short* pact = PACT + (size_t)s * T * 128;
    LAS unsigned char* tb = lds + wave * PB_WAVE;
#define TOK(n) (wx + ((n) < NT ? (n) : NT - 1) * NWX)
    v4u u[16];
    DotRes pend;
    TokI iN = peer_tokI(IDX, TOK(0), lane);
    peer_gather(u, iN.ia, iN.ib, eus, coff);
    TokX xC = peer_tokX(XF8, TOK(0), s, lane);
    iN = peer_tokI(IDX, TOK(1), lane);
    for (int n = 0; n < NT; ++n) {
        peer_tile_write(u, tb, lane);
        peer_gather(u, iN.ia, iN.ib, eus, coff);
        const TokX xN = peer_tokX(XF8, TOK(n + 1), s, lane);
        iN = peer_tokI(IDX, TOK(n + 2), lane);
        if (n > 0) peer_dot_store(pend, pact + (size_t)TOK(n - 1) * 128, lane);
        peer_mfma(pend, xC.xa, xC.xb, tb, lane);
        xC = xN;
    }
    if (NT > 0) peer_dot_store(pend, pact + (size_t)TOK(NT - 1) * 128, lane);
#undef TOK
}
struct CoefIn { float pa[NSLICE], pb[NSLICE], g0, g1, rn; int e0, e1; };
struct CoefSc { float su0, su1, sv0, sv1; };
__device__ __forceinline__ CoefIn coef_load(const Ptrs& p, int t, int lane) {
    const unsigned short* PACT = (const unsigned short*)(p.ws + WS_PACT); const unsigned short* GATE = (const unsigned short*)(p.ws + WS_GATE); const unsigned short* IDX = (const unsigned short*)(p.ws + WS_IDX);
    CoefIn k;
#pragma unroll
    for (int s = 0; s < NSLICE; ++s) { k.pa[s] = __uint_as_float((unsigned)PACT[((size_t)s * T + t) * 128 + lane] << 16); k.pb[s] = __uint_as_float((unsigned)PACT[((size_t)s * T + t) * 128 + 64 + lane] << 16); }
    k.g0 = __uint_as_float((unsigned)GATE[(size_t)t * 128 + lane] << 16); k.g1 = __uint_as_float((unsigned)GATE[(size_t)t * 128 + 64 + lane] << 16); k.e0 = IDX[(size_t)t * 128 + lane]; k.e1 = IDX[(size_t)t * 128 + 64 + lane]; k.rn = ((const float*)(p.ws + WS_RN))[t]; return k;
}
__device__ __forceinline__ CoefSc coef_scales(const Ptrs& p, const CoefIn& k) {
    const float* SU = (const float*)(p.ws + WS_SU); const float* SV = (const float*)(p.ws + WS_SV);
    CoefSc c; c.su0 = SU[k.e0]; c.su1 = SU[k.e1]; c.sv0 = SV[k.e0]; c.sv1 = SV[k.e1]; return c;
}
__device__ __forceinline__ void coef_finish(const CoefIn& k, const CoefSc& c, float& c0, float& c1, float& m) {
    float a0 = 0.f, a1 = 0.f;
#pragma unroll
    for (int s = 0; s < NSLICE; ++s) { a0 += k.pa[s]; a1 += k.pb[s]; }
    const float rt = 0.125f * k.rn;
    const pg8::f32x2 gl = pg8::gelu_pk((pg8::f32x2){a0 * rt * c.su0, a1 * rt * c.su1});
    c0 = k.g0 * gl.x * c.sv0; c1 = k.g1 * gl.y * c.sv1; m = fmaxf(fabsf(c0), fabsf(c1));
}
__device__ __forceinline__ void coef_store(unsigned char* COEF8, float* CS, int t, int lane, float c0, float c1, float m) {
    const int ex = (int)((__float_as_uint(m) >> 23) & 0xffu);
    const float S = (ex > 0 && ex < 200) ? __uint_as_float((unsigned)(127 + 7 + 127 - ex) << 23) : 1.f, Si = (ex > 0 && ex < 200) ? __uint_as_float((unsigned)(ex - 7) << 23) : 1.f;
    const int pk = __builtin_amdgcn_cvt_pk_fp8_f32(c0 * S, c1 * S, 0, false);
    COEF8[(size_t)t * 128 + lane] = (unsigned char)(pk & 0xff); COEF8[(size_t)t * 128 + 64 + lane] = (unsigned char)((pk >> 8) & 0xff);
    if (lane == 0) CS[t] = Si;
}
__device__ __forceinline__ void peer_coef(const Ptrs& p, int gw, int NGW, int lane) {
    unsigned char* COEF8 = p.ws + WS_COEF; float* CS = (float*)(p.ws + WS_CS);
    const int NTW = (T - gw + NGW - 1) / NGW;
    if (NTW <= 0) return;
#define CTOK(n_) (gw + (((n_) < NTW) ? (n_) : (NTW - 1)) * NGW)
    CoefIn ka = coef_load(p, CTOK(0), lane), kb = coef_load(p, CTOK(1), lane);
    for (int n = 0; n < NTW; n += 2) {
        const CoefSc ca = coef_scales(p, ka), cb = coef_scales(p, kb);
        const CoefIn na = coef_load(p, CTOK(n + 2), lane), nb = coef_load(p, CTOK(n + 3), lane);
        float a0, a1, am, b0, b1, bm;
        coef_finish(ka, ca, a0, a1, am); coef_finish(kb, cb, b0, b1, bm);
#pragma unroll
        for (int o = 0; o < 1; ++o) { am = wave_max(am); bm = wave_max(bm); }
        coef_store(COEF8, CS, CTOK(n), lane, a0, a1, am);
        if (n + 1 < NTW) coef_store(COEF8, CS, CTOK(n + 1), lane, b0, b1, bm);
        ka = na; kb = nb;
    }
#undef CTOK
}
typedef int v2i __attribute__((ext_vector_type(2)));
struct TokB { v4u ia, ib, ca, cb; v2u xr; float cs; };
__device__ __forceinline__ TokB peer_tokB(const unsigned short* IDX, const unsigned char* COEF8, const float* CS, const bf16* xb, int t, int lane) {
    TokB k; const int g = lane >> 3; k.ia = *(const v4u*)(IDX + (size_t)t * 128 + 16 * g); k.ib = *(const v4u*)(IDX + (size_t)t * 128 + 16 * g + 8);
    const v4u z = {0u, 0u, 0u, 0u};
    if ((lane & 15) == 0) { const unsigned char* cp = COEF8 + (size_t)t * 128 + (lane >> 4) * 16; k.ca = *(const v4u*)cp; k.cb = *(const v4u*)(cp + 64); } else { k.ca = z; k.cb = z; }
    k.cs = CS[t]; k.xr = *(const v2u*)(xb + (size_t)t * 1024 + 4 * lane); return k;
}
__device__ __forceinline__ float pack_rows(float a, float b, float c, float d) {
    const v2u s1 = __builtin_amdgcn_permlane32_swap(__float_as_uint(a), __float_as_uint(c), false, false); const unsigned ac = s1.x;
    const v2u s2 = __builtin_amdgcn_permlane32_swap(__float_as_uint(b), __float_as_uint(d), false, false); const unsigned bd = s2.x;
    const v2u s3 = __builtin_amdgcn_permlane16_swap(ac, bd, false, false); const unsigned r = s3.x;
    return __uint_as_float(r);
}
__device__ __forceinline__ void peer_axpy_mfma(const v4u (&v)[16], const TokB& k, LAS unsigned char* tb, float* o, int lane) {
    const int g = lane >> 3, c = lane & 7, n = lane & 15, kg = lane >> 4;
#pragma unroll
    for (int i = 0; i < 16; ++i) *(LAS v4u*)(tb + (16 * g + i) * PB_ROW + 16 * c) = v[i];
    asm volatile("s_waitcnt lgkmcnt(0)" ::: "memory");
    const v8i aop = {(int)k.ca.x, (int)k.ca.y, (int)k.ca.z, (int)k.ca.w, (int)k.cb.x, (int)k.cb.y, (int)k.cb.z, (int)k.cb.w};
    const LAS unsigned char* ra = tb + (32 * kg + n) * PB_ROW;
    float pk[4];
#pragma unroll
    for (int q = 0; q < 4; ++q) {
        float val[4];
#pragma unroll
        for (int r = 0; r < 4; ++r) { const int nt = 4 * q + r;
            const v2i lo = __builtin_amdgcn_ds_read_tr4_b64_v2i32((LAS v2i*)(ra + nt * 8)), hi = __builtin_amdgcn_ds_read_tr4_b64_v2i32((LAS v2i*)(ra + 16 * PB_ROW + nt * 8));
            const v8i bop = {lo.x, lo.y, hi.x, hi.y, 0, 0, 0, 0};
            const f32x4 z = {0.f, 0.f, 0.f, 0.f};
            const f32x4 d = __builtin_amdgcn_mfma_scale_f32_16x16x128_f8f6f4(aop, bop, z, 0  , 4  , 0, 0, 0, 0);
            val[r] = d[0]; }
        pk[q] = pack_rows(val[0], val[1], val[2], val[3]);
    }
    asm volatile("s_waitcnt lgkmcnt(0)" ::: "memory");
    const unsigned r0 = k.xr.x, r1 = k.xr.y; const float cs = k.cs;
    *(f32x4*)(o + 4 * lane) = (f32x4){bflo(r0) + pk[0] * cs, bfhi(r0) + pk[1] * cs, bflo(r1) + pk[2] * cs, bfhi(r1) + pk[3] * cs};
}
__device__ __forceinline__ void peer_axpy(const Ptrs& p, LAS unsigned char* lds, int bx, int G, int wave, int lane) {
    const unsigned short* IDX = (const unsigned short*)(p.ws + WS_IDX); const unsigned char* COEF8 = p.ws + WS_COEF; const float* CS = (const float*)(p.ws + WS_CS);
    const int s = (bx & 7) >> 1, wx = ((bx >> 3) * NWAVES + wave) * 2 + (bx & 1), NWX = (G >> 3) * NWAVES * 2, c = lane & 7;
    const int NT = (T - wx + NWX - 1) / NWX;
    const unsigned char* evs = p.ws + WS_EV + (size_t)s * NEXP * 128; const unsigned coff = c * 16; float* ob = p.out + s * SLW; const bf16* xb = (const bf16*)(p.ws + WS_X1B) + s * SLW;
    LAS unsigned char* tb = lds + wave * PB_WAVE;
#define TOK(n) (wx + ((n) < NT ? (n) : NT - 1) * NWX)
    v4u va[16], vb[16];
    TokB kA = peer_tokB(IDX, COEF8, CS, xb, TOK(0), lane);
    peer_gather(va, kA.ia, kA.ib, evs, coff);
    TokB kB = peer_tokB(IDX, COEF8, CS, xb, TOK(1), lane);
    for (int n = 0; n < NT; n += 2) {
        peer_gather(vb, kB.ia, kB.ib, evs, coff);
        TokB kC = peer_tokB(IDX, COEF8, CS, xb, TOK(n + 2), lane);
        peer_axpy_mfma(va, kA, tb, ob + (size_t)TOK(n) * 1024, lane);
        peer_gather(va, kC.ia, kC.ib, evs, coff);
        kA = peer_tokB(IDX, COEF8, CS, xb, TOK(n + 3), lane);
        if (n + 1 < NT) peer_axpy_mfma(vb, kB, tb, ob + (size_t)TOK(n + 1) * 1024, lane);
        kB = kA; kA = kC;
    }
#undef TOK
}

#define XB_TMO      128
#define XB_XCNT(j)  (256  + 64 * (j))
#define XB_XSUB(j)  (1280 + 64 * (j))
#define XB_XGEN(j)  (2304 + 64 * (j))
#define XB_TOP      3328
#define XB_TOPGEN   3392
#define XCD_BAR_WORDS 3456
#define XB_SPIN_CAP (1u << 18)

__device__ __forceinline__ unsigned xb_ld(unsigned* p)              { return __hip_atomic_load(p, __ATOMIC_RELAXED, __HIP_MEMORY_SCOPE_AGENT); }
__device__ __forceinline__ unsigned xb_add(unsigned* p, unsigned v) { return __hip_atomic_fetch_add(p, v, __ATOMIC_RELAXED, __HIP_MEMORY_SCOPE_AGENT); }
__device__ __forceinline__ unsigned xb_xcc_id() { return (unsigned)__builtin_amdgcn_s_getreg((3 << 11) | 20) & 0xFu; }
#define XB_SPIN(cond, bar) do { unsigned _sp = 0; while (cond) { __builtin_amdgcn_s_sleep(1); \
    if ((++_sp & 255u) == 0u) { if (xb_ld(&(bar)[XB_TMO])) break; if (_sp > XB_SPIN_CAP) { atomicAdd(&(bar)[XB_TMO], 1u); break; } } } } while (0)

struct XcdBarrier {
    unsigned* bar; unsigned x;
    volatile LAS unsigned* st;
};

__device__ __forceinline__ XcdBarrier xcd_barrier_post(unsigned* bar, volatile LAS unsigned* st) {
    XcdBarrier b; b.bar = bar; b.x = xb_xcc_id(); b.st = st;
    if (threadIdx.x == 0) (void)xb_add(&bar[XB_XCNT(b.x)], 1u);
    return b;
}
__device__ __forceinline__ void xcd_barrier_complete(unsigned* bar, unsigned x, unsigned& nloc, unsigned& nx) {
    const unsigned G = gridDim.x * gridDim.y * gridDim.z;
    unsigned sum, cnt, mine, sp = 0u;
    for (;;) {
        sum = 0u; cnt = 0u; mine = 0u;
#pragma unroll
        for (unsigned j = 0; j < 16; ++j) { const unsigned c = xb_ld(&bar[XB_XCNT(j)]); sum += c; cnt += (c > 0u) ? 1u : 0u; mine = (j == x) ? c : mine; }
        if (sum == G) break;
        __builtin_amdgcn_s_sleep(1);
        if ((++sp & 255u) == 0u) { if (xb_ld(&bar[XB_TMO])) break; if (sp > XB_SPIN_CAP) { atomicAdd(&bar[XB_TMO], 1u); break; } }
    }
    nloc = mine > 0u ? mine : 1u; nx = cnt > 0u ? cnt : 1u;
}

__device__ __forceinline__ void xcd_barrier(const XcdBarrier& b) {
    asm volatile("s_waitcnt vmcnt(0)" ::: "memory");
    __syncthreads();
    if (threadIdx.x == 0) {
        unsigned* bar = b.bar;
        __builtin_amdgcn_s_waitcnt(0);
        unsigned nloc = b.st[0], nx = b.st[1];
        if (nloc == 0u) { xcd_barrier_complete(bar, b.x, nloc, nx); b.st[0] = nloc; b.st[1] = nx; }
        const unsigned old = xb_add(&bar[XB_XSUB(b.x)], 1u);
        const unsigned gen = old / nloc;
        if (old + 1u == (gen + 1u) * nloc) {
            __builtin_amdgcn_fence(__ATOMIC_RELEASE, "agent");
            asm volatile("s_waitcnt vmcnt(0)" ::: "memory");
            const unsigned og = xb_add(&bar[XB_TOP], 1u);
            const unsigned tg = og / nx;
            if (og + 1u == (tg + 1u) * nx) xb_add(&bar[XB_TOPGEN], 1u);
            else XB_SPIN(xb_ld(&bar[XB_TOPGEN]) == tg, bar);
            __builtin_amdgcn_fence(__ATOMIC_ACQUIRE, "agent");
            xb_add(&bar[XB_XGEN(b.x)], 1u);
            asm volatile("s_waitcnt vmcnt(0)" ::: "memory");
        } else {
            XB_SPIN(xb_ld(&bar[XB_XGEN(b.x)]) == gen, bar);
            __builtin_amdgcn_fence(__ATOMIC_ACQUIRE, "agent");
            asm volatile("s_waitcnt vmcnt(0)" ::: "memory");
        }
    }
    __syncthreads();
}

constexpr int N_PHASES = 8;
#ifndef PROBE
#define PROBE 0
#endif
__global__ void __launch_bounds__(NTHR, 2) hymba_fwd(Args args) {
    extern __shared__ __attribute__((aligned(16))) unsigned char lds_raw[];
    LAS unsigned char* lds = (LAS unsigned char*)lds_raw;
    const Ptrs& p = args.p;
    const int tid = threadIdx.x, lane = tid & 63, wave = __builtin_amdgcn_readfirstlane(tid >> 6);
    const int G = gridDim.x, bx = blockIdx.x, vcu = (G % 8 == 0) ? (bx % 8) * (G / 8) + bx / 8 : bx;
    const int gw = vcu * NWAVES + wave, NGW = G * NWAVES;
    const int lo = args.ph_lo, hi = args.ph_hi;
    volatile LAS unsigned* MISC = (volatile LAS unsigned*)(lds + MISC_OFF);
    if (tid < 64) MISC[tid] = 0u;
    __syncthreads();
    XcdBarrier bar = xcd_barrier_post((unsigned*)(p.ws + WS_CTL) + CW_BAR, MISC + 8);
#define IN(k) (lo <= (k) && (k) < hi)
#define SEAM(k) do { if (IN(k) && IN((k) + 1)) xcd_barrier(bar); } while (0)
    if (IN(0)) p0_prologue(p, lds, tid, lane, wave, vcu, G);
    SEAM(0);
    if (IN(1)) {
        pg8::Gemm g{(const bf16*)(p.ws + WS_HN), (const bf16*)(p.ws + WS_WIN), T, INW, D}; pg8::StaticOrder S; S.init(T, INW, G, bx);
        EpiProj E{(bf16*)(p.ws + WS_Q), (bf16*)(p.ws + WS_K), (bf16*)(p.ws + WS_V), (bf16*)(p.ws + WS_GU), (bf16*)(p.ws + WS_GV), p.q_g, p.k_g};
        pg8::gemm_phase<EpiProj, pg8::StaticOrder, true, true>(lds, g, S, E);
    }
    SEAM(1);
    if (IN(2)) attn_phase(p, lds, vcu, G, lane, wave);
    SEAM(2);
    if (IN(3)) {
        for (int u = vcu; u < T / 128; u += G) gmlp_unit(p, lds, u, tid, lane, wave);
        combine_phase(p, gw, NGW, lane);
        wqk_rowmax(p, gw, NGW, lane);
    }
    SEAM(3);
    if (IN(4)) {
        wqk_to_fp8(p, gw, NGW, lane);
        pg8::Gemm g{(const bf16*)(p.ws + WS_HN), (const bf16*)(p.ws + WS_WOUT), T, D, D}; pg8::StaticOrder S; S.init(T, D, G, bx);
        EpiOut E{p.x, p.out, (bf16*)(p.ws + WS_X1B), (float*)(p.ws + WS_PART), p.ws + WS_XF8};
        pg8::gemm_phase<EpiOut, pg8::StaticOrder, true, true>(lds, g, S, E);
    }
    SEAM(4);
    if (IN(5)) {
        pg8::Gemm g{(const bf16*)(p.ws + WS_XF8), (const bf16*)(p.ws + WS_WQK8), T, 2048, D / 2}; pg8::StaticOrder S; S.init(T, 2048, G, bx);
        EpiTopk E{(float*)(p.ws + WS_SC)};
        pg8::gemm_phase<EpiTopk, pg8::StaticOrder, true, true, true>(lds, g, S, E);
    }
    SEAM(5);
    if (IN(6)) topk_phase(p, lds, vcu, G, tid);
    SEAM(6);
    if (IN(7)) {
        __syncthreads();
        peer_dots(p, lds, bx, G, wave, lane);
        if (args.probe == 1) peer_dots(p, lds, bx, G, wave, lane);
        xcd_barrier(bar);
        peer_coef(p, gw, NGW, lane);
        if (args.probe == 2) peer_coef(p, gw, NGW, lane);
        xcd_barrier(bar);
        if (args.probe == 3) { xcd_barrier(bar); xcd_barrier(bar); xcd_barrier(bar); xcd_barrier(bar); xcd_barrier(bar); xcd_barrier(bar); xcd_barrier(bar); xcd_barrier(bar); xcd_barrier(bar); xcd_barrier(bar); }
        __syncthreads();
        peer_axpy(p, lds, bx, G, wave, lane);
        if (args.probe == 5) peer_axpy(p, lds, bx, G, wave, lane);
    }
#undef IN
#undef SEAM
}

extern "C" void kernel_launch(void* const* d_in, const int* in_sizes, int n_in, void* d_out, int out_size, void* d_ws, size_t ws_size, hipStream_t stream) {
    static int grid = 0;
    if (grid == 0) {
        if (n_in != 17 || in_sizes[0] != T * D || out_size != T * D || ws_size < WS_END) { fprintf(stderr, "kernel_launch: unexpected shapes (n_in %d, in0 %d, out %d, ws %zu); nothing launched\n", n_in, n_in > 0 ? in_sizes[0] : -1, out_size, ws_size); grid = -1; return; }
        int dev = 0, cus = 0, per_cu = 0;
        if (hipGetDevice(&dev) != hipSuccess || hipDeviceGetAttribute(&cus, hipDeviceAttributeMultiprocessorCount, dev) != hipSuccess) { grid = -1; return; }
        if (hipFuncSetAttribute((const void*)hymba_fwd, hipFuncAttributeMaxDynamicSharedMemorySize, LDS_BYTES) != hipSuccess) { fprintf(stderr, "kernel_launch: hipFuncSetAttribute failed\n"); grid = -1; return; }
        if (hipOccupancyMaxActiveBlocksPerMultiprocessor(&per_cu, (const void*)hymba_fwd, NTHR, LDS_BYTES) != hipSuccess || per_cu < 1) fprintf(stderr, "kernel_launch: occupancy query reports %d\n", per_cu);
        (void)hipGetLastError();
        grid = cus;
    }
    if (grid < 0) return;
    Args a{};
    const float** pp = (const float**)&a.p;
    for (int i = 0; i < 17; ++i) pp[i] = (const float*)d_in[i];
    a.p.out = (float*)d_out; a.p.ws = (unsigned char*)d_ws;
    if (hipMemsetAsync((char*)d_ws + WS_CTL, 0, CTL_ZERO_BYTES, stream) != hipSuccess) { fprintf(stderr, "kernel_launch: hipMemsetAsync failed\n"); return; }
    a.ph_lo = 0; a.ph_hi = N_PHASES; a.probe = PROBE;
    hipLaunchKernelGGL(hymba_fwd, dim3(grid), dim3(NTHR), LDS_BYTES, stream, a);
}
```

```cpp
#include <hip/hip_runtime.h>
#include <cstdio>
#include <cstdint>
#include <cmath>
namespace pg8 {
#define PG8_LAS __attribute__((address_space(3)))
typedef unsigned short bf16_t;
typedef short bf16x8 __attribute__((ext_vector_type(8)));
typedef float f32x4 __attribute__((ext_vector_type(4)));
typedef unsigned u32x4 __attribute__((ext_vector_type(4)));
typedef int i32x4 __attribute__((ext_vector_type(4)));
typedef int i32x8 __attribute__((ext_vector_type(8)));
constexpr int BM = 256, BK = 64, HALF = 128, HTB = HALF * BK * 2  , STAGE_BYTES = 8 * HTB, NXCD = 8, WGM = 8;

__host__ __device__ __forceinline__ int lds_byte(int r, int c) { const int st = (r >> 4) * 2 + (c >> 5), rr = r & 15, cc = c & 31, ob = rr * 64 + cc * 2; return st * 1024 + (ob ^ (((ob >> 9) & 1) << 5)); }
__host__ __device__ __forceinline__ void stage_rc(int b, int& R, int& C) { const int st = b / 1024, sb = b % 1024, swz = sb ^ (((sb >> 9) & 1) << 5); R = (st >> 1) * 16 + swz / 64; C = (st & 1) * 32 + (swz % 64) / 2; }
__host__ __device__ __forceinline__ int perm32(int rho) { const int n = rho >> 4, i = rho & 15; return 8 * (i >> 2) + 4 * n + (i & 3); }

struct Unit { int pm, pn; };
struct Gemm { const bf16_t* A; const bf16_t* Bt; int M, N, K; };

struct StaticOrder {
    int nM, nN, nwg, G, c;
    __host__ __device__ void init(int M, int N, int G_, int c_) { nM = M / BM; nN = N / BM; nwg = nM * nN; G = G_; c = c_; }
    __host__ __device__ bool next(int i, Unit& u) const {
        const long L = (long)i * G + c; if (L >= nwg) return false;
        int wgid = (int)L; { const int q = nwg / NXCD, r = nwg % NXCD, xcd = wgid % NXCD, off = wgid / NXCD; wgid = (xcd < r ? xcd * (q + 1) : r * (q + 1) + (xcd - r) * q) + off; }
        const int nig = WGM * nN, gid = wgid / nig, fm = gid * WGM, gsz = (nM - fm) < WGM ? (nM - fm) : WGM;
        u.pm = fm + ((wgid % nig) % gsz); u.pn = (wgid % nig) / gsz; return true;
    }
    __device__ __forceinline__ void a_ready(const Unit&) const {}
    __device__ __forceinline__ void done(const Unit&) const {}
};

__device__ __forceinline__ unsigned cvt_pk_bf16(float lo, float hi) { unsigned r; asm volatile("v_cvt_pk_bf16_f32 %0, %1, %2" : "=v"(r) : "v"(lo), "v"(hi)); return r; }
typedef float f32x2 __attribute__((ext_vector_type(2)));
__device__ __forceinline__ f32x2 gelu_pk(f32x2 v) {
    const f32x2 av = __builtin_elementwise_abs(v), d = av * 0.2316418882f + 1.0f;
    f32x2 t; t.x = __builtin_amdgcn_rcpf(d.x); t.y = __builtin_amdgcn_rcpf(d.y);
    f32x2 q = t * 0.5307027145f + (-0.7265760135f); q = q * t + 0.7107068705f; q = q * t + (-0.142248368f); q = q * t + 0.127414796f; q = q * t;
    const f32x2 s = (v * v) * (-0.72134752044f);
    f32x2 e; e.x = __builtin_amdgcn_exp2f(s.x); e.y = __builtin_amdgcn_exp2f(s.y);
    const f32x2 m = v * (q * e), r = v - m;
    f32x2 o; o.x = v.x < 0.f ? m.x : r.x; o.y = v.y < 0.f ? m.y : r.y; return o;
}

template <class Epi, class Sched, bool ALIGN_EPI = false, bool SP2 = false, bool FP8 = false>
__device__ __forceinline__ void gemm_phase(PG8_LAS unsigned char* lds, const Gemm g, const Sched& S, const Epi& E) {
    const int tid = threadIdx.x, wid = __builtin_amdgcn_readfirstlane(tid >> 6), lane = tid & 63, wr = wid >> 2, wc = wid & 3, fr = lane & 15, fq = lane >> 4;
    const int K = g.K, nt = K / BK;
    unsigned voffA[2], voffB[2];
#pragma unroll
    for (int i = 0; i < 2; ++i) { int R, C; stage_rc(tid * 16 + i * 8192, R, C); const int Rb = Epi::PERM ? ((R & ~31) + perm32(R & 31)) : R;
        voffA[i] = (unsigned)(R * K + C) * 2u; voffB[i] = (unsigned)(Rb * K + C) * 2u; }
    const size_t kstep = (size_t)(BK * 2);
    const size_t hstep = (size_t)HALF * K * 2;
    const size_t tstep = 2 * hstep;
    const unsigned ldsw = (unsigned)wid * 1024u;
    const int aoff = lds_byte(wr * 64 + fr, fq * 8), boff = lds_byte(wc * 32 + fr, fq * 8);
#define PG8_SA(b, h) (((b) * 2 + (h)) * HTB)
#define PG8_SB(b, h) ((4 + (b) * 2 + (h)) * HTB)
#define PG8_STAGE(bufoff, gbase, voff) do { _Pragma("unroll") for (int _i = 0; _i < 2; ++_i) \
        __builtin_amdgcn_global_load_lds((const unsigned*)((const char*)(gbase) + (voff)[_i]), (PG8_LAS unsigned*)(lds + (bufoff) + ldsw + _i * 8192), 16, 0, 0); } while (0)
#define PG8_LD8(p_) __builtin_shufflevector(*(const PG8_LAS i32x4*)(p_), *(const PG8_LAS i32x4*)((p_) + 1024), 0, 1, 2, 3, 4, 5, 6, 7)
#define PG8_LDA(dst, b, h) do { if constexpr (FP8) { _Pragma("unroll") for (int m = 0; m < 4; ++m) dst##8[m] = PG8_LD8(lds + PG8_SA(b, h) + aoff + m * 2048); } \
        else { _Pragma("unroll") for (int m = 0; m < 4; ++m) _Pragma("unroll") for (int k = 0; k < 2; ++k) dst[m][k] = *(const PG8_LAS bf16x8*)(lds + PG8_SA(b, h) + aoff + m * 2048 + k * 1024); } } while (0)
#define PG8_LDB(dst, b, h) do { if constexpr (FP8) { _Pragma("unroll") for (int n = 0; n < 2; ++n) dst##8[n] = PG8_LD8(lds + PG8_SB(b, h) + boff + n * 2048); } \
        else { _Pragma("unroll") for (int n = 0; n < 2; ++n) _Pragma("unroll") for (int k = 0; k < 2; ++k) dst[n][k] = *(const PG8_LAS bf16x8*)(lds + PG8_SB(b, h) + boff + n * 2048 + k * 1024); } } while (0)
#define PG8_MMA(ai, bj, At, Bt) do { __builtin_amdgcn_s_setprio(1); \
        if constexpr (FP8) { _Pragma("unroll") for (int m = 0; m < 4; ++m) _Pragma("unroll") for (int n = 0; n < 2; ++n) \
            asm volatile("v_mfma_f32_16x16x128_f8f6f4 %0, %1, %2, %0" : "+v"(acc[ai][bj][m][n]) : "v"(Bt##8[n]), "v"(At##8[m])); }   \
        else { _Pragma("unroll") for (int m = 0; m < 4; ++m) _Pragma("unroll") for (int n = 0; n < 2; ++n) _Pragma("unroll") for (int k = 0; k < 2; ++k) \
            acc[ai][bj][m][n] = __builtin_amdgcn_mfma_f32_16x16x32_bf16(Bt[n][k], At[m][k], acc[ai][bj][m][n], 0, 0, 0); } \
        __builtin_amdgcn_s_setprio(0); } while (0)
#define PG8_WAIT_V(n) asm volatile("s_waitcnt vmcnt(" #n ")" ::: "memory")
#define PG8_WAIT_L(n) asm volatile("s_waitcnt lgkmcnt(" #n ")" ::: "memory")
#define PG8_BAR __builtin_amdgcn_s_barrier()
#define PG8_SCHED __builtin_amdgcn_sched_barrier(0)
    Unit cur, nxt; int ui = 0;
    if (!S.next(0, cur)) return;
    f32x4 acc[2][2][4][2];
#pragma unroll
    for (int a = 0; a < 2; ++a)
#pragma unroll
        for (int b = 0; b < 2; ++b)
#pragma unroll
            for (int m = 0; m < 4; ++m)
#pragma unroll
                for (int n = 0; n < 2; ++n) acc[a][b][m][n] = (f32x4){0.f, 0.f, 0.f, 0.f};
    bf16x8 At[4][2], B0[2][2], B1[2][2];
    i32x8 At8[4], B08[2], B18[2];
    const char* cA = (const char*)g.A + (size_t)cur.pm * tstep; const char* cB = (const char*)g.Bt + (size_t)cur.pn * tstep;
    S.a_ready(cur);
    if constexpr (SP2) {
        PG8_STAGE(PG8_SB(0, 0), cB, voffB); PG8_STAGE(PG8_SB(0, 1), cB + hstep, voffB); PG8_STAGE(PG8_SA(0, 0), cA, voffA); PG8_STAGE(PG8_SA(0, 1), cA + hstep, voffA);
        if (wr == 1) PG8_BAR;
        PG8_WAIT_V(2); PG8_BAR;
        PG8_STAGE(PG8_SB(1, 0), cB + kstep, voffB); PG8_STAGE(PG8_SA(1, 0), cA + kstep, voffA); PG8_STAGE(PG8_SB(1, 1), cB + hstep + kstep, voffB);
        PG8_WAIT_V(6); PG8_BAR;
    } else {
        PG8_STAGE(PG8_SB(0, 0), cB, voffB); PG8_STAGE(PG8_SA(0, 0), cA, voffA); PG8_STAGE(PG8_SB(0, 1), cB + hstep, voffB); PG8_STAGE(PG8_SA(0, 1), cA + hstep, voffA);
        if (wr == 1) PG8_BAR;
        PG8_WAIT_V(4); PG8_BAR;
        PG8_STAGE(PG8_SB(1, 0), cB + kstep, voffB); PG8_STAGE(PG8_SA(1, 0), cA + kstep, voffA); PG8_STAGE(PG8_SB(1, 1), cB + hstep + kstep, voffB);
        PG8_WAIT_V(6); PG8_BAR;
    }
    for (;;) {
        const bool has_next = S.next(ui + 1, nxt);
        const char* nA = has_next ? (const char*)g.A + (size_t)nxt.pm * tstep : cA; const char* nB = has_next ? (const char*)g.Bt + (size_t)nxt.pn * tstep : cB;
        for (int t = 0; t < nt; t += 2) {
            const bool last = (t == nt - 2);
            const char* a1 = cA + (size_t)(t + 1) * kstep;
            const char* a2 = last ? nA : cA + (size_t)(t + 2) * kstep; const char* b2 = last ? nB : cB + (size_t)(t + 2) * kstep;
            const char* a3 = a2 + kstep; const char* b3 = b2 + kstep;
            if (last && has_next) S.a_ready(nxt);
            if constexpr (SP2) {
            PG8_LDB(B0, 0, 0); PG8_LDB(B1, 0, 1); PG8_SCHED; PG8_LDA(At, 0, 0); PG8_STAGE(PG8_SA(1, 1), a1 + hstep, voffA);
            PG8_WAIT_V(8); PG8_WAIT_L(0); PG8_BAR; PG8_MMA(0, 0, At, B0); PG8_MMA(0, 1, At, B1); PG8_BAR; PG8_SCHED;
            PG8_LDA(At, 0, 1); PG8_STAGE(PG8_SB(0, 0), b2, voffB); PG8_STAGE(PG8_SB(0, 1), b2 + hstep, voffB); PG8_STAGE(PG8_SA(0, 0), a2, voffA);
            PG8_WAIT_V(8); PG8_WAIT_L(0); PG8_BAR; PG8_MMA(1, 0, At, B0); PG8_MMA(1, 1, At, B1); PG8_BAR; PG8_SCHED;
            PG8_LDB(B0, 1, 0); PG8_LDB(B1, 1, 1); PG8_SCHED; PG8_LDA(At, 1, 0); PG8_STAGE(PG8_SA(0, 1), a2 + hstep, voffA);
            PG8_WAIT_V(8); PG8_WAIT_L(0); PG8_BAR; PG8_MMA(0, 0, At, B0); PG8_MMA(0, 1, At, B1); PG8_BAR; PG8_SCHED;
            PG8_LDA(At, 1, 1); PG8_STAGE(PG8_SB(1, 0), b3, voffB); PG8_STAGE(PG8_SB(1, 1), b3 + hstep, voffB); PG8_STAGE(PG8_SA(1, 0), a3, voffA);
            PG8_WAIT_V(8); PG8_WAIT_L(0); PG8_BAR; PG8_MMA(1, 0, At, B0); PG8_MMA(1, 1, At, B1); PG8_BAR; PG8_SCHED;
            } else {
            PG8_LDB(B0, 0, 0); PG8_SCHED; PG8_LDA(At, 0, 0); PG8_STAGE(PG8_SA(1, 1), a1 + hstep, voffA);
            PG8_WAIT_L(8); PG8_BAR; PG8_WAIT_L(0); PG8_MMA(0, 0, At, B0); PG8_BAR; PG8_SCHED;
            PG8_LDB(B1, 0, 1); PG8_STAGE(PG8_SB(0, 0), b2, voffB);
            PG8_BAR; PG8_WAIT_L(0); PG8_MMA(0, 1, At, B1); PG8_BAR;
            PG8_LDA(At, 0, 1); PG8_STAGE(PG8_SA(0, 0), a2, voffA);
            PG8_BAR; PG8_WAIT_L(0); PG8_MMA(1, 0, At, B0); PG8_BAR; PG8_SCHED;
            PG8_STAGE(PG8_SB(0, 1), b2 + hstep, voffB);
            PG8_WAIT_V(6); PG8_BAR; PG8_MMA(1, 1, At, B1); PG8_BAR;
            PG8_LDB(B0, 1, 0); PG8_SCHED; PG8_LDA(At, 1, 0); PG8_STAGE(PG8_SA(0, 1), a2 + hstep, voffA);
            PG8_WAIT_L(8); PG8_BAR; PG8_WAIT_L(0); PG8_MMA(0, 0, At, B0); PG8_BAR; PG8_SCHED;
            PG8_LDB(B1, 1, 1); PG8_STAGE(PG8_SB(1, 0), b3, voffB);
            PG8_BAR; PG8_WAIT_L(0); PG8_MMA(0, 1, At, B1); PG8_BAR;
            PG8_LDA(At, 1, 1); PG8_STAGE(PG8_SA(1, 0), a3, voffA);
            PG8_BAR; PG8_WAIT_L(0); PG8_MMA(1, 0, At, B0); PG8_BAR; PG8_SCHED;
            PG8_STAGE(PG8_SB(1, 1), b3 + hstep, voffB);
            PG8_WAIT_V(6); PG8_BAR; PG8_MMA(1, 1, At, B1); PG8_BAR;
            }
        }
        if constexpr (ALIGN_EPI) { if (wr == 0) PG8_BAR; }
        if constexpr (FP8) { asm volatile("s_nop 15\n\ts_nop 15" ::: "memory"); }
        if constexpr (!Epi::AFTER_DRAIN) { E(acc, cur, wr, wc, fr, fq); S.done(cur); }
        if (!has_next) break;
#pragma unroll
        for (int a = 0; a < 2; ++a)
#pragma unroll
            for (int b = 0; b < 2; ++b)
#pragma unroll
                for (int m = 0; m < 4; ++m)
#pragma unroll
                    for (int n = 0; n < 2; ++n) acc[a][b][m][n] = (f32x4){0.f, 0.f, 0.f, 0.f};
        cur = nxt; cA = nA; cB = nB; ++ui;
        if constexpr (ALIGN_EPI) { if (wr == 1) PG8_BAR; }
    }
    PG8_WAIT_V(0);
    if constexpr (!ALIGN_EPI) { if (wr == 0) PG8_BAR; }
    PG8_BAR;
    if constexpr (Epi::AFTER_DRAIN) { E.fused(acc, cur, wr, wc, fr, fq, lds, wid, lane); S.done(cur); }
#undef PG8_SA
#undef PG8_SB
#undef PG8_STAGE
#undef PG8_LD8
#undef PG8_LDA
#undef PG8_LDB
#undef PG8_MMA
#undef PG8_WAIT_V
#undef PG8_WAIT_L
#undef PG8_BAR
#undef PG8_SCHED
}
}

constexpr int BATCH = 16, SEQ = 4096, D = 1024, T = BATCH * SEQ;
constexpr int AW = 512, NH = 8, HD = 64, GWID = 512, INW = 2560;
constexpr int NKEYS = 128, NEXP = 16384, PH = 8, TOPK = 16, NSEL = PH * TOPK;
constexpr float EPS = 1e-6f;
constexpr float QSCALE = 0.125f * 1.4426950408889634f;
constexpr int NWAVES = 8, NTHR = 512;

constexpr size_t MiB = 1u << 20;
constexpr size_t WS_CTL = 0, CTL_ZERO_BYTES = 1 * MiB;
constexpr size_t WS_WIN = 2 * MiB;
constexpr size_t WS_WOUT = 8 * MiB;
constexpr size_t WS_WQK = 10 * MiB;
constexpr size_t WS_WSP = 14 * MiB;
constexpr size_t WS_PART = 15 * MiB;
constexpr size_t WS_EU = 20 * MiB;
constexpr size_t WS_EV = 52 * MiB;
constexpr size_t WS_SU = 36 * MiB, WS_SV = 37 * MiB;
constexpr size_t WS_HN = 84 * MiB;
constexpr size_t WS_X1B = 212 * MiB;
constexpr size_t WS_Q = 340 * MiB, WS_K = 404 * MiB, WS_V = 468 * MiB, WS_GU = 532 * MiB, WS_GV = 596 * MiB;
constexpr size_t WS_PO = 660 * MiB;
constexpr size_t WS_LSE = 852 * MiB;
constexpr size_t WS_SC = 340 * MiB;
constexpr size_t WS_IDX = 860 * MiB;
constexpr size_t WS_PACT = 340 * MiB;
constexpr size_t WS_COEF = 924 * MiB;
constexpr size_t WS_CS = 940 * MiB;
constexpr size_t WS_WQK8 = 1010 * MiB;
constexpr size_t WS_CSC = 1012 * MiB;
constexpr size_t WS_RN = 941 * MiB;
constexpr size_t WS_GATE = 892 * MiB;
constexpr size_t WS_XF8 = 944 * MiB;
constexpr size_t WS_END = 1013 * MiB;
constexpr int NSLICE = 4, SLW = D / NSLICE;
constexpr int CW_BAR = 4096;

constexpr int LDS_BYTES = 163840 - 2048;
constexpr int MISC_OFF = 160 * 1024 - 2048 - 256;

#define GAS __attribute__((address_space(1)))
#define LAS __attribute__((address_space(3)))
typedef unsigned short bf16;
typedef unsigned v4u __attribute__((ext_vector_type(4)));
typedef unsigned v2u __attribute__((ext_vector_type(2)));
typedef float f32x4 __attribute__((ext_vector_type(4)));
typedef float f32x16 __attribute__((ext_vector_type(16)));
typedef short bf16x8 __attribute__((ext_vector_type(8)));
typedef short s16x4 __attribute__((ext_vector_type(4)));
typedef short v4i16_t __attribute__((ext_vector_type(4)));
typedef __bf16 bf16x2_t __attribute__((ext_vector_type(2)));

typedef float f32x2_t __attribute__((ext_vector_type(2)));
__device__ __forceinline__ unsigned pk2(float lo, float hi) { const f32x2_t v = {lo, hi}; const bf16x2_t b = __builtin_convertvector(v, bf16x2_t); return __builtin_bit_cast(unsigned, b); }
__device__ __forceinline__ unsigned f2bf(float f) { return pk2(f, f) & 0xffffu; }
__device__ __forceinline__ float bflo(unsigned u) { return __uint_as_float(u << 16); }
__device__ __forceinline__ float bfhi(unsigned u) { return __uint_as_float(u & 0xffff0000u); }
#define DPPV(v, ctrl) __builtin_bit_cast(float, __builtin_amdgcn_update_dpp(0, __builtin_bit_cast(int, (v)), (ctrl), 0xF, 0xF, true))
__device__ __forceinline__ void swap16(float& a, float& b) { const v2u s = __builtin_amdgcn_permlane16_swap(__float_as_uint(a), __float_as_uint(b), false, false); const unsigned x = s.x, y = s.y; a = __uint_as_float(x); b = __uint_as_float(y); }
__device__ __forceinline__ void swap32(float& a, float& b) { const v2u s = __builtin_amdgcn_permlane32_swap(__float_as_uint(a), __float_as_uint(b), false, false); const unsigned x = s.x, y = s.y; a = __uint_as_float(x); b = __uint_as_float(y); }
__device__ __forceinline__ float sum_x16(float v) { float a = v, b = v; swap16(a, b); return a + b; }
__device__ __forceinline__ float sum_x32(float v) { float a = v, b = v; swap32(a, b); return a + b; }
__device__ __forceinline__ float max_x16(float v) { float a = v, b = v; swap16(a, b); return fmaxf(a, b); }
__device__ __forceinline__ float max_x32(float v) { float a = v, b = v; swap32(a, b); return fmaxf(a, b); }
__device__ __forceinline__ float row_sum16(float v) { float a = v; a += DPPV(a, 0xB1); a += DPPV(a, 0x4E); a += DPPV(a, 0x141); a += DPPV(a, 0x140); return a; }
__device__ __forceinline__ float row_max16(float v) { float a = v; a = fmaxf(a, DPPV(a, 0xB1)); a = fmaxf(a, DPPV(a, 0x4E)); a = fmaxf(a, DPPV(a, 0x141)); a = fmaxf(a, DPPV(a, 0x140)); return a; }
__device__ __forceinline__ float wave_sum(float v) { return sum_x32(sum_x16(row_sum16(v))); }
__device__ __forceinline__ float wave_max(float v) { return max_x32(max_x16(row_max16(v))); }
__device__ __forceinline__ int crow(int r, int hi) { return (r & 3) + 8 * (r >> 2) + 4 * hi; }
__device__ __forceinline__ float gelu_exact(float v) { return 0.5f * v * (1.0f + erff(v * 0.70710678118654752f)); }

#define CE16(l, a, b) { const float hi_ = fmaxf(l[a], l[b]), lo_ = fminf(l[a], l[b]); l[a] = hi_; l[b] = lo_; }
#define SORT16_DESC(l) do { CE16(l,0,1) CE16(l,2,3) CE16(l,0,2) CE16(l,1,3) CE16(l,1,2) CE16(l,4,5) CE16(l,6,7) CE16(l,4,6) CE16(l,5,7) CE16(l,5,6) CE16(l,0,4) CE16(l,2,6) CE16(l,2,4) CE16(l,1,5) CE16(l,3,7) CE16(l,3,5) CE16(l,1,2) CE16(l,3,4) CE16(l,5,6) CE16(l,8,9) CE16(l,10,11) CE16(l,8,10) CE16(l,9,11) CE16(l,9,10) CE16(l,12,13) CE16(l,14,15) CE16(l,12,14) CE16(l,13,15) CE16(l,13,14) CE16(l,8,12) CE16(l,10,14) CE16(l,10,12) CE16(l,9,13) CE16(l,11,15) CE16(l,11,13) CE16(l,9,10) CE16(l,11,12) CE16(l,13,14) CE16(l,0,8) CE16(l,4,12) CE16(l,4,8) CE16(l,2,10) CE16(l,6,14) CE16(l,6,10) CE16(l,2,4) CE16(l,6,8) CE16(l,10,12) CE16(l,1,9) CE16(l,5,13) CE16(l,5,9) CE16(l,3,11) CE16(l,7,15) CE16(l,7,11) CE16(l,3,5) CE16(l,7,9) CE16(l,11,13) CE16(l,1,2) CE16(l,3,4) CE16(l,5,6) CE16(l,7,8) CE16(l,9,10) CE16(l,11,12) CE16(l,13,14) } while (0)
#define BITONIC16_DESC(l) do { _Pragma("unroll") for (int d_ = 8; d_ >= 1; d_ >>= 1) _Pragma("unroll") for (int i_ = 0; i_ < 16; ++i_) if ((i_ & d_) == 0) { const float hi_ = fmaxf(l[i_], l[i_ + d_]), lo_ = fminf(l[i_], l[i_ + d_]); l[i_] = hi_; l[i_ + d_] = lo_; } } while (0)
#define MERGE16_REG(l, o) do { _Pragma("unroll") for (int i_ = 0; i_ < 16; ++i_) l[i_] = fmaxf(l[i_], o[15 - i_]); BITONIC16_DESC(l); } while (0)
#define MERGE16_XOR(l, mask) do { float o_[16]; _Pragma("unroll") for (int i_ = 0; i_ < 16; ++i_) o_[i_] = __shfl_xor(l[i_], (mask)); MERGE16_REG(l, o_); } while (0)

struct Ptrs {
    const float *x, *mix_g, *w_in, *q_g, *k_g, *vg_g, *w_sp, *b_sp, *ao_g, *go_g, *w_out, *ffn_g, *w_query, *keys_a, *keys_b, *exp_u, *exp_v;
    float* out; unsigned char* ws;
};
struct Args { Ptrs p; int ph_lo, ph_hi, probe, pad; };

__device__ __forceinline__ void p0_transpose_item(const float* W, int K, int N, bf16* WT, bool perm, LAS float* scr, int item, int lane) {
    const int nblk = N / 32, kb = item / nblk, nb = item % nblk, k0 = 64 * kb, n0 = 32 * nb;
    int pn0 = n0;
    if (perm) { const int tile = n0 >> 8, lb = (n0 & 255) >> 5; pn0 = (tile << 8) + 32 * (4 * (lb & 1) + (lb >> 1)); }
#pragma unroll 8
    for (int i = 0; i < 32; ++i) { const int kk = 2 * i + (lane >> 5); scr[kk * 33 + (lane & 31)] = W[(size_t)(k0 + kk) * N + n0 + (lane & 31)]; }
    asm volatile("s_waitcnt lgkmcnt(0)" ::: "memory");
    const int c = lane & 7;
#pragma unroll
    for (int j = 0; j < 4; ++j) { const int n = (lane >> 3) + 8 * j; const LAS float* s = scr + (8 * c) * 33 + n;
        v4u o; o.x = pk2(s[0 * 33], s[1 * 33]); o.y = pk2(s[2 * 33], s[3 * 33]); o.z = pk2(s[4 * 33], s[5 * 33]); o.w = pk2(s[6 * 33], s[7 * 33]);
        *(v4u*)(WT + (size_t)(pn0 + n) * K + k0 + 8 * c) = o; }
    asm volatile("s_waitcnt lgkmcnt(0)" ::: "memory");
}

__device__ __forceinline__ void p0_fold_item(const Ptrs& p, LAS unsigned char* lds, int it, int tid) {
    const int h = it >> 5, half = (it >> 4) & 1, d0 = (it & 15) * 64;
    LAS float* A = (LAS float*)lds;
    LAS float* Kt = (LAS float*)(lds + 33280);
    const float* wq = p.w_query + h * 256 + half * 128;
    for (int i = tid; i < 8192; i += NTHR) { const int dd = i >> 7, c = i & 127; A[dd * 129 + c] = wq[(size_t)(d0 + dd) * 2048 + c]; }
    const float* keys = half ? p.keys_b : p.keys_a;
    for (int i = tid; i < 16384; i += NTHR) Kt[i] = keys[i];
    __syncthreads();
    const int dd = tid & 63, kg = tid >> 6;
    float acc[16];
#pragma unroll
    for (int kk = 0; kk < 16; ++kk) acc[kk] = 0.f;
    for (int c = 0; c < 128; ++c) { const float a = A[dd * 129 + c];
#pragma unroll
        for (int kk = 0; kk < 16; ++kk) acc[kk] += a * Kt[(kg * 16 + kk) * 128 + c]; }
    const float g = p.ffn_g[d0 + dd];
    bf16* WQK = (bf16*)(p.ws + WS_WQK);
#pragma unroll
    for (int kk = 0; kk < 16; ++kk) { const int key = kg * 16 + kk, wcq = 2 * half + (key >> 6), kidx = key & 63;
        const int prow = 128 * (kidx >> 5) + 32 * wcq + 16 * ((kidx >> 4) & 1) + 4 * ((kidx >> 2) & 3) + (kidx & 3);
        WQK[(size_t)(h * 256 + prow) * 1024 + d0 + dd] = (bf16)f2bf(acc[kk] * g); }
    __syncthreads();
}

__device__ __forceinline__ void p0_prologue(const Ptrs& p, LAS unsigned char* lds, int tid, int lane, int wave, int vcu, int G) {
    for (int it = blockIdx.x; it < 256; it += G) p0_fold_item(p, lds, it, tid);
    __syncthreads();
    const int gw = vcu * NWAVES + wave, NGW = G * NWAVES;
    LAS float* scr = (LAS float*)(lds + wave * 16384);
    constexpr int I_IN = (D / 64) * (INW / 32), I_OUT = (D / 64) * (D / 32);
    bf16* WIN = (bf16*)(p.ws + WS_WIN); bf16* WOUT = (bf16*)(p.ws + WS_WOUT);
    for (int it = gw; it < I_IN + I_OUT; it += NGW) {
        if (it < I_IN) p0_transpose_item(p.w_in, D, INW, WIN, true, scr, it, lane);
        else p0_transpose_item(p.w_out, D, D, WOUT, false, scr, it - I_IN, lane);
    }
    const int gt = gw * 64 + lane, NGT = NGW * 64;
    {
        unsigned char* EU4 = p.ws + WS_EU; unsigned char* EV4 = p.ws + WS_EV; float* SU = (float*)(p.ws + WS_SU); float* SV = (float*)(p.ws + WS_SV);
        f32x4 gf[4];
#pragma unroll
        for (int j = 0; j < 4; ++j) gf[j] = *(const f32x4*)(p.ffn_g + lane * 16 + 4 * j);
        f32x4 nv[4];
        if (gw < 2 * NEXP) { const float* src0 = ((gw & 1) ? p.exp_v : p.exp_u) + (size_t)(gw >> 1) * D + lane * 16;
#pragma unroll
            for (int j = 0; j < 4; ++j) nv[j] = *(const f32x4*)(src0 + 4 * j); }
        for (int r = gw; r < 2 * NEXP; r += NGW) {
            const int e = r >> 1, tb = r & 1;
            f32x4 v[4]; float ss = 0.f;
#pragma unroll
            for (int j = 0; j < 4; ++j) v[j] = nv[j];
            { const int rn = (r + NGW < 2 * NEXP) ? r + NGW : r; const float* srcn = ((rn & 1) ? p.exp_v : p.exp_u) + (size_t)(rn >> 1) * D + lane * 16;
#pragma unroll
              for (int j = 0; j < 4; ++j) nv[j] = *(const f32x4*)(srcn + 4 * j); }
#pragma unroll
            for (int j = 0; j < 4; ++j) { if (!tb) v[j] = v[j] * gf[j];
                ss += (v[j][0] * v[j][0] + v[j][1] * v[j][1]) + (v[j][2] * v[j][2] + v[j][3] * v[j][3]); }
            ss = wave_sum(ss);
            const float sc = (ss > 0.f) ? 0.5f * sqrtf(ss * (1.f / D)) : 1.f, inv = 1.f / sc;
            unsigned wlo = 0u, whi = 0u;
#pragma unroll
            for (int j = 0; j < 4; ++j)
#pragma unroll
                for (int i = 0; i < 4; ++i) { const float y = v[j][i] * inv, a = fabsf(y);
                    const unsigned code = (unsigned)(a > 0.25f) + (unsigned)(a > 0.75f) + (unsigned)(a > 1.25f) + (unsigned)(a > 1.75f) + (unsigned)(a > 2.5f) + (unsigned)(a > 3.5f) + (unsigned)(a > 5.0f) + ((y < 0.f) ? 8u : 0u);
                    const int n = 4 * j + i; if (n < 8) wlo |= code << (4 * n); else whi |= code << (4 * (n - 8)); }
            unsigned char* dst = (tb ? EV4 : EU4) + ((size_t)(lane >> 4) * NEXP + e) * 128 + (lane & 15) * 8;
            if (tb) {
                LAS unsigned* cs4 = (LAS unsigned*)scr;
                cs4[lane * 2] = wlo; cs4[lane * 2 + 1] = whi;
                asm volatile("s_waitcnt lgkmcnt(0)" ::: "memory");
                const int q = lane & 15, sl = lane >> 4; unsigned tlo = 0u, thi = 0u;
#pragma unroll
                for (int n = 0; n < 16; ++n) { const int m = 4 * (n & 3);
                    const unsigned w = cs4[(sl * 16 + 4 * (q & 3) + (n >> 2)) * 2 + (m >> 3)]; const unsigned code = (w >> (4 * ((m & 7) + (q >> 2)))) & 0xfu;
                    if (n < 8) tlo |= code << (4 * n); else thi |= code << (4 * (n - 8)); }
                asm volatile("s_waitcnt lgkmcnt(0)" ::: "memory");
                wlo = tlo; whi = thi;
            }
            *(v2u*)dst = (v2u){wlo, whi};
            if (lane == 0) (tb ? SV : SU)[e] = sc;
        }
    }
    bf16* WSP = (bf16*)(p.ws + WS_WSP);
    for (int i = gt; i < 4 * 128 * 128; i += NGT) {
        const int pj = i & 127, ii = (i >> 7) & 127, g = i >> 14;
        const int ks = pj >> 4, hi = (pj >> 3) & 1, jj = pj & 7, j = 16 * ks + 4 * hi + (jj & 3) + 8 * (jj >> 2);
        WSP[i] = (bf16)((j <= ii) ? f2bf(p.w_sp[(g * 128 + ii) * 128 + j]) : 0u);
    }
    bf16* HN = (bf16*)(p.ws + WS_HN);
    {
        f32x4 g4[4];
#pragma unroll
        for (int j = 0; j < 4; ++j) g4[j] = *((const f32x4*)p.mix_g + lane + 64 * j);
        f32x4 nx[4];
        if (gw < T) {
#pragma unroll
            for (int j = 0; j < 4; ++j) nx[j] = ((const f32x4*)(p.x + (size_t)gw * D) + lane)[64 * j]; }
        for (int m = gw; m < T; m += NGW) {
            f32x4 v[4]; float s = 0.f;
#pragma unroll
            for (int j = 0; j < 4; ++j) v[j] = nx[j];
            const int mn = (m + NGW < T) ? m + NGW : m;
#pragma unroll
            for (int j = 0; j < 4; ++j) nx[j] = ((const f32x4*)(p.x + (size_t)mn * D) + lane)[64 * j];
#pragma unroll
            for (int j = 0; j < 4; ++j) s += (v[j].x * v[j].x + v[j].y * v[j].y) + (v[j].z * v[j].z + v[j].w * v[j].w);
            const float r = rsqrtf(wave_sum(s) * (1.f / D) + EPS);
            v2u* o8 = (v2u*)(HN + (size_t)m * D) + lane;
#pragma unroll
            for (int j = 0; j < 4; ++j) { const f32x4 g = g4[j]; v2u o; o.x = pk2(v[j].x * r * g.x, v[j].y * r * g.y); o.y = pk2(v[j].z * r * g.z, v[j].w * r * g.w); o8[64 * j] = o; }
        }
    }
}

struct EpiProj {
    static constexpr bool PERM = true, AFTER_DRAIN = false;
    bf16 *Q, *K, *V, *GU, *GV; const float *qg, *kg;
    __device__ __forceinline__ void operator()(const pg8::f32x4 (&acc)[2][2][4][2], const pg8::Unit& u, int wr, int wc, int fr, int fq) const {
        const int type = u.pn >> 1;
        bf16* base = type == 0 ? Q : type == 1 ? K : type == 2 ? V : type == 3 ? GU : GV;
        const int ct = (u.pn & 1) * 256 + wc * 64 + 8 * fq;
        const int row0 = u.pm * 256 + wr * 64 + fr;
        if (type <= 1) {
            const float* g = type == 0 ? qg : kg; const float sc = type == 0 ? QSCALE : 1.f;
            f32x4 gv[2][2];
#pragma unroll
            for (int bj = 0; bj < 2; ++bj)
#pragma unroll
                for (int n = 0; n < 2; ++n) gv[bj][n] = *(const f32x4*)(g + 32 * bj + 8 * fq + 4 * n);
#pragma unroll
            for (int ai = 0; ai < 2; ++ai)
#pragma unroll
                for (int m = 0; m < 4; ++m) {
                    float ss = 0.f;
#pragma unroll
                    for (int bj = 0; bj < 2; ++bj)
#pragma unroll
                        for (int n = 0; n < 2; ++n) { const f32x4 v = acc[ai][bj][m][n]; ss += (v[0] * v[0] + v[1] * v[1]) + (v[2] * v[2] + v[3] * v[3]); }
                    ss = sum_x32(sum_x16(ss));
                    const float r = rsqrtf(ss * (1.f / 64.f) + EPS) * sc;
                    bf16* rowp = base + (size_t)(row0 + ai * 128 + m * 16) * 512 + ct;
#pragma unroll
                    for (int bj = 0; bj < 2; ++bj) { const f32x4 v0 = acc[ai][bj][m][0] * gv[bj][0] * r, v1 = acc[ai][bj][m][1] * gv[bj][1] * r;
                        v4u w; w.x = pk2(v0[0], v0[1]); w.y = pk2(v0[2], v0[3]); w.z = pk2(v1[0], v1[1]); w.w = pk2(v1[2], v1[3]);
                        *(v4u*)(rowp + 32 * bj) = w; }
                }
        } else {
#pragma unroll
            for (int ai = 0; ai < 2; ++ai)
#pragma unroll
                for (int m = 0; m < 4; ++m) {
                    bf16* rowp = base + (size_t)(row0 + ai * 128 + m * 16) * 512 + ct;
#pragma unroll
                    for (int bj = 0; bj < 2; ++bj) { f32x4 v0 = acc[ai][bj][m][0], v1 = acc[ai][bj][m][1];
                        if (type >= 3) { pg8::f32x2 a = pg8::gelu_pk((pg8::f32x2){v0[0], v0[1]}), b = pg8::gelu_pk((pg8::f32x2){v0[2], v0[3]}), c = pg8::gelu_pk((pg8::f32x2){v1[0], v1[1]}), d = pg8::gelu_pk((pg8::f32x2){v1[2], v1[3]});
                            v0 = (f32x4){a.x, a.y, b.x, b.y}; v1 = (f32x4){c.x, c.y, d.x, d.y}; }
                        v4u w; w.x = pk2(v0[0], v0[1]); w.y = pk2(v0[2], v0[3]); w.z = pk2(v1[0], v1[1]); w.w = pk2(v1[2], v1[3]);
                        *(v4u*)(rowp + 32 * bj) = w; }
                }
        }
    }
};
struct EpiOut {
    static constexpr bool PERM = true, AFTER_DRAIN = false;
    const float* X; float* OUT; bf16* X1B; float* PART; unsigned char* XF8;
    __device__ __forceinline__ void operator()(const pg8::f32x4 (&acc)[2][2][4][2], const pg8::Unit& u, int wr, int wc, int fr, int fq) const {
        const int row0 = u.pm * 256 + wr * 64 + fr, col0 = u.pn * 256 + wc * 32 + 8 * fq;
#pragma unroll
        for (int ai = 0; ai < 2; ++ai) {
            f32x4 xv[4][2][2];
#pragma unroll
            for (int m = 0; m < 4; ++m)
#pragma unroll
                for (int bj = 0; bj < 2; ++bj)
#pragma unroll
                    for (int n = 0; n < 2; ++n) xv[m][bj][n] = *(const f32x4*)(X + (size_t)(row0 + ai * 128 + m * 16) * D + col0 + bj * 128 + n * 4);
#pragma unroll
            for (int m = 0; m < 4; ++m) {
                const int row = row0 + ai * 128 + m * 16; float ss = 0.f;
#pragma unroll
                for (int bj = 0; bj < 2; ++bj) { const size_t off = (size_t)row * D + col0 + bj * 128;
                    const f32x4 o0 = xv[m][bj][0] + acc[ai][bj][m][0], o1 = xv[m][bj][1] + acc[ai][bj][m][1];
                    ss += ((o0[0] * o0[0] + o0[1] * o0[1]) + (o0[2] * o0[2] + o0[3] * o0[3])) + ((o1[0] * o1[0] + o1[1] * o1[1]) + (o1[2] * o1[2] + o1[3] * o1[3]));
                    v4u w; w.x = pk2(o0[0], o0[1]); w.y = pk2(o0[2], o0[3]); w.z = pk2(o1[0], o1[1]); w.w = pk2(o1[2], o1[3]); *(v4u*)(X1B + off) = w;
                    int lo = 0, hi = 0;
                    lo = __builtin_amdgcn_cvt_pk_fp8_f32(o0[0] * 8.f, o0[1] * 8.f, lo, false); lo = __builtin_amdgcn_cvt_pk_fp8_f32(o0[2] * 8.f, o0[3] * 8.f, lo, true);
                    hi = __builtin_amdgcn_cvt_pk_fp8_f32(o1[0] * 8.f, o1[1] * 8.f, hi, false); hi = __builtin_amdgcn_cvt_pk_fp8_f32(o1[2] * 8.f, o1[3] * 8.f, hi, true);
                    *(v2u*)(XF8 + off) = (v2u){(unsigned)lo, (unsigned)hi}; }
                ss = sum_x32(sum_x16(ss));
                if (fq == 0) PART[(size_t)row * 16 + u.pn * 4 + wc] = ss;
            }
        }
    }
};
struct EpiF32 {
    static constexpr bool PERM = false, AFTER_DRAIN = false;
    float* C; int ldc;
    __device__ __forceinline__ void operator()(const pg8::f32x4 (&acc)[2][2][4][2], const pg8::Unit& u, int wr, int wc, int fr, int fq) const {
        const int row0 = u.pm * 256 + wr * 64 + fr, col0 = u.pn * 256 + wc * 32 + 4 * fq;
#pragma unroll
        for (int ai = 0; ai < 2; ++ai)
#pragma unroll
            for (int m = 0; m < 4; ++m) { float* rowp = C + (size_t)(row0 + ai * 128 + m * 16) * ldc + col0;
#pragma unroll
                for (int bj = 0; bj < 2; ++bj)
#pragma unroll
                    for (int n = 0; n < 2; ++n) *(f32x4*)(rowp + bj * 128 + n * 16) = acc[ai][bj][m][n]; }
    }
};

struct EpiTopk {
    static constexpr bool PERM = false, AFTER_DRAIN = false;
    float* TOPW;
    __device__ __forceinline__ void operator()(const pg8::f32x4 (&acc)[2][2][4][2], const pg8::Unit& u, int wr, int wc, int fr, int fq) const {
        const int row0 = u.pm * 256 + wr * 64 + fr; unsigned kb = 64u * (wc & 1) + 4u * fq;
        asm volatile("" : "+v"(kb));
#pragma unroll
        for (int ai = 0; ai < 2; ++ai) {
            float x[16], y[16], r[16];
#define TOPK_PACK(dst, m) do { _Pragma("unroll") for (int bj = 0; bj < 2; ++bj) _Pragma("unroll") for (int n = 0; n < 2; ++n) _Pragma("unroll") for (int i = 0; i < 4; ++i) \
                dst[8 * bj + 4 * n + i] = __uint_as_float(((__float_as_uint(acc[ai][bj][m][n][i]) & ~0x7fu) | kb) | (32u * bj + 16u * n + i));   \
                SORT16_DESC(dst); } while (0)
            TOPK_PACK(x, 0); TOPK_PACK(r, 1);
#pragma unroll
            for (int i = 0; i < 16; ++i) swap16(x[i], r[i]);
            MERGE16_REG(x, r);
            __builtin_amdgcn_sched_barrier(0);
            TOPK_PACK(y, 2); TOPK_PACK(r, 3);
#pragma unroll
            for (int i = 0; i < 16; ++i) swap16(y[i], r[i]);
            MERGE16_REG(y, r);
            __builtin_amdgcn_sched_barrier(0);
#pragma unroll
            for (int i = 0; i < 16; ++i) { r[i] = y[i]; swap32(x[i], r[i]); }
            MERGE16_REG(x, r);
#undef TOPK_PACK
            f32x4* o = (f32x4*)(TOPW + (((size_t)(row0 + ai * 128 + fq * 16) * 8 + u.pn) * 4 + wc) * 16);
            o[0] = (f32x4){x[0], x[1], x[2], x[3]}; o[1] = (f32x4){x[4], x[5], x[6], x[7]}; o[2] = (f32x4){x[8], x[9], x[10], x[11]}; o[3] = (f32x4){x[12], x[13], x[14], x[15]};
        }
    }
};

constexpr int A_KP = 1152, A_KT = 8 * A_KP;
constexpr int A_K = 0, A_V = 6 * A_KT, A_ST = A_V + 49152, A_STW = 32 * 144;
struct AttnU { int h, pat, dl, m0, jlo; size_t rowbase; };
__device__ __forceinline__ AttnU attn_decode(int unit) {
    AttnU u; const int bh = unit / 48, rem = unit % 48, k16 = rem & 15; u.pat = rem >> 4;
    const int b = bh >> 3, nb = 16 >> (2 * u.pat), r = k16 / nb, qb = k16 % nb;
    u.h = bh & 7; u.dl = 1 << (2 * u.pat); u.m0 = qb * 256; u.jlo = (qb == 0) ? 2 : 0; u.rowbase = (size_t)b * SEQ + r; return u;
}
__device__ __forceinline__ long attn_off(const AttnU& u, int m) { return (((long)u.rowbase + (long)m * u.dl) * 512 + u.h * 64) * 2; }
__device__ __forceinline__ void attn_dma_k(const Ptrs& p, LAS unsigned char* lds, const AttnU& u, int lane, int w) {
    const unsigned char* kb = p.ws + WS_K + attn_off(u, u.m0 - 128 + 8 * w); const unsigned voff = (unsigned)((lane & 7) * u.dl) * 1024u + (lane >> 3) * 16u;
#pragma unroll
    for (int j = 0; j < 6; ++j) if (j >= u.jlo)
        __builtin_amdgcn_global_load_lds((const unsigned*)(kb + (size_t)(j * 64 * u.dl) * 1024 + voff), (LAS unsigned*)(lds + A_K + j * A_KT + w * A_KP), 16, 0, 0);
}
__device__ __forceinline__ void attn_dma_v(const Ptrs& p, LAS unsigned char* lds, const AttnU& u, int lane, int w) {
    const unsigned char* vb = p.ws + WS_V + attn_off(u, u.m0 - 128 + 8 * w); const unsigned voff = (unsigned)(((lane >> 2) & 7) * u.dl) * 1024u + (lane >> 5) * 64u + (lane & 3) * 16u;
#pragma unroll
    for (int j = 0; j < 6; ++j) if (j >= u.jlo)
        __builtin_amdgcn_global_load_lds((const unsigned*)(vb + (size_t)(j * 64 * u.dl) * 1024 + voff), (LAS unsigned*)(lds + A_V + j * 8192 + w * 1024), 16, 0, 0);
}
__device__ __forceinline__ void attn_dma_q(const Ptrs& p, LAS unsigned char* lds, const AttnU& u, int lane, int w) {
    const unsigned char* qb = p.ws + WS_Q + attn_off(u, u.m0 + 32 * w); const unsigned voff = (unsigned)((lane & 7) * u.dl) * 1024u + (lane >> 3) * 16u;
#pragma unroll
    for (int i = 0; i < 4; ++i)
        __builtin_amdgcn_global_load_lds((const unsigned*)(qb + (size_t)(i * 8 * u.dl) * 1024 + voff), (LAS unsigned*)(lds + A_ST + w * A_STW + i * 1024), 16, 0, 0);
}
__device__ __forceinline__ void attn_read_q(bf16x8 (&q)[4], LAS unsigned char* lds, int lane, int w) {
    const int r32 = lane & 31, hi = lane >> 5;
    const LAS unsigned char* qs = lds + A_ST + w * A_STW + (r32 >> 3) * 1024 + hi * 128 + (r32 & 7) * 16;
    asm volatile("s_waitcnt vmcnt(0)" ::: "memory");
#pragma unroll
    for (int d0 = 0; d0 < 4; ++d0) q[d0] = *(const LAS bf16x8*)(qs + d0 * 256);
    asm volatile("s_waitcnt lgkmcnt(0)" ::: "memory");
}
#define ATT_BAR_VM() do { asm volatile("s_waitcnt vmcnt(0) lgkmcnt(0)" ::: "memory"); __builtin_amdgcn_s_barrier(); asm volatile("" ::: "memory"); } while (0)
#define ATT_BAR_LDS() do { asm volatile("s_waitcnt lgkmcnt(0)" ::: "memory"); __builtin_amdgcn_s_barrier(); asm volatile("" ::: "memory"); } while (0)
template <bool FIRST>
__device__ __forceinline__ void attn_pv_tile(f32x16 (&o)[2], const f32x16& zacc, const v4u (&pwi)[2], const LAS unsigned char* vb) {
#pragma unroll
    for (int ks = 0; ks < 2; ++ks) {
        const bf16x8 pa = __builtin_bit_cast(bf16x8, pwi[ks]);
#pragma unroll
        for (int d0 = 0; d0 < 2; ++d0) {
            const s16x4 lo = __builtin_bit_cast(s16x4, __builtin_amdgcn_ds_read_tr16_b64_v4i16((LAS v4i16_t*)(vb + d0 * 512 + ks * 2048)));
            const s16x4 hh = __builtin_bit_cast(s16x4, __builtin_amdgcn_ds_read_tr16_b64_v4i16((LAS v4i16_t*)(vb + d0 * 512 + ks * 2048 + 1024)));
            const bf16x8 vf = (bf16x8){lo[0], lo[1], lo[2], lo[3], hh[0], hh[1], hh[2], hh[3]};
            if (FIRST && ks == 0) o[d0] = __builtin_amdgcn_mfma_f32_32x32x16_bf16(vf, pa, zacc, 0, 0, 0);
            else o[d0] = __builtin_amdgcn_mfma_f32_32x32x16_bf16(vf, pa, o[d0], 0, 0, 0);
        }
    }
}
__device__ __forceinline__ void attn_compute(const Ptrs& p, LAS unsigned char* lds, const AttnU& u, const AttnU& un, bool has_next, bf16x8 (&qr)[4], int lane, int w) {
    const int r32 = lane & 31, hi = lane >> 5, glo = 2 * u.jlo;
    const float NEGINF = -INFINITY;
    f32x16 zacc = {}; asm volatile("" : "+v"(zacc));
    f32x16 sc[5];
#pragma unroll
    for (int i = 0; i < 5; ++i) {
        const int g = w + i;
        f32x16 a;
        if (g >= glo) {
            const LAS unsigned char* kb = lds + A_K + (g >> 1) * A_KT + ((g & 1) * 4 + (r32 >> 3)) * A_KP + hi * 128 + (r32 & 7) * 16;
            a = __builtin_amdgcn_mfma_f32_32x32x16_bf16(*(const LAS bf16x8*)(kb), qr[0], zacc, 0, 0, 0);
#pragma unroll
            for (int d0 = 1; d0 < 4; ++d0) a = __builtin_amdgcn_mfma_f32_32x32x16_bf16(*(const LAS bf16x8*)(kb + d0 * 256), qr[d0], a, 0, 0, 0);
            if (i == 0) {
#pragma unroll
                for (int rr = 0; rr < 16; ++rr) a[rr] = (crow(rr, hi) >= r32) ? a[rr] : NEGINF; }
            if (i == 4) {
#pragma unroll
                for (int rr = 0; rr < 16; ++rr) a[rr] = (crow(rr, hi) <= r32) ? a[rr] : NEGINF; }
        } else {
#pragma unroll
            for (int rr = 0; rr < 16; ++rr) a[rr] = NEGINF; }
        sc[i] = a;
    }
    ATT_BAR_LDS();
    if (has_next) { attn_dma_k(p, lds, un, lane, w); attn_dma_q(p, lds, un, lane, w); }
    float mx = NEGINF;
#pragma unroll
    for (int i = 0; i < 5; ++i)
#pragma unroll
        for (int rr = 0; rr < 16; ++rr) mx = fmaxf(mx, sc[i][rr]);
    mx = max_x32(mx);
    const f32x2_t mx2 = {mx, mx};
    f32x2_t l2 = {0.f, 0.f};
    v4u pw[5][2];
#pragma unroll
    for (int i = 0; i < 5; ++i) {
        unsigned pk[8];
#pragma unroll
        for (int r2 = 0; r2 < 8; ++r2) { const f32x2_t d = (f32x2_t){sc[i][2 * r2], sc[i][2 * r2 + 1]} - mx2; const f32x2_t e = {__builtin_amdgcn_exp2f(d.x), __builtin_amdgcn_exp2f(d.y)}; l2 += e; pk[r2] = pk2(e.x, e.y); }
        pw[i][0] = (v4u){pk[0], pk[1], pk[2], pk[3]};
        pw[i][1] = (v4u){pk[4], pk[5], pk[6], pk[7]};
    }
    float l = l2.x + l2.y;
    l = sum_x32(l);
    if (has_next) attn_read_q(qr, lds, lane, w);
    f32x16 o[2];
    const int vlane = ((lane >> 4) & 1) * 32 + (lane & 3) * 8 + (4 * hi + ((lane & 15) >> 2)) * 64;
    { const int g = w + 4; attn_pv_tile<true>(o, zacc, pw[4], lds + A_V + (g >> 1) * 8192 + (g & 1) * 4096 + vlane); }
#pragma unroll
    for (int i = 0; i < 4; ++i) {
        const int g = w + i;
        if (g >= glo) attn_pv_tile<false>(o, zacc, pw[i], lds + A_V + (g >> 1) * 8192 + (g & 1) * 4096 + vlane);
    }
    ATT_BAR_LDS();
    if (has_next) attn_dma_v(p, lds, un, lane, w);
    const float rl = __builtin_amdgcn_rcpf(l);
    if (hi == 0) *(float*)(p.ws + WS_LSE + ((size_t)u.pat * T * 8 + (u.rowbase + (size_t)(u.m0 + 32 * w) * u.dl) * 8 + u.h) * 4 + (unsigned)(r32 * u.dl) * 32u) = mx + __builtin_amdgcn_logf(l);
    LAS unsigned char* stw = lds + A_ST + w * A_STW;
    LAS unsigned char* stg = stw + r32 * 144 + hi * 8;
#pragma unroll
    for (int d0 = 0; d0 < 2; ++d0)
#pragma unroll
        for (int q4 = 0; q4 < 4; ++q4)
            *(LAS v2u*)(stg + d0 * 64 + q4 * 16) = (v2u){pk2(o[d0][4 * q4] * rl, o[d0][4 * q4 + 1] * rl), pk2(o[d0][4 * q4 + 2] * rl, o[d0][4 * q4 + 3] * rl)};
    asm volatile("s_waitcnt lgkmcnt(0)" ::: "memory");
    unsigned char* pob = p.ws + WS_PO + (size_t)u.pat * T * 1024 + attn_off(u, u.m0 + 32 * w); const unsigned pvoff = (unsigned)((lane >> 3) * u.dl) * 1024u + (lane & 7) * 16u;
#pragma unroll
    for (int i = 0; i < 4; ++i) { const v4u v = *(const LAS v4u*)(stw + (i * 8 + (lane >> 3)) * 144 + (lane & 7) * 16);
        *(v4u*)(pob + (size_t)(i * 8 * u.dl) * 1024 + pvoff) = v; }
}
__device__ __forceinline__ void attn_phase(const Ptrs& p, LAS unsigned char* lds, int vcu, int G, int lane, int w) {
    const int NU = BATCH * NH * 48;
    if (vcu >= NU) return;
    AttnU u = attn_decode(vcu);
    bf16x8 qr[4];
    attn_dma_k(p, lds, u, lane, w); attn_dma_v(p, lds, u, lane, w); attn_dma_q(p, lds, u, lane, w); attn_read_q(qr, lds, lane, w);
    for (int unit = vcu; unit < NU; unit += G) {
        const bool has_next = unit + G < NU;
        const AttnU un = attn_decode(has_next ? unit + G : unit);
        ATT_BAR_VM();
        attn_compute(p, lds, u, un, has_next, qr, lane, w);
        u = un;
    }
    ATT_BAR_VM();
}

__device__ __forceinline__ void gmlp_unit(const Ptrs& p, LAS unsigned char* lds, int unit, int tid, int lane, int w) {
    const size_t rowbase = (size_t)unit * 128;
    const bf16* GU = (const bf16*)(p.ws + WS_GU); const bf16* GV = (const bf16*)(p.ws + WS_GV); const bf16* WSP = (const bf16*)(p.ws + WS_WSP);
    bf16* MG = (bf16*)(p.ws + WS_HN);
    const int r32 = lane & 31, hi = lane >> 5;
    {
        const int g = lane >> 4; f32x4 ga = *(const f32x4*)(p.vg_g + g * 128 + (lane & 15) * 8), gb = *(const f32x4*)(p.vg_g + g * 128 + (lane & 15) * 8 + 4);
#pragma unroll 4
        for (int it = 0; it < 16; ++it) {
            const int j = it * 8 + w;
            const v4u raw = *(const v4u*)(GV + (rowbase + j) * 512 + lane * 8);
            float v[8] = {bflo(raw.x), bfhi(raw.x), bflo(raw.y), bfhi(raw.y), bflo(raw.z), bfhi(raw.z), bflo(raw.w), bfhi(raw.w)};
            float ss = 0.f;
#pragma unroll
            for (int i = 0; i < 8; ++i) ss += v[i] * v[i];
            ss = row_sum16(ss);
            const float rn = rsqrtf(ss * (1.f / 128.f) + EPS);
            v4u o; o.x = pk2(v[0] * rn * ga.x, v[1] * rn * ga.y); o.y = pk2(v[2] * rn * ga.z, v[3] * rn * ga.w); o.z = pk2(v[4] * rn * gb.x, v[5] * rn * gb.y); o.w = pk2(v[6] * rn * gb.z, v[7] * rn * gb.w);
            *(LAS v4u*)(lds + ((lane >> 2) * 8 + (j >> 4)) * 1024 + (j & 15) * 64 + (lane & 3) * 16) = o;
        }
    }
    __syncthreads();
    const int ib = w & 3, gp = w >> 2;
    f32x16 acc[8];
#pragma unroll
    for (int i = 0; i < 8; ++i) acc[i] = (f32x16){};
    const int vlane = ((lane >> 4) & 1) * 32 + (lane & 3) * 8 + (4 * hi + ((lane & 15) >> 2)) * 64;
#pragma unroll
    for (int g2 = 0; g2 < 2; ++g2) {
        const int g = 2 * gp + g2;
        for (int ks = 0; ks < 2 * ib + 2; ++ks) {
            const bf16x8 af = *(const bf16x8*)(WSP + (size_t)((g * 128 + 32 * ib + r32) * 128 + 16 * ks + 8 * hi));
#pragma unroll
            for (int ct = 0; ct < 4; ++ct) {
                const LAS unsigned char* vb = lds + ((g * 4 + ct) * 8 + ks) * 1024 + vlane;
                const s16x4 lo = __builtin_bit_cast(s16x4, __builtin_amdgcn_ds_read_tr16_b64_v4i16((LAS v4i16_t*)(vb)));
                const s16x4 hh = __builtin_bit_cast(s16x4, __builtin_amdgcn_ds_read_tr16_b64_v4i16((LAS v4i16_t*)(vb + 512)));
                const bf16x8 vf = (bf16x8){lo[0], lo[1], lo[2], lo[3], hh[0], hh[1], hh[2], hh[3]};
                acc[g2 * 4 + ct] = __builtin_amdgcn_mfma_f32_32x32x16_bf16(af, vf, acc[g2 * 4 + ct], 0, 0, 0);
            }
        }
    }
    __syncthreads();
#pragma unroll
    for (int g2 = 0; g2 < 2; ++g2) {
        const int g = 2 * gp + g2;
#pragma unroll
        for (int rr = 0; rr < 16; ++rr) {
            const int i = 32 * ib + crow(rr, hi); const float bias = p.b_sp[g * 128 + i];
#pragma unroll
            for (int ct = 0; ct < 4; ++ct) {
                const int c = g * 128 + ct * 32 + r32;
                *(LAS bf16*)(lds + (i * 512 + c) * 2) = (bf16)f2bf(acc[g2 * 4 + ct][rr] + bias);
            }
        }
    }
    __syncthreads();
    {
        const f32x4 ga = *(const f32x4*)(p.go_g + lane * 8), gb = *(const f32x4*)(p.go_g + lane * 8 + 4);
#pragma unroll 4
        for (int ii = 0; ii < 16; ++ii) {
            const int i = 16 * w + ii;
            const v4u raw = *(const LAS v4u*)(lds + (i * 512 + lane * 8) * 2);
            const v4u gur = *(const v4u*)(GU + (rowbase + i) * 512 + lane * 8);
            const unsigned z0 = raw.x, z1 = raw.y, z2 = raw.z, z3 = raw.w, u0 = gur.x, u1 = gur.y, u2 = gur.z, u3 = gur.w;
            float v[8] = {bflo(z0) * bflo(u0), bfhi(z0) * bfhi(u0), bflo(z1) * bflo(u1), bfhi(z1) * bfhi(u1), bflo(z2) * bflo(u2), bfhi(z2) * bfhi(u2), bflo(z3) * bflo(u3), bfhi(z3) * bfhi(u3)};
            float ss = 0.f;
#pragma unroll
            for (int k = 0; k < 8; ++k) ss += v[k] * v[k];
            const float rn = rsqrtf(wave_sum(ss) * (1.f / 512.f) + EPS);
            v4u o; o.x = pk2(v[0] * rn * ga.x, v[1] * rn * ga.y); o.y = pk2(v[2] * rn * ga.z, v[3] * rn * ga.w); o.z = pk2(v[4] * rn * gb.x, v[5] * rn * gb.y); o.w = pk2(v[6] * rn * gb.z, v[7] * rn * gb.w);
            *(v4u*)(MG + (rowbase + i) * 1024 + 512 + lane * 8) = o;
        }
    }
    __syncthreads();
}

struct CombIn { v4u a, b, c; float l0, l1, l2; };
__device__ __forceinline__ CombIn combine_load(const Ptrs& p, size_t row, int lane) {
    const bf16* PO = (const bf16*)(p.ws + WS_PO); const float* LSE = (const float*)(p.ws + WS_LSE); const int h = lane >> 3;
    CombIn k; k.l0 = LSE[row * 8 + h]; k.l1 = LSE[(size_t)T * 8 + row * 8 + h]; k.l2 = LSE[(size_t)2 * T * 8 + row * 8 + h];
    k.a = *(const v4u*)(PO + row * 512 + lane * 8); k.b = *(const v4u*)(PO + (size_t)T * 512 + row * 512 + lane * 8); k.c = *(const v4u*)(PO + (size_t)2 * T * 512 + row * 512 + lane * 8); return k;
}
__device__ __forceinline__ void combine_row(const Ptrs& p, const CombIn& k, const f32x4 ga, const f32x4 gb, size_t row, int lane) {
    bf16* MG = (bf16*)(p.ws + WS_HN);
    const float l0 = k.l0, l1 = k.l1, l2 = k.l2; const v4u a = k.a, b = k.b, c = k.c;
    const float mx = fmaxf(l0, fmaxf(l1, l2));
    float w0 = __builtin_amdgcn_exp2f(l0 - mx), w1 = __builtin_amdgcn_exp2f(l1 - mx), w2 = __builtin_amdgcn_exp2f(l2 - mx);
    const float inv = 1.f / (w0 + w1 + w2); w0 *= inv; w1 *= inv; w2 *= inv;
    const unsigned a0 = a.x, a1 = a.y, a2 = a.z, a3 = a.w, b0 = b.x, b1 = b.y, b2 = b.z, b3 = b.w, c0 = c.x, c1 = c.y, c2 = c.z, c3 = c.w;
    float v[8];
    v[0] = w0 * bflo(a0) + w1 * bflo(b0) + w2 * bflo(c0); v[1] = w0 * bfhi(a0) + w1 * bfhi(b0) + w2 * bfhi(c0);
    v[2] = w0 * bflo(a1) + w1 * bflo(b1) + w2 * bflo(c1); v[3] = w0 * bfhi(a1) + w1 * bfhi(b1) + w2 * bfhi(c1);
    v[4] = w0 * bflo(a2) + w1 * bflo(b2) + w2 * bflo(c2); v[5] = w0 * bfhi(a2) + w1 * bfhi(b2) + w2 * bfhi(c2);
    v[6] = w0 * bflo(a3) + w1 * bflo(b3) + w2 * bflo(c3); v[7] = w0 * bfhi(a3) + w1 * bfhi(b3) + w2 * bfhi(c3);
    float ss = 0.f;
#pragma unroll
    for (int q = 0; q < 8; ++q) ss += v[q] * v[q];
    const float rn = rsqrtf(wave_sum(ss) * (1.f / 512.f) + EPS);
    v4u o; o.x = pk2(v[0] * rn * ga.x, v[1] * rn * ga.y); o.y = pk2(v[2] * rn * ga.z, v[3] * rn * ga.w); o.z = pk2(v[4] * rn * gb.x, v[5] * rn * gb.y); o.w = pk2(v[6] * rn * gb.z, v[7] * rn * gb.w);
    *(v4u*)(MG + row * 1024 + lane * 8) = o;
}
__device__ __forceinline__ void combine_phase(const Ptrs& p, int gw, int NGW, int lane) {
    if (gw >= T) return;
    const f32x4 ga = *(const f32x4*)(p.ao_g + lane * 8), gb = *(const f32x4*)(p.ao_g + lane * 8 + 4);
    CombIn nx = combine_load(p, (size_t)gw, lane);
    for (int m = gw; m < T; m += NGW) {
        const CombIn cur = nx;
        nx = combine_load(p, (size_t)((m + NGW < T) ? m + NGW : m), lane);
        combine_row(p, cur, ga, gb, (size_t)m, lane);
    }
}

__device__ __forceinline__ void wqk_rowmax(const Ptrs& p, int gw, int NGW, int lane) {
    const bf16* WQK = (const bf16*)(p.ws + WS_WQK); float* RMAX = (float*)(p.ws + WS_CSC);
    for (int r = gw; r < 2048; r += NGW) {
        const v4u a = *(const v4u*)(WQK + (size_t)r * 1024 + lane * 16), b = *(const v4u*)(WQK + (size_t)r * 1024 + lane * 16 + 8);
        const unsigned w0 = a.x, w1 = a.y, w2 = a.z, w3 = a.w, w4 = b.x, w5 = b.y, w6 = b.z, w7 = b.w;
        float m = fmaxf(fmaxf(fmaxf(fabsf(bflo(w0)), fabsf(bfhi(w0))), fmaxf(fabsf(bflo(w1)), fabsf(bfhi(w1)))), fmaxf(fmaxf(fabsf(bflo(w2)), fabsf(bfhi(w2))), fmaxf(fabsf(bflo(w3)), fabsf(bfhi(w3)))));
        m = fmaxf(m, fmaxf(fmaxf(fmaxf(fabsf(bflo(w4)), fabsf(bfhi(w4))), fmaxf(fabsf(bflo(w5)), fabsf(bfhi(w5)))), fmaxf(fmaxf(fabsf(bflo(w6)), fabsf(bfhi(w6))), fmaxf(fabsf(bflo(w7)), fabsf(bfhi(w7))))));
        m = wave_max(m);
        if (lane == 0) RMAX[r] = m;
    }
}
__device__ __forceinline__ void wqk_to_fp8(const Ptrs& p, int gw, int NGW, int lane) {
    const bf16* WQK = (const bf16*)(p.ws + WS_WQK); unsigned char* W8 = p.ws + WS_WQK8; const float* RMAX = (const float*)(p.ws + WS_CSC);
    if (gw >= 2048) return;
    float m = 0.f;
#pragma unroll
    for (int q = 0; q < 8; ++q) { const f32x4 v = *(const f32x4*)(RMAX + q * 256 + lane * 4); m = fmaxf(m, fmaxf(fmaxf(v[0], v[1]), fmaxf(v[2], v[3]))); }
    m = wave_max(m);
    const int ex = (int)((__float_as_uint(m) >> 23) & 0xffu);
    const bool ok = ex > 16 && ex < 250;
    const float S = ok ? __uint_as_float((unsigned)(127 + 7 + 127 - ex) << 23) : 1.f, Si = ok ? __uint_as_float((unsigned)(ex - 7 - 3) << 23) : 0.125f;
    if (gw == 0 && lane == 0) ((float*)(p.ws + WS_CSC))[2048] = Si;
    for (int r = gw; r < 2048; r += NGW) {
        const v4u a = *(const v4u*)(WQK + (size_t)r * 1024 + lane * 16), b = *(const v4u*)(WQK + (size_t)r * 1024 + lane * 16 + 8);
        const unsigned w0 = a.x, w1 = a.y, w2 = a.z, w3 = a.w, w4 = b.x, w5 = b.y, w6 = b.z, w7 = b.w;
        const float v[16] = {bflo(w0), bfhi(w0), bflo(w1), bfhi(w1), bflo(w2), bfhi(w2), bflo(w3), bfhi(w3), bflo(w4), bfhi(w4), bflo(w5), bfhi(w5), bflo(w6), bfhi(w6), bflo(w7), bfhi(w7)};
        unsigned wd[4];
#pragma unroll
        for (int q = 0; q < 4; ++q) { int pk = 0; pk = __builtin_amdgcn_cvt_pk_fp8_f32(v[4 * q] * S, v[4 * q + 1] * S, pk, false); pk = __builtin_amdgcn_cvt_pk_fp8_f32(v[4 * q + 2] * S, v[4 * q + 3] * S, pk, true); wd[q] = (unsigned)pk; }
        *(v4u*)(W8 + (size_t)r * 1024 + lane * 16) = (v4u){wd[0], wd[1], wd[2], wd[3]};
    }
}

__device__ __forceinline__ void ins16(float (&l)[16], float x) {
#pragma unroll
    for (int i = 15; i >= 1; --i) l[i] = __builtin_amdgcn_fmed3f(l[i - 1], l[i], x);
    l[0] = fmaxf(l[0], x);
}
#define DPP_F(v, ctrl) __builtin_bit_cast(float, __builtin_amdgcn_update_dpp(0, __builtin_bit_cast(int, (v)), (ctrl), 0xF, 0xF, true))
__device__ __forceinline__ void topk_ld16(float (&d)[16], const f32x4* q) { const f32x4 a = q[0], b = q[1], c = q[2], e = q[3];
    d[0] = a[0]; d[1] = a[1]; d[2] = a[2]; d[3] = a[3]; d[4] = b[0]; d[5] = b[1]; d[6] = b[2]; d[7] = b[3]; d[8] = c[0]; d[9] = c[1]; d[10] = c[2]; d[11] = c[3]; d[12] = e[0]; d[13] = e[1]; d[14] = e[2]; d[15] = e[3]; }
__device__ __forceinline__ void topk_phase(const Ptrs& p, LAS unsigned char* lds, int vcu, int G, int tid) {
    const float* TOPW = (const float*)(p.ws + WS_SC); const float* PART = (const float*)(p.ws + WS_PART);
    unsigned short* IDX = (unsigned short*)(p.ws + WS_IDX); unsigned short* GATE = (unsigned short*)(p.ws + WS_GATE);
    LAS unsigned* L = (LAS unsigned*)lds + tid * 32;
    const int NU = T / 64, tk = tid >> 3, hd = tid & 7;
    for (int unit = vcu; unit < NU; unit += G) {
        const size_t t = (size_t)unit * 64 + tk;
        float ss;
        { const f32x4* pp = (const f32x4*)(PART + t * 16); const f32x4 a = pp[0], b = pp[1], c = pp[2], d = pp[3];
          ss = ((a[0] + a[1]) + (a[2] + a[3])) + ((b[0] + b[1]) + (b[2] + b[3])) + ((c[0] + c[1]) + (c[2] + c[3])) + ((d[0] + d[1]) + (d[2] + d[3])); }
        const float rn = rsqrtf(ss * (1.f / D) + EPS);
        if (hd == 0) ((float*)(p.ws + WS_RN))[t] = rn;
        const f32x4* tp = (const f32x4*)(TOPW + ((t * 8 + hd) * 4) * 16);
        float la[16], lb[16], lo_[16];
        topk_ld16(la, tp); topk_ld16(lo_, tp + 4); MERGE16_REG(la, lo_);
        topk_ld16(lb, tp + 8); topk_ld16(lo_, tp + 12); MERGE16_REG(lb, lo_);
#pragma unroll
        for (int i = 0; i < 16; ++i) { L[i] = __float_as_uint(la[i]); L[16 + i] = __float_as_uint(lb[i]); }
        float fa[16], fb[16];
#pragma unroll
        for (int i = 0; i < 16; ++i) { fa[i] = __uint_as_float(__float_as_uint(la[i]) & ~0x7fu); fb[i] = __uint_as_float(__float_as_uint(lb[i]) & ~0x7fu); }
        float l[16];
#pragma unroll
        for (int j = 0; j < 16; ++j) l[j] = __uint_as_float((__float_as_uint(fa[0] + fb[j]) & ~0xffu) | (unsigned)(255 - j));
#pragma unroll
        for (int i = 1; i < 16; ++i)
#pragma unroll
            for (int j = 0; j < 16; ++j) if ((i + 1) * (j + 1) <= 16) ins16(l, __uint_as_float((__float_as_uint(fa[i] + fb[j]) & ~0xffu) | (unsigned)(255 - (i * 16 + j))));
        const float rt = rn * 1.4426950408889634f * ((const float*)(p.ws + WS_CSC))[2048];
        float sv[16], den = 0.f; const float s0 = __uint_as_float(__float_as_uint(l[0]) & ~0xffu);
#pragma unroll
        for (int k = 0; k < 16; ++k) { sv[k] = __builtin_amdgcn_exp2f((__uint_as_float(__float_as_uint(l[k]) & ~0xffu) - s0) * rt); den += sv[k]; }
        const float inv = 1.f / den;
        unsigned ids[16];
#pragma unroll
        for (int k = 0; k < 16; ++k) { const unsigned code = 255u - (__float_as_uint(l[k]) & 0xffu); ids[k] = (L[code >> 4] & 0x7fu) * 128u + (L[16 + (code & 15u)] & 0x7fu); sv[k] *= inv; }
        v4u* ip = (v4u*)(IDX + t * 128 + hd * 16);
        ip[0] = (v4u){ids[0] | (ids[1] << 16), ids[2] | (ids[3] << 16), ids[4] | (ids[5] << 16), ids[6] | (ids[7] << 16)};
        ip[1] = (v4u){ids[8] | (ids[9] << 16), ids[10] | (ids[11] << 16), ids[12] | (ids[13] << 16), ids[14] | (ids[15] << 16)};
        v4u* gp = (v4u*)(GATE + t * 128 + hd * 16);
        gp[0] = (v4u){pk2(sv[0], sv[1]), pk2(sv[2], sv[3]), pk2(sv[4], sv[5]), pk2(sv[6], sv[7])}; gp[1] = (v4u){pk2(sv[8], sv[9]), pk2(sv[10], sv[11]), pk2(sv[12], sv[13]), pk2(sv[14], sv[15])};
    }
}

__device__ __forceinline__ float dot2bf(unsigned u, unsigned x, float acc) { return __builtin_amdgcn_fdot2_f32_bf16(__builtin_bit_cast(bf16x2_t, u), __builtin_bit_cast(bf16x2_t, x), acc, false); }
#define DPP_ADD(v, ctrl) ((v) + __builtin_bit_cast(float, __builtin_amdgcn_update_dpp(0, __builtin_bit_cast(int, (v)), (ctrl), 0xF, 0xF, true)))
__device__ __forceinline__ float red8(float v) {
    float a = v; a = DPP_ADD(a, 0xB1); a = DPP_ADD(a, 0x4E); a = DPP_ADD(a, 0x141); return a;
}
constexpr int PB_ROW = 144, PB_WAVE = 128 * PB_ROW;
typedef int v8i __attribute__((ext_vector_type(8)));
struct TokI { v4u ia, ib; };
struct TokX { v4u xa, xb; };
__device__ __forceinline__ TokI peer_tokI(const unsigned short* IDX, int t, int lane) {
    TokI k; const unsigned short* ip = IDX + (size_t)t * 128 + (lane >> 3) * 16; k.ia = *(const v4u*)ip; k.ib = *(const v4u*)(ip + 8); return k;
}
__device__ __forceinline__ TokX peer_tokX(const unsigned char* XF8, int t, int s, int lane) {
    TokX k; const v4u z = {0u, 0u, 0u, 0u};
    if ((lane & 15) < 2) { const unsigned char* xp = XF8 + (size_t)t * 1024 + s * SLW + (lane & 15) * 128 + (lane >> 4) * 16; k.xa = *(const v4u*)xp; k.xb = *(const v4u*)(xp + 64); } else { k.xa = z; k.xb = z; }
    return k;
}
__device__ __forceinline__ void peer_gather(v4u (&u)[16], const v4u ia, const v4u ib, const unsigned char* base, unsigned coff) {
    const unsigned i0 = ia.x, i1 = ia.y, i2 = ia.z, i3 = ia.w, i4 = ib.x, i5 = ib.y, i6 = ib.z, i7 = ib.w;
#define PG_LD(j, w) u[2 * (j)] = *(const v4u*)(base + (((w) & 0xffffu) * 128u + coff)); u[2 * (j) + 1] = *(const v4u*)(base + (((w) >> 16) * 128u + coff))
    PG_LD(0, i0); PG_LD(1, i1); PG_LD(2, i2); PG_LD(3, i3); PG_LD(4, i4); PG_LD(5, i5); PG_LD(6, i6); PG_LD(7, i7);
#undef PG_LD
}
struct DotRes { float v0[16], v1[16]; };
__device__ __forceinline__ void peer_dot_store(const DotRes& r, unsigned short* dst, int lane) {
    if ((lane & 15) == 0) {
        v4u* o = (v4u*)(dst + (lane >> 4) * 32);
#pragma unroll
        for (int q = 0; q < 2; ++q) { o[q] = (v4u){pk2(r.v0[8 * q], r.v0[8 * q + 1]), pk2(r.v0[8 * q + 2], r.v0[8 * q + 3]), pk2(r.v0[8 * q + 4], r.v0[8 * q + 5]), pk2(r.v0[8 * q + 6], r.v0[8 * q + 7])};
            o[2 + q] = (v4u){pk2(r.v1[8 * q], r.v1[8 * q + 1]), pk2(r.v1[8 * q + 2], r.v1[8 * q + 3]), pk2(r.v1[8 * q + 4], r.v1[8 * q + 5]), pk2(r.v1[8 * q + 6], r.v1[8 * q + 7])}; } }
}
__device__ __forceinline__ void peer_tile_write(const v4u (&u)[16], LAS unsigned char* tb, int lane) {
    const int g = lane >> 3, c = lane & 7;
#pragma unroll
    for (int i = 0; i < 16; ++i) *(LAS v4u*)(tb + (8 * i + g) * PB_ROW + 16 * c) = u[i];
    asm volatile("s_waitcnt lgkmcnt(0)" ::: "memory");
}
__device__ __forceinline__ void peer_mfma(DotRes& r, const v4u xa, const v4u xb, LAS unsigned char* tb, int lane) {
    const v8i bop = {(int)xa.x, (int)xa.y, (int)xa.z, (int)xa.w, (int)xb.x, (int)xb.y, (int)xb.z, (int)xb.w};
    const LAS unsigned char* ra = tb + ((lane & 15) >> 1) * PB_ROW + (lane & 1) * 64 + (lane >> 4) * 16;
#pragma unroll
    for (int i = 0; i < 16; ++i) { const v4u w = *(const LAS v4u*)(ra + i * 8 * PB_ROW); const v8i aop = {(int)w.x, (int)w.y, (int)w.z, (int)w.w, 0, 0, 0, 0};
        const f32x4 z = {0.f, 0.f, 0.f, 0.f};
        const f32x4 a = __builtin_amdgcn_mfma_scale_f32_16x16x128_f8f6f4(aop, bop, z, 4  , 0  , 0, 0, 0, 0);
        const float a0 = a[0], a1 = a[1], a2 = a[2], a3 = a[3];
        r.v0[i] = a0 + DPP_F(a1, 0xB1); r.v1[i] = a2 + DPP_F(a3, 0xB1); }
    asm volatile("s_waitcnt lgkmcnt(0)" ::: "memory");
}
__device__ __forceinline__ void peer_dots(const Ptrs& p, LAS unsigned char* lds, int bx, int G, int wave, int lane) {
    const unsigned char* XF8 = p.ws + WS_XF8; const unsigned short* IDX = (const unsigned short*)(p.ws + WS_IDX);
    unsigned short* PACT = (unsigned short*)(p.ws + WS_PACT);
    const int s = (bx & 7) >> 1, wx = ((bx >> 3) * NWAVES + wave) * 2 + (bx & 1), NWX = (G >> 3) * NWAVES * 2;
    const int NT = (T - wx + NWX - 1) / NWX;
    const unsigned char* eus = p.ws + WS_EU + (size_t)s * NEXP * 128; const unsigned coff = (lane & 7) * 16; unsigned short* pact = PACT + (size_t)s * T * 128;
    LAS unsigned char* tb = lds + wave * PB_WAVE;
#define TOK(n) (wx + ((n) < NT ? (n) : NT - 1) * NWX)
    v4u u[16];
    DotRes pend;
    TokI iN = peer_tokI(IDX, TOK(0), lane);
    peer_gather(u, iN.ia, iN.ib, eus, coff);
    TokX xC = peer_tokX(XF8, TOK(0), s, lane);
    iN = peer_tokI(IDX, TOK(1), lane);
    for (int n = 0; n < NT; ++n) {
        peer_tile_write(u, tb, lane);
        peer_gather(u, iN.ia, iN.ib, eus, coff);
        const TokX xN = peer_tokX(XF8, TOK(n + 1), s, lane);
        iN = peer_tokI(IDX, TOK(n + 2), lane);
        if (n > 0) peer_dot_store(pend, pact + (size_t)TOK(n - 1) * 128, lane);
        peer_mfma(pend, xC.xa, xC.xb, tb, lane);
        xC = xN;
    }
    if (NT > 0) peer_dot_store(pend, pact + (size_t)TOK(NT - 1) * 128, lane);
#undef TOK
}
struct CoefIn { float pa[NSLICE], pb[NSLICE], g0, g1, rn; int e0, e1; };
struct CoefSc { float su0, su1, sv0, sv1; };
__device__ __forceinline__ CoefIn coef_load(const Ptrs& p, int t, int lane) {
    const unsigned short* PACT = (const unsigned short*)(p.ws + WS_PACT); const unsigned short* GATE = (const unsigned short*)(p.ws + WS_GATE); const unsigned short* IDX = (const unsigned short*)(p.ws + WS_IDX);
    CoefIn k;
#pragma unroll
    for (int s = 0; s < NSLICE; ++s) { k.pa[s] = __uint_as_float((unsigned)PACT[((size_t)s * T + t) * 128 + lane] << 16); k.pb[s] = __uint_as_float((unsigned)PACT[((size_t)s * T + t) * 128 + 64 + lane] << 16); }
    k.g0 = __uint_as_float((unsigned)GATE[(size_t)t * 128 + lane] << 16); k.g1 = __uint_as_float((unsigned)GATE[(size_t)t * 128 + 64 + lane] << 16); k.e0 = IDX[(size_t)t * 128 + lane]; k.e1 = IDX[(size_t)t * 128 + 64 + lane]; k.rn = ((const float*)(p.ws + WS_RN))[t]; return k;
}
__device__ __forceinline__ CoefSc coef_scales(const Ptrs& p, const CoefIn& k) {
    const float* SU = (const float*)(p.ws + WS_SU); const float* SV = (const float*)(p.ws + WS_SV);
    CoefSc c; c.su0 = SU[k.e0]; c.su1 = SU[k.e1]; c.sv0 = SV[k.e0]; c.sv1 = SV[k.e1]; return c;
}
__device__ __forceinline__ void coef_finish(const CoefIn& k, const CoefSc& c, float& c0, float& c1, float& m) {
    float a0 = 0.f, a1 = 0.f;
#pragma unroll
    for (int s = 0; s < NSLICE; ++s) { a0 += k.pa[s]; a1 += k.pb[s]; }
    const float rt = 0.125f * k.rn;
    const pg8::f32x2 gl = pg8::gelu_pk((pg8::f32x2){a0 * rt * c.su0, a1 * rt * c.su1});
    c0 = k.g0 * gl.x * c.sv0; c1 = k.g1 * gl.y * c.sv1; m = fmaxf(fabsf(c0), fabsf(c1));
}
__device__ __forceinline__ void coef_store(unsigned char* COEF8, float* CS, int t, int lane, float c0, float c1, float m) {
    const int ex = (int)((__float_as_uint(m) >> 23) & 0xffu);
    const float S = (ex > 0 && ex < 200) ? __uint_as_float((unsigned)(127 + 7 + 127 - ex) << 23) : 1.f, Si = (ex > 0 && ex < 200) ? __uint_as_float((unsigned)(ex - 7) << 23) : 1.f;
    const int pk = __builtin_amdgcn_cvt_pk_fp8_f32(c0 * S, c1 * S, 0, false);
    COEF8[(size_t)t * 128 + lane] = (unsigned char)(pk & 0xff); COEF8[(size_t)t * 128 + 64 + lane] = (unsigned char)((pk >> 8) & 0xff);
    if (lane == 0) CS[t] = Si;
}
__device__ __forceinline__ void peer_coef(const Ptrs& p, int gw, int NGW, int lane) {
    unsigned char* COEF8 = p.ws + WS_COEF; float* CS = (float*)(p.ws + WS_CS);
    const int NTW = (T - gw + NGW - 1) / NGW;
    if (NTW <= 0) return;
#define CTOK(n_) (gw + (((n_) < NTW) ? (n_) : (NTW - 1)) * NGW)
    CoefIn ka = coef_load(p, CTOK(0), lane), kb = coef_load(p, CTOK(1), lane);
    for (int n = 0; n < NTW; n += 2) {
        const CoefSc ca = coef_scales(p, ka), cb = coef_scales(p, kb);
        const CoefIn na = coef_load(p, CTOK(n + 2), lane), nb = coef_load(p, CTOK(n + 3), lane);
        float a0, a1, am, b0, b1, bm;
        coef_finish(ka, ca, a0, a1, am); coef_finish(kb, cb, b0, b1, bm);
#pragma unroll
        for (int o = 0; o < 1; ++o) { am = wave_max(am); bm = wave_max(bm); }
        coef_store(COEF8, CS, CTOK(n), lane, a0, a1, am);
        if (n + 1 < NTW) coef_store(COEF8, CS, CTOK(n + 1), lane, b0, b1, bm);
        ka = na; kb = nb;
    }
#undef CTOK
}
typedef int v2i __attribute__((ext_vector_type(2)));
struct TokB { v4u ia, ib, ca, cb; v2u xr; float cs; };
__device__ __forceinline__ TokB peer_tokB(const unsigned short* IDX, const unsigned char* COEF8, const float* CS, const bf16* xb, int t, int lane) {
    TokB k; const int g = lane >> 3; k.ia = *(const v4u*)(IDX + (size_t)t * 128 + 16 * g); k.ib = *(const v4u*)(IDX + (size_t)t * 128 + 16 * g + 8);
    const v4u z = {0u, 0u, 0u, 0u};
    if ((lane & 15) == 0) { const unsigned char* cp = COEF8 + (size_t)t * 128 + (lane >> 4) * 16; k.ca = *(const v4u*)cp; k.cb = *(const v4u*)(cp + 64); } else { k.ca = z; k.cb = z; }
    k.cs = CS[t]; k.xr = *(const v2u*)(xb + (size_t)t * 1024 + 4 * lane); return k;
}
__device__ __forceinline__ float pack_rows(float a, float b, float c, float d) {
    const v2u s1 = __builtin_amdgcn_permlane32_swap(__float_as_uint(a), __float_as_uint(c), false, false); const unsigned ac = s1.x;
    const v2u s2 = __builtin_amdgcn_permlane32_swap(__float_as_uint(b), __float_as_uint(d), false, false); const unsigned bd = s2.x;
    const v2u s3 = __builtin_amdgcn_permlane16_swap(ac, bd, false, false); const unsigned r = s3.x;
    return __uint_as_float(r);
}
__device__ __forceinline__ void peer_axpy_mfma(const v4u (&v)[16], const TokB& k, LAS unsigned char* tb, float* o, int lane) {
    const int g = lane >> 3, c = lane & 7, n = lane & 15, kg = lane >> 4;
#pragma unroll
    for (int i = 0; i < 16; ++i) *(LAS v4u*)(tb + (16 * g + i) * PB_ROW + 16 * c) = v[i];
    asm volatile("s_waitcnt lgkmcnt(0)" ::: "memory");
    const v8i aop = {(int)k.ca.x, (int)k.ca.y, (int)k.ca.z, (int)k.ca.w, (int)k.cb.x, (int)k.cb.y, (int)k.cb.z, (int)k.cb.w};
    const LAS unsigned char* ra = tb + (32 * kg + n) * PB_ROW;
    float pk[4];
#pragma unroll
    for (int q = 0; q < 4; ++q) {
        float val[4];
#pragma unroll
        for (int r = 0; r < 4; ++r) { const int nt = 4 * q + r;
            const v2i lo = __builtin_amdgcn_ds_read_tr4_b64_v2i32((LAS v2i*)(ra + nt * 8)), hi = __builtin_amdgcn_ds_read_tr4_b64_v2i32((LAS v2i*)(ra + 16 * PB_ROW + nt * 8));
            const v8i bop = {lo.x, lo.y, hi.x, hi.y, 0, 0, 0, 0};
            const f32x4 z = {0.f, 0.f, 0.f, 0.f};
            const f32x4 d = __builtin_amdgcn_mfma_scale_f32_16x16x128_f8f6f4(aop, bop, z, 0  , 4  , 0, 0, 0, 0);
            val[r] = d[0]; }
        pk[q] = pack_rows(val[0], val[1], val[2], val[3]);
    }
    asm volatile("s_waitcnt lgkmcnt(0)" ::: "memory");
    const unsigned r0 = k.xr.x, r1 = k.xr.y; const float cs = k.cs;
    *(f32x4*)(o + 4 * lane) = (f32x4){bflo(r0) + pk[0] * cs, bfhi(r0) + pk[1] * cs, bflo(r1) + pk[2] * cs, bfhi(r1) + pk[3] * cs};
}
__device__ __forceinline__ void peer_axpy(const Ptrs& p, LAS unsigned char* lds, int bx, int G, int wave, int lane) {
    const unsigned short* IDX = (const unsigned short*)(p.ws + WS_IDX); const unsigned char* COEF8 = p.ws + WS_COEF; const float* CS = (const float*)(p.ws + WS_CS);
    const int s = (bx & 7) >> 1, wx = ((bx >> 3) * NWAVES + wave) * 2 + (bx & 1), NWX = (G >> 3) * NWAVES * 2, c = lane & 7;
    const int NT = (T - wx + NWX - 1) / NWX;
    const unsigned char* evs = p.ws + WS_EV + (size_t)s * NEXP * 128; const unsigned coff = c * 16; float* ob = p.out + s * SLW; const bf16* xb = (const bf16*)(p.ws + WS_X1B) + s * SLW;
    LAS unsigned char* tb = lds + wave * PB_WAVE;
#define TOK(n) (wx + ((n) < NT ? (n) : NT - 1) * NWX)
    v4u va[16], vb[16];
    TokB kA = peer_tokB(IDX, COEF8, CS, xb, TOK(0), lane);
    peer_gather(va, kA.ia, kA.ib, evs, coff);
    TokB kB = peer_tokB(IDX, COEF8, CS, xb, TOK(1), lane);
    for (int n = 0; n < NT; n += 2) {
        peer_gather(vb, kB.ia, kB.ib, evs, coff);
        TokB kC = peer_tokB(IDX, COEF8, CS, xb, TOK(n + 2), lane);
        peer_axpy_mfma(va, kA, tb, ob + (size_t)TOK(n) * 1024, lane);
        peer_gather(va, kC.ia, kC.ib, evs, coff);
        kA = peer_tokB(IDX, COEF8, CS, xb, TOK(n + 3), lane);
        if (n + 1 < NT) peer_axpy_mfma(vb, kB, tb, ob + (size_t)TOK(n + 1) * 1024, lane);
        kB = kA; kA = kC;
    }
#undef TOK
}

#define XB_TMO      128
#define XB_XCNT(j)  (256  + 64 * (j))
#define XB_XSUB(j)  (1280 + 64 * (j))
#define XB_XGEN(j)  (2304 + 64 * (j))
#define XB_TOP      3328
#define XB_TOPGEN   3392
#define XCD_BAR_WORDS 3456
#define XB_SPIN_CAP (1u << 18)

__device__ __forceinline__ unsigned xb_ld(unsigned* p)              { return __hip_atomic_load(p, __ATOMIC_RELAXED, __HIP_MEMORY_SCOPE_AGENT); }
__device__ __forceinline__ unsigned xb_add(unsigned* p, unsigned v) { return __hip_atomic_fetch_add(p, v, __ATOMIC_RELAXED, __HIP_MEMORY_SCOPE_AGENT); }
__device__ __forceinline__ unsigned xb_xcc_id() { return (unsigned)__builtin_amdgcn_s_getreg((3 << 11) | 20) & 0xFu; }
#define XB_SPIN(cond, bar) do { unsigned _sp = 0; while (cond) { __builtin_amdgcn_s_sleep(1); \
    if ((++_sp & 255u) == 0u) { if (xb_ld(&(bar)[XB_TMO])) break; if (_sp > XB_SPIN_CAP) { atomicAdd(&(bar)[XB_TMO], 1u); break; } } } } while (0)

struct XcdBarrier {
    unsigned* bar; unsigned x;
    volatile LAS unsigned* st;
};

__device__ __forceinline__ XcdBarrier xcd_barrier_post(unsigned* bar, volatile LAS unsigned* st) {
    XcdBarrier b; b.bar = bar; b.x = xb_xcc_id(); b.st = st;
    if (threadIdx.x == 0) (void)xb_add(&bar[XB_XCNT(b.x)], 1u);
    return b;
}
__device__ __forceinline__ void xcd_barrier_complete(unsigned* bar, unsigned x, unsigned& nloc, unsigned& nx) {
    const unsigned G = gridDim.x * gridDim.y * gridDim.z;
    unsigned sum, cnt, mine, sp = 0u;
    for (;;) {
        sum = 0u; cnt = 0u; mine = 0u;
#pragma unroll
        for (unsigned j = 0; j < 16; ++j) { const unsigned c = xb_ld(&bar[XB_XCNT(j)]); sum += c; cnt += (c > 0u) ? 1u : 0u; mine = (j == x) ? c : mine; }
        if (sum == G) break;
        __builtin_amdgcn_s_sleep(1);
        if ((++sp & 255u) == 0u) { if (xb_ld(&bar[XB_TMO])) break; if (sp > XB_SPIN_CAP) { atomicAdd(&bar[XB_TMO], 1u); break; } }
    }
    nloc = mine > 0u ? mine : 1u; nx = cnt > 0u ? cnt : 1u;
}

__device__ __forceinline__ void xcd_barrier(const XcdBarrier& b) {
    asm volatile("s_waitcnt vmcnt(0)" ::: "memory");
    __syncthreads();
    if (threadIdx.x == 0) {
        unsigned* bar = b.bar;
        __builtin_amdgcn_s_waitcnt(0);
        unsigned nloc = b.st[0], nx = b.st[1];
        if (nloc == 0u) { xcd_barrier_complete(bar, b.x, nloc, nx); b.st[0] = nloc; b.st[1] = nx; }
        const unsigned old = xb_add(&bar[XB_XSUB(b.x)], 1u);
        const unsigned gen = old / nloc;
        if (old + 1u == (gen + 1u) * nloc) {
            __builtin_amdgcn_fence(__ATOMIC_RELEASE, "agent");
            asm volatile("s_waitcnt vmcnt(0)" ::: "memory");
            const unsigned og = xb_add(&bar[XB_TOP], 1u);
            const unsigned tg = og / nx;
            if (og + 1u == (tg + 1u) * nx) xb_add(&bar[XB_TOPGEN], 1u);
            else XB_SPIN(xb_ld(&bar[XB_TOPGEN]) == tg, bar);
            __builtin_amdgcn_fence(__ATOMIC_ACQUIRE, "agent");
            xb_add(&bar[XB_XGEN(b.x)], 1u);
            asm volatile("s_waitcnt vmcnt(0)" ::: "memory");
        } else {
            XB_SPIN(xb_ld(&bar[XB_XGEN(b.x)]) == gen, bar);
            __builtin_amdgcn_fence(__ATOMIC_ACQUIRE, "agent");
            asm volatile("s_waitcnt vmcnt(0)" ::: "memory");
        }
    }
    __syncthreads();
}

constexpr int N_PHASES = 8;
#ifndef PROBE
#define PROBE 0
#endif
__global__ void __launch_bounds__(NTHR, 2) hymba_fwd(Args args) {
    extern __shared__ __attribute__((aligned(16))) unsigned char lds_raw[];
    LAS unsigned char* lds = (LAS unsigned char*)lds_raw;
    const Ptrs& p = args.p;
    const int tid = threadIdx.x, lane = tid & 63, wave = __builtin_amdgcn_readfirstlane(tid >> 6);
    const int G = gridDim.x, bx = blockIdx.x, vcu = (G % 8 == 0) ? (bx % 8) * (G / 8) + bx / 8 : bx;
    const int gw = vcu * NWAVES + wave, NGW = G * NWAVES;
    const int lo = args.ph_lo, hi = args.ph_hi;
    volatile LAS unsigned* MISC = (volatile LAS unsigned*)(lds + MISC_OFF);
    if (tid < 64) MISC[tid] = 0u;
    __syncthreads();
    XcdBarrier bar = xcd_barrier_post((unsigned*)(p.ws + WS_CTL) + CW_BAR, MISC + 8);
#define IN(k) (lo <= (k) && (k) < hi)
#define SEAM(k) do { if (IN(k) && IN((k) + 1)) xcd_barrier(bar); } while (0)
    if (IN(0)) p0_prologue(p, lds, tid, lane, wave, vcu, G);
    SEAM(0);
    if (IN(1)) {
        pg8::Gemm g{(const bf16*)(p.ws + WS_HN), (const bf16*)(p.ws + WS_WIN), T, INW, D}; pg8::StaticOrder S; S.init(T, INW, G, bx);
        EpiProj E{(bf16*)(p.ws + WS_Q), (bf16*)(p.ws + WS_K), (bf16*)(p.ws + WS_V), (bf16*)(p.ws + WS_GU), (bf16*)(p.ws + WS_GV), p.q_g, p.k_g};
        pg8::gemm_phase<EpiProj, pg8::StaticOrder, true, true>(lds, g, S, E);
    }
    SEAM(1);
    if (IN(2)) attn_phase(p, lds, vcu, G, lane, wave);
    SEAM(2);
    if (IN(3)) {
        for (int u = vcu; u < T / 128; u += G) gmlp_unit(p, lds, u, tid, lane, wave);
        combine_phase(p, gw, NGW, lane);
        wqk_rowmax(p, gw, NGW, lane);
    }
    SEAM(3);
    if (IN(4)) {
        wqk_to_fp8(p, gw, NGW, lane);
        pg8::Gemm g{(const bf16*)(p.ws + WS_HN), (const bf16*)(p.ws + WS_WOUT), T, D, D}; pg8::StaticOrder S; S.init(T, D, G, bx);
        EpiOut E{p.x, p.out, (bf16*)(p.ws + WS_X1B), (float*)(p.ws + WS_PART), p.ws + WS_XF8};
        pg8::gemm_phase<EpiOut, pg8::StaticOrder, true, true>(lds, g, S, E);
    }
    SEAM(4);
    if (IN(5)) {
        pg8::Gemm g{(const bf16*)(p.ws + WS_XF8), (const bf16*)(p.ws + WS_WQK8), T, 2048, D / 2}; pg8::StaticOrder S; S.init(T, 2048, G, bx);
        EpiTopk E{(float*)(p.ws + WS_SC)};
        pg8::gemm_phase<EpiTopk, pg8::StaticOrder, true, true, true>(lds, g, S, E);
    }
    SEAM(5);
    if (IN(6)) topk_phase(p, lds, vcu, G, tid);
    SEAM(6);
    if (IN(7)) {
        __syncthreads();
        peer_dots(p, lds, bx, G, wave, lane);
        if (args.probe == 1) peer_dots(p, lds, bx, G, wave, lane);
        xcd_barrier(bar);
        peer_coef(p, gw, NGW, lane);
        if (args.probe == 2) peer_coef(p, gw, NGW, lane);
        xcd_barrier(bar);
        if (args.probe == 3) { xcd_barrier(bar); xcd_barrier(bar); xcd_barrier(bar); xcd_barrier(bar); xcd_barrier(bar); xcd_barrier(bar); xcd_barrier(bar); xcd_barrier(bar); xcd_barrier(bar); xcd_barrier(bar); }
        __syncthreads();
        peer_axpy(p, lds, bx, G, wave, lane);
        if (args.probe == 5) peer_axpy(p, lds, bx, G, wave, lane);
    }
#undef IN
#undef SEAM
}

extern "C" void kernel_launch(void* const* d_in, const int* in_sizes, int n_in, void* d_out, int out_size, void* d_ws, size_t ws_size, hipStream_t stream) {
    static int grid = 0;
    if (grid == 0) {
        if (n_in != 17 || in_sizes[0] != T * D || out_size != T * D || ws_size < WS_END) { fprintf(stderr, "kernel_launch: unexpected shapes (n_in %d, in0 %d, out %d, ws %zu); nothing launched\n", n_in, n_in > 0 ? in_sizes[0] : -1, out_size, ws_size); grid = -1; return; }
        int dev = 0, cus = 0, per_cu = 0;
        if (hipGetDevice(&dev) != hipSuccess || hipDeviceGetAttribute(&cus, hipDeviceAttributeMultiprocessorCount, dev) != hipSuccess) { grid = -1; return; }
        if (hipFuncSetAttribute((const void*)hymba_fwd, hipFuncAttributeMaxDynamicSharedMemorySize, LDS_BYTES) != hipSuccess) { fprintf(stderr, "kernel_launch: hipFuncSetAttribute failed\n"); grid = -1; return; }
        if (hipOccupancyMaxActiveBlocksPerMultiprocessor(&per_cu, (const void*)hymba_fwd, NTHR, LDS_BYTES) != hipSuccess || per_cu < 1) fprintf(stderr, "kernel_launch: occupancy query reports %d\n", per_cu);
        (void)hipGetLastError();
        grid = cus;
    }
    if (grid < 0) return;
    Args a{};
    const float** pp = (const float**)&a.p;
    for (int i = 0; i < 17; ++i) pp[i] = (const float*)d_in[i];
    a.p.out = (float*)d_out; a.p.ws = (unsigned char*)d_ws;
    if (hipMemsetAsync((char*)d_ws + WS_CTL, 0, CTL_ZERO_BYTES, stream) != hipSuccess) { fprintf(stderr, "kernel_launch: hipMemsetAsync failed\n"); return; }
    a.ph_lo = 0; a.ph_hi = N_PHASES; a.probe = PROBE;
    hipLaunchKernelGGL(hymba_fwd, dim3(grid), dim3(NTHR), LDS_BYTES, stream, a);
}
```

```cpp
#include <hip/hip_runtime.h>
#include <cstdio>
#include <cstdint>
#include <cmath>
namespace pg8 {
#define PG8_LAS __attribute__((address_space(3)))
typedef unsigned short bf16_t;
typedef short bf16x8 __attribute__((ext_vector_type(8)));
typedef float f32x4 __attribute__((ext_vector_type(4)));
typedef unsigned u32x4 __attribute__((ext_vector_type(4)));
typedef int i32x4 __attribute__((ext_vector_type(4)));
typedef int i32x8 __attribute__((ext_vector_type(8)));
constexpr int BM = 256, BK = 64, HALF = 128, HTB = HALF * BK * 2  , STAGE_BYTES = 8 * HTB, NXCD = 8, WGM = 8;

__host__ __device__ __forceinline__ int lds_byte(int r, int c) { const int st = (r >> 4) * 2 + (c >> 5), rr = r & 15, cc = c & 31, ob = rr * 64 + cc * 2; return st * 1024 + (ob ^ (((ob >> 9) & 1) << 5)); }
__host__ __device__ __forceinline__ void stage_rc(int b, int& R, int& C) { const int st = b / 1024, sb = b % 1024, swz = sb ^ (((sb >> 9) & 1) << 5); R = (st >> 1) * 16 + swz / 64; C = (st & 1) * 32 + (swz % 64) / 2; }
__host__ __device__ __forceinline__ int perm32(int rho) { const int n = rho >> 4, i = rho & 15; return 8 * (i >> 2) + 4 * n + (i & 3); }

struct Unit { int pm, pn; };
struct Gemm { const bf16_t* A; const bf16_t* Bt; int M, N, K; };

struct StaticOrder {
    int nM, nN, nwg, G, c;
    __host__ __device__ void init(int M, int N, int G_, int c_) { nM = M / BM; nN = N / BM; nwg = nM * nN; G = G_; c = c_; }
    __host__ __device__ bool next(int i, Unit& u) const {
        const long L = (long)i * G + c; if (L >= nwg) return false;
        int wgid = (int)L; { const int q = nwg / NXCD, r = nwg % NXCD, xcd = wgid % NXCD, off = wgid / NXCD; wgid = (xcd < r ? xcd * (q + 1) : r * (q + 1) + (xcd - r) * q) + off; }
        const int nig = WGM * nN, gid = wgid / nig, fm = gid * WGM, gsz = (nM - fm) < WGM ? (nM - fm) : WGM;
        u.pm = fm + ((wgid % nig) % gsz); u.pn = (wgid % nig) / gsz; return true;
    }
    __device__ __forceinline__ void a_ready(const Unit&) const {}
    __device__ __forceinline__ void done(const Unit&) const {}
};

__device__ __forceinline__ unsigned cvt_pk_bf16(float lo, float hi) { unsigned r; asm volatile("v_cvt_pk_bf16_f32 %0, %1, %2" : "=v"(r) : "v"(lo), "v"(hi)); return r; }
typedef float f32x2 __attribute__((ext_vector_type(2)));
__device__ __forceinline__ f32x2 gelu_pk(f32x2 v) {
    const f32x2 av = __builtin_elementwise_abs(v), d = av * 0.2316418882f + 1.0f;
    f32x2 t; t.x = __builtin_amdgcn_rcpf(d.x); t.y = __builtin_amdgcn_rcpf(d.y);
    f32x2 q = t * 0.5307027145f + (-0.7265760135f); q = q * t + 0.7107068705f; q = q * t + (-0.142248368f); q = q * t + 0.127414796f; q = q * t;
    const f32x2 s = (v * v) * (-0.72134752044f);
    f32x2 e; e.x = __builtin_amdgcn_exp2f(s.x); e.y = __builtin_amdgcn_exp2f(s.y);
    const f32x2 m = v * (q * e), r = v - m;
    f32x2 o; o.x = v.x < 0.f ? m.x : r.x; o.y = v.y < 0.f ? m.y : r.y; return o;
}

template <class Epi, class Sched, bool ALIGN_EPI = false, bool SP2 = false, bool FP8 = false>
__device__ __forceinline__ void gemm_phase(PG8_LAS unsigned char* lds, const Gemm g, const Sched& S, const Epi& E) {
    const int tid = threadIdx.x, wid = __builtin_amdgcn_readfirstlane(tid >> 6), lane = tid & 63, wr = wid >> 2, wc = wid & 3, fr = lane & 15, fq = lane >> 4;
    const int K = g.K, nt = K / BK;
    unsigned voffA[2], voffB[2];
#pragma unroll
    for (int i = 0; i < 2; ++i) { int R, C; stage_rc(tid * 16 + i * 8192, R, C); const int Rb = Epi::PERM ? ((R & ~31) + perm32(R & 31)) : R;
        voffA[i] = (unsigned)(R * K + C) * 2u; voffB[i] = (unsigned)(Rb * K + C) * 2u; }
    const size_t kstep = (size_t)(BK * 2);
    const size_t hstep = (size_t)HALF * K * 2;
    const size_t tstep = 2 * hstep;
    const unsigned ldsw = (unsigned)wid * 1024u;
    const int aoff = lds_byte(wr * 64 + fr, fq * 8), boff = lds_byte(wc * 32 + fr, fq * 8);
#define PG8_SA(b, h) (((b) * 2 + (h)) * HTB)
#define PG8_SB(b, h) ((4 + (b) * 2 + (h)) * HTB)
#define PG8_STAGE(bufoff, gbase, voff) do { _Pragma("unroll") for (int _i = 0; _i < 2; ++_i) \
        __builtin_amdgcn_global_load_lds((const unsigned*)((const char*)(gbase) + (voff)[_i]), (PG8_LAS unsigned*)(lds + (bufoff) + ldsw + _i * 8192), 16, 0, 0); } while (0)
#define PG8_LD8(p_) __builtin_shufflevector(*(const PG8_LAS i32x4*)(p_), *(const PG8_LAS i32x4*)((p_) + 1024), 0, 1, 2, 3, 4, 5, 6, 7)
#define PG8_LDA(dst, b, h) do { if constexpr (FP8) { _Pragma("unroll") for (int m = 0; m < 4; ++m) dst##8[m] = PG8_LD8(lds + PG8_SA(b, h) + aoff + m * 2048); } \
        else { _Pragma("unroll") for (int m = 0; m < 4; ++m) _Pragma("unroll") for (int k = 0; k < 2; ++k) dst[m][k] = *(const PG8_LAS bf16x8*)(lds + PG8_SA(b, h) + aoff + m * 2048 + k * 1024); } } while (0)
#define PG8_LDB(dst, b, h) do { if constexpr (FP8) { _Pragma("unroll") for (int n = 0; n < 2; ++n) dst##8[n] = PG8_LD8(lds + PG8_SB(b, h) + boff + n * 2048); } \
        else { _Pragma("unroll") for (int n = 0; n < 2; ++n) _Pragma("unroll") for (int k = 0; k < 2; ++k) dst[n][k] = *(const PG8_LAS bf16x8*)(lds + PG8_SB(b, h) + boff + n * 2048 + k * 1024); } } while (0)
#define PG8_MMA(ai, bj, At, Bt) do { __builtin_amdgcn_s_setprio(1); \
        if constexpr (FP8) { _Pragma("unroll") for (int m = 0; m < 4; ++m) _Pragma("unroll") for (int n = 0; n < 2; ++n) \
            asm volatile("v_mfma_f32_16x16x128_f8f6f4 %0, %1, %2, %0" : "+v"(acc[ai][bj][m][n]) : "v"(Bt##8[n]), "v"(At##8[m])); }   \
        else { _Pragma("unroll") for (int m = 0; m < 4; ++m) _Pragma("unroll") for (int n = 0; n < 2; ++n) _Pragma("unroll") for (int k = 0; k < 2; ++k) \
            acc[ai][bj][m][n] = __builtin_amdgcn_mfma_f32_16x16x32_bf16(Bt[n][k], At[m][k], acc[ai][bj][m][n], 0, 0, 0); } \
        __builtin_amdgcn_s_setprio(0); } while (0)
#define PG8_WAIT_V(n) asm volatile("s_waitcnt vmcnt(" #n ")" ::: "memory")
#define PG8_WAIT_L(n) asm volatile("s_waitcnt lgkmcnt(" #n ")" ::: "memory")
#define PG8_BAR __builtin_amdgcn_s_barrier()
#define PG8_SCHED __builtin_amdgcn_sched_barrier(0)
    Unit cur, nxt; int ui = 0;
    if (!S.next(0, cur)) return;
    f32x4 acc[2][2][4][2];
#pragma unroll
    for (int a = 0; a < 2; ++a)
#pragma unroll
        for (int b = 0; b < 2; ++b)
#pragma unroll
            for (int m = 0; m < 4; ++m)
#pragma unroll
                for (int n = 0; n < 2; ++n) acc[a][b][m][n] = (f32x4){0.f, 0.f, 0.f, 0.f};
    bf16x8 At[4][2], B0[2][2], B1[2][2];
    i32x8 At8[4], B08[2], B18[2];
    const char* cA = (const char*)g.A + (size_t)cur.pm * tstep; const char* cB = (const char*)g.Bt + (size_t)cur.pn * tstep;
    S.a_ready(cur);
    if constexpr (SP2) {
        PG8_STAGE(PG8_SB(0, 0), cB, voffB); PG8_STAGE(PG8_SB(0, 1), cB + hstep, voffB); PG8_STAGE(PG8_SA(0, 0), cA, voffA); PG8_STAGE(PG8_SA(0, 1), cA + hstep, voffA);
        if (wr == 1) PG8_BAR;
        PG8_WAIT_V(2); PG8_BAR;
        PG8_STAGE(PG8_SB(1, 0), cB + kstep, voffB); PG8_STAGE(PG8_SA(1, 0), cA + kstep, voffA); PG8_STAGE(PG8_SB(1, 1), cB + hstep + kstep, voffB);
        PG8_WAIT_V(6); PG8_BAR;
    } else {
        PG8_STAGE(PG8_SB(0, 0), cB, voffB); PG8_STAGE(PG8_SA(0, 0), cA, voffA); PG8_STAGE(PG8_SB(0, 1), cB + hstep, voffB); PG8_STAGE(PG8_SA(0, 1), cA + hstep, voffA);
        if (wr == 1) PG8_BAR;
        PG8_WAIT_V(4); PG8_BAR;
        PG8_STAGE(PG8_SB(1, 0), cB + kstep, voffB); PG8_STAGE(PG8_SA(1, 0), cA + kstep, voffA); PG8_STAGE(PG8_SB(1, 1), cB + hstep + kstep, voffB);
        PG8_WAIT_V(6); PG8_BAR;
    }
    for (;;) {
        const bool has_next = S.next(ui + 1, nxt);
        const char* nA = has_next ? (const char*)g.A + (size_t)nxt.pm * tstep : cA; const char* nB = has_next ? (const char*)g.Bt + (size_t)nxt.pn * tstep : cB;
        for (int t = 0; t < nt; t += 2) {
            const bool last = (t == nt - 2);
            const char* a1 = cA + (size_t)(t + 1) * kstep;
            const char* a2 = last ? nA : cA + (size_t)(t + 2) * kstep; const char* b2 = last ? nB : cB + (size_t)(t + 2) * kstep;
            const char* a3 = a2 + kstep; const char* b3 = b2 + kstep;
            if (last && has_next) S.a_ready(nxt);
            if constexpr (SP2) {
            PG8_LDB(B0, 0, 0); PG8_LDB(B1, 0, 1); PG8_SCHED; PG8_LDA(At, 0, 0); PG8_STAGE(PG8_SA(1, 1), a1 + hstep, voffA);
            PG8_WAIT_V(8); PG8_WAIT_L(0); PG8_BAR; PG8_MMA(0, 0, At, B0); PG8_MMA(0, 1, At, B1); PG8_BAR; PG8_SCHED;
            PG8_LDA(At, 0, 1); PG8_STAGE(PG8_SB(0, 0), b2, voffB); PG8_STAGE(PG8_SB(0, 1), b2 + hstep, voffB); PG8_STAGE(PG8_SA(0, 0), a2, voffA);
            PG8_WAIT_V(8); PG8_WAIT_L(0); PG8_BAR; PG8_MMA(1, 0, At, B0); PG8_MMA(1, 1, At, B1); PG8_BAR; PG8_SCHED;
            PG8_LDB(B0, 1, 0); PG8_LDB(B1, 1, 1); PG8_SCHED; PG8_LDA(At, 1, 0); PG8_STAGE(PG8_SA(0, 1), a2 + hstep, voffA);
            PG8_WAIT_V(8); PG8_WAIT_L(0); PG8_BAR; PG8_MMA(0, 0, At, B0); PG8_MMA(0, 1, At, B1); PG8_BAR; PG8_SCHED;
            PG8_LDA(At, 1, 1); PG8_STAGE(PG8_SB(1, 0), b3, voffB); PG8_STAGE(PG8_SB(1, 1), b3 + hstep, voffB); PG8_STAGE(PG8_SA(1, 0), a3, voffA);
            PG8_WAIT_V(8); PG8_WAIT_L(0); PG8_BAR; PG8_MMA(1, 0, At, B0); PG8_MMA(1, 1, At, B1); PG8_BAR; PG8_SCHED;
            } else {
            PG8_LDB(B0, 0, 0); PG8_SCHED; PG8_LDA(At, 0, 0); PG8_STAGE(PG8_SA(1, 1), a1 + hstep, voffA);
            PG8_WAIT_L(8); PG8_BAR; PG8_WAIT_L(0); PG8_MMA(0, 0, At, B0); PG8_BAR; PG8_SCHED;
            PG8_LDB(B1, 0, 1); PG8_STAGE(PG8_SB(0, 0), b2, voffB);
            PG8_BAR; PG8_WAIT_L(0); PG8_MMA(0, 1, At, B1); PG8_BAR;
            PG8_LDA(At, 0, 1); PG8_STAGE(PG8_SA(0, 0), a2, voffA);
            PG8_BAR; PG8_WAIT_L(0); PG8_MMA(1, 0, At, B0); PG8_BAR; PG8_SCHED;
            PG8_STAGE(PG8_SB(0, 1), b2 + hstep, voffB);
            PG8_WAIT_V(6); PG8_BAR; PG8_MMA(1, 1, At, B1); PG8_BAR;
            PG8_LDB(B0, 1, 0); PG8_SCHED; PG8_LDA(At, 1, 0); PG8_STAGE(PG8_SA(0, 1), a2 + hstep, voffA);
            PG8_WAIT_L(8); PG8_BAR; PG8_WAIT_L(0); PG8_MMA(0, 0, At, B0); PG8_BAR; PG8_SCHED;
            PG8_LDB(B1, 1, 1); PG8_STAGE(PG8_SB(1, 0), b3, voffB);
            PG8_BAR; PG8_WAIT_L(0); PG8_MMA(0, 1, At, B1); PG8_BAR;
            PG8_LDA(At, 1, 1); PG8_STAGE(PG8_SA(1, 0), a3, voffA);
            PG8_BAR; PG8_WAIT_L(0); PG8_MMA(1, 0, At, B0); PG8_BAR; PG8_SCHED;
            PG8_STAGE(PG8_SB(1, 1), b3 + hstep, voffB);
            PG8_WAIT_V(6); PG8_BAR; PG8_MMA(1, 1, At, B1); PG8_BAR;
            }
        }
        if constexpr (ALIGN_EPI) { if (wr == 0) PG8_BAR; }
        if constexpr (FP8) { asm volatile("s_nop 15\n\ts_nop 15" ::: "memory"); }
        if constexpr (!Epi::AFTER_DRAIN) { E(acc, cur, wr, wc, fr, fq); S.done(cur); }
        if (!has_next) break;
#pragma unroll
        for (int a = 0; a < 2; ++a)
#pragma unroll
            for (int b = 0; b < 2; ++b)
#pragma unroll
                for (int m = 0; m < 4; ++m)
#pragma unroll
                    for (int n = 0; n < 2; ++n) acc[a][b][m][n] = (f32x4){0.f, 0.f, 0.f, 0.f};
        cur = nxt; cA = nA; cB = nB; ++ui;
        if constexpr (ALIGN_EPI) { if (wr == 1) PG8_BAR; }
    }
    PG8_WAIT_V(0);
    if constexpr (!ALIGN_EPI) { if (wr == 0) PG8_BAR; }
    PG8_BAR;
    if constexpr (Epi::AFTER_DRAIN) { E.fused(acc, cur, wr, wc, fr, fq, lds, wid, lane); S.done(cur); }
#undef PG8_SA
#undef PG8_SB
#undef PG8_STAGE
#undef PG8_LD8
#undef PG8_LDA
#undef PG8_LDB
#undef PG8_MMA
#undef PG8_WAIT_V
#undef PG8_WAIT_L
#undef PG8_BAR
#undef PG8_SCHED
}
}

constexpr int BATCH = 16, SEQ = 4096, D = 1024, T = BATCH * SEQ;
constexpr int AW = 512, NH = 8, HD = 64, GWID = 512, INW = 2560;
constexpr int NKEYS = 128, NEXP = 16384, PH = 8, TOPK = 16, NSEL = PH * TOPK;
constexpr float EPS = 1e-6f;
constexpr float QSCALE = 0.125f * 1.4426950408889634f;
constexpr int NWAVES = 8, NTHR = 512;

constexpr size_t MiB = 1u << 20;
constexpr size_t WS_CTL = 0, CTL_ZERO_BYTES = 1 * MiB;
constexpr size_t WS_WIN = 2 * MiB;
constexpr size_t WS_WOUT = 8 * MiB;
constexpr size_t WS_WQK = 10 * MiB;
constexpr size_t WS_WSP = 14 * MiB;
constexpr size_t WS_PART = 15 * MiB;
constexpr size_t WS_EU = 20 * MiB;
constexpr size_t WS_EV = 52 * MiB;
constexpr size_t WS_SU = 36 * MiB, WS_SV = 37 * MiB;
constexpr size_t WS_HN = 84 * MiB;
constexpr size_t WS_X1B = 212 * MiB;
constexpr size_t WS_Q = 340 * MiB, WS_K = 404 * MiB, WS_V = 468 * MiB, WS_GU = 532 * MiB, WS_GV = 596 * MiB;
constexpr size_t WS_PO = 660 * MiB;
constexpr size_t WS_LSE = 852 * MiB;
constexpr size_t WS_SC = 340 * MiB;
constexpr size_t WS_IDX = 860 * MiB;
constexpr size_t WS_PACT = 340 * MiB;
constexpr size_t WS_COEF = 924 * MiB;
constexpr size_t WS_CS = 940 * MiB;
constexpr size_t WS_WQK8 = 1010 * MiB;
constexpr size_t WS_CSC = 1012 * MiB;
constexpr size_t WS_RN = 941 * MiB;
constexpr size_t WS_GATE = 892 * MiB;
constexpr size_t WS_XF8 = 944 * MiB;
constexpr size_t WS_END = 1013 * MiB;
constexpr int NSLICE = 4, SLW = D / NSLICE;
constexpr int CW_BAR = 4096;

constexpr int LDS_BYTES = 163840 - 2048;
constexpr int MISC_OFF = 160 * 1024 - 2048 - 256;

#define GAS __attribute__((address_space(1)))
#define LAS __attribute__((address_space(3)))
typedef unsigned short bf16;
typedef unsigned v4u __attribute__((ext_vector_type(4)));
typedef unsigned v2u __attribute__((ext_vector_type(2)));
typedef float f32x4 __attribute__((ext_vector_type(4)));
typedef float f32x16 __attribute__((ext_vector_type(16)));
typedef short bf16x8 __attribute__((ext_vector_type(8)));
typedef short s16x4 __attribute__((ext_vector_type(4)));
typedef short v4i16_t __attribute__((ext_vector_type(4)));
typedef __bf16 bf16x2_t __attribute__((ext_vector_type(2)));

typedef float f32x2_t __attribute__((ext_vector_type(2)));
__device__ __forceinline__ unsigned pk2(float lo, float hi) { const f32x2_t v = {lo, hi}; const bf16x2_t b = __builtin_convertvector(v, bf16x2_t); return __builtin_bit_cast(unsigned, b); }
__device__ __forceinline__ unsigned f2bf(float f) { return pk2(f, f) & 0xffffu; }
__device__ __forceinline__ float bflo(unsigned u) { return __uint_as_float(u << 16); }
__device__ __forceinline__ float bfhi(unsigned u) { return __uint_as_float(u & 0xffff0000u); }
#define DPPV(v, ctrl) __builtin_bit_cast(float, __builtin_amdgcn_update_dpp(0, __builtin_bit_cast(int, (v)), (ctrl), 0xF, 0xF, true))
__device__ __forceinline__ void swap16(float& a, float& b) { const v2u s = __builtin_amdgcn_permlane16_swap(__float_as_uint(a), __float_as_uint(b), false, false); const unsigned x = s.x, y = s.y; a = __uint_as_float(x); b = __uint_as_float(y); }
__device__ __forceinline__ void swap32(float& a, float& b) { const v2u s = __builtin_amdgcn_permlane32_swap(__float_as_uint(a), __float_as_uint(b), false, false); const unsigned x = s.x, y = s.y; a = __uint_as_float(x); b = __uint_as_float(y); }
__device__ __forceinline__ float sum_x16(float v) { float a = v, b = v; swap16(a, b); return a + b; }
__device__ __forceinline__ float sum_x32(float v) { float a = v, b = v; swap32(a, b); return a + b; }
__device__ __forceinline__ float max_x16(float v) { float a = v, b = v; swap16(a, b); return fmaxf(a, b); }
__device__ __forceinline__ float max_x32(float v) { float a = v, b = v; swap32(a, b); return fmaxf(a, b); }
__device__ __forceinline__ float row_sum16(float v) { float a = v; a += DPPV(a, 0xB1); a += DPPV(a, 0x4E); a += DPPV(a, 0x141); a += DPPV(a, 0x140); return a; }
__device__ __forceinline__ float row_max16(float v) { float a = v; a = fmaxf(a, DPPV(a, 0xB1)); a = fmaxf(a, DPPV(a, 0x4E)); a = fmaxf(a, DPPV(a, 0x141)); a = fmaxf(a, DPPV(a, 0x140)); return a; }
__device__ __forceinline__ float wave_sum(float v) { return sum_x32(sum_x16(row_sum16(v))); }
__device__ __forceinline__ float wave_max(float v) { return max_x32(max_x16(row_max16(v))); }
__device__ __forceinline__ int crow(int r, int hi) { return (r & 3) + 8 * (r >> 2) + 4 * hi; }
__device__ __forceinline__ float gelu_exact(float v) { return 0.5f * v * (1.0f + erff(v * 0.70710678118654752f)); }

#define CE16(l, a, b) { const float hi_ = fmaxf(l[a], l[b]), lo_ = fminf(l[a], l[b]); l[a] = hi_; l[b] = lo_; }
#define SORT16_DESC(l) do { CE16(l,0,1) CE16(l,2,3) CE16(l,0,2) CE16(l,1,3) CE16(l,1,2) CE16(l,4,5) CE16(l,6,7) CE16(l,4,6) CE16(l,5,7) CE16(l,5,6) CE16(l,0,4) CE16(l,2,6) CE16(l,2,4) CE16(l,1,5) CE16(l,3,7) CE16(l,3,5) CE16(l,1,2) CE16(l,3,4) CE16(l,5,6) CE16(l,8,9) CE16(l,10,11) CE16(l,8,10) CE16(l,9,11) CE16(l,9,10) CE16(l,12,13) CE16(l,14,15) CE16(l,12,14) CE16(l,13,15) CE16(l,13,14) CE16(l,8,12) CE16(l,10,14) CE16(l,10,12) CE16(l,9,13) CE16(l,11,15) CE16(l,11,13) CE16(l,9,10) CE16(l,11,12) CE16(l,13,14) CE16(l,0,8) CE16(l,4,12) CE16(l,4,8) CE16(l,2,10) CE16(l,6,14) CE16(l,6,10) CE16(l,2,4) CE16(l,6,8) CE16(l,10,12) CE16(l,1,9) CE16(l,5,13) CE16(l,5,9) CE16(l,3,11) CE16(l,7,15) CE16(l,7,11) CE16(l,3,5) CE16(l,7,9) CE16(l,11,13) CE16(l,1,2) CE16(l,3,4) CE16(l,5,6) CE16(l,7,8) CE16(l,9,10) CE16(l,11,12) CE16(l,13,14) } while (0)
#define BITONIC16_DESC(l) do { _Pragma("unroll") for (int d_ = 8; d_ >= 1; d_ >>= 1) _Pragma("unroll") for (int i_ = 0; i_ < 16; ++i_) if ((i_ & d_) == 0) { const float hi_ = fmaxf(l[i_], l[i_ + d_]), lo_ = fminf(l[i_], l[i_ + d_]); l[i_] = hi_; l[i_ + d_] = lo_; } } while (0)
#define MERGE16_REG(l, o) do { _Pragma("unroll") for (int i_ = 0; i_ < 16; ++i_) l[i_] = fmaxf(l[i_], o[15 - i_]); BITONIC16_DESC(l); } while (0)
#define MERGE16_XOR(l, mask) do { float o_[16]; _Pragma("unroll") for (int i_ = 0; i_ < 16; ++i_) o_[i_] = __shfl_xor(l[i_], (mask)); MERGE16_REG(l, o_); } while (0)

struct Ptrs {
    const float *x, *mix_g, *w_in, *q_g, *k_g, *vg_g, *w_sp, *b_sp, *ao_g, *go_g, *w_out, *ffn_g, *w_query, *keys_a, *keys_b, *exp_u, *exp_v;
    float* out; unsigned char* ws;
};
struct Args { Ptrs p; int ph_lo, ph_hi, probe, pad; };

__device__ __forceinline__ void p0_transpose_item(const float* W, int K, int N, bf16* WT, bool perm, LAS float* scr, int item, int lane) {
    const int nblk = N / 32, kb = item / nblk, nb = item % nblk, k0 = 64 * kb, n0 = 32 * nb;
    int pn0 = n0;
    if (perm) { const int tile = n0 >> 8, lb = (n0 & 255) >> 5; pn0 = (tile << 8) + 32 * (4 * (lb & 1) + (lb >> 1)); }
#pragma unroll 8
    for (int i = 0; i < 32; ++i) { const int kk = 2 * i + (lane >> 5); scr[kk * 33 + (lane & 31)] = W[(size_t)(k0 + kk) * N + n0 + (lane & 31)]; }
    asm volatile("s_waitcnt lgkmcnt(0)" ::: "memory");
    const int c = lane & 7;
#pragma unroll
    for (int j = 0; j < 4; ++j) { const int n = (lane >> 3) + 8 * j; const LAS float* s = scr + (8 * c) * 33 + n;
        v4u o; o.x = pk2(s[0 * 33], s[1 * 33]); o.y = pk2(s[2 * 33], s[3 * 33]); o.z = pk2(s[4 * 33], s[5 * 33]); o.w = pk2(s[6 * 33], s[7 * 33]);
        *(v4u*)(WT + (size_t)(pn0 + n) * K + k0 + 8 * c) = o; }
    asm volatile("s_waitcnt lgkmcnt(0)" ::: "memory");
}

__device__ __forceinline__ void p0_fold_item(const Ptrs& p, LAS unsigned char* lds, int it, int tid) {
    const int h = it >> 5, half = (it >> 4) & 1, d0 = (it & 15) * 64;
    LAS float* A = (LAS float*)lds;
    LAS float* Kt = (LAS float*)(lds + 33280);
    const float* wq = p.w_query + h * 256 + half * 128;
    for (int i = tid; i < 8192; i += NTHR) { const int dd = i >> 7, c = i & 127; A[dd * 129 + c] = wq[(size_t)(d0 + dd) * 2048 + c]; }
    const float* keys = half ? p.keys_b : p.keys_a;
    for (int i = tid; i < 16384; i += NTHR) Kt[i] = keys[i];
    __syncthreads();
    const int dd = tid & 63, kg = tid >> 6;
    float acc[16];
#pragma unroll
    for (int kk = 0; kk < 16; ++kk) acc[kk] = 0.f;
    for (int c = 0; c < 128; ++c) { const float a = A[dd * 129 + c];
#pragma unroll
        for (int kk = 0; kk < 16; ++kk) acc[kk] += a * Kt[(kg * 16 + kk) * 128 + c]; }
    const float g = p.ffn_g[d0 + dd];
    bf16* WQK = (bf16*)(p.ws + WS_WQK);
#pragma unroll
    for (int kk = 0; kk < 16; ++kk) { const int key = kg * 16 + kk, wcq = 2 * half + (key >> 6), kidx = key & 63;
        const int prow = 128 * (kidx >> 5) + 32 * wcq + 16 * ((kidx >> 4) & 1) + 4 * ((kidx >> 2) & 3) + (kidx & 3);
        WQK[(size_t)(h * 256 + prow) * 1024 + d0 + dd] = (bf16)f2bf(acc[kk] * g); }
    __syncthreads();
}

__device__ __forceinline__ void p0_prologue(const Ptrs& p, LAS unsigned char* lds, int tid, int lane, int wave, int vcu, int G) {
    for (int it = blockIdx.x; it < 256; it += G) p0_fold_item(p, lds, it, tid);
    __syncthreads();
    const int gw = vcu * NWAVES + wave, NGW = G * NWAVES;
    LAS float* scr = (LAS float*)(lds + wave * 16384);
    constexpr int I_IN = (D / 64) * (INW / 32), I_OUT = (D / 64) * (D / 32);
    bf16* WIN = (bf16*)(p.ws + WS_WIN); bf16* WOUT = (bf16*)(p.ws + WS_WOUT);
    for (int it = gw; it < I_IN + I_OUT; it += NGW) {
        if (it < I_IN) p0_transpose_item(p.w_in, D, INW, WIN, true, scr, it, lane);
        else p0_transpose_item(p.w_out, D, D, WOUT, false, scr, it - I_IN, lane);
    }
    const int gt = gw * 64 + lane, NGT = NGW * 64;
    {
        unsigned char* EU4 = p.ws + WS_EU; unsigned char* EV4 = p.ws + WS_EV; float* SU = (float*)(p.ws + WS_SU); float* SV = (float*)(p.ws + WS_SV);
        f32x4 gf[4];
#pragma unroll
        for (int j = 0; j < 4; ++j) gf[j] = *(const f32x4*)(p.ffn_g + lane * 16 + 4 * j);
        f32x4 nv[4];
        if (gw < 2 * NEXP) { const float* src0 = ((gw & 1) ? p.exp_v : p.exp_u) + (size_t)(gw >> 1) * D + lane * 16;
#pragma unroll
            for (int j = 0; j < 4; ++j) nv[j] = *(const f32x4*)(src0 + 4 * j); }
        for (int r = gw; r < 2 * NEXP; r += NGW) {
            const int e = r >> 1, tb = r & 1;
            f32x4 v[4]; float ss = 0.f;
#pragma unroll
            for (int j = 0; j < 4; ++j) v[j] = nv[j];
            { const int rn = (r + NGW < 2 * NEXP) ? r + NGW : r; const float* srcn = ((rn & 1) ? p.exp_v : p.exp_u) + (size_t)(rn >> 1) * D + lane * 16;
#pragma unroll
              for (int j = 0; j < 4; ++j) nv[j] = *(const f32x4*)(srcn + 4 * j); }
#pragma unroll
            for (int j = 0; j < 4; ++j) { if (!tb) v[j] = v[j] * gf[j];
                ss += (v[j][0] * v[j][0] + v[j][1] * v[j][1]) + (v[j][2] * v[j][2] + v[j][3] * v[j][3]); }
            ss = wave_sum(ss);
            const float sc = (ss > 0.f) ? 0.5f * sqrtf(ss * (1.f / D)) : 1.f, inv = 1.f / sc;
            unsigned wlo = 0u, whi = 0u;
#pragma unroll
            for (int j = 0; j < 4; ++j)
#pragma unroll
                for (int i = 0; i < 4; ++i) { const float y = v[j][i] * inv, a = fabsf(y);
                    const unsigned code = (unsigned)(a > 0.25f) + (unsigned)(a > 0.75f) + (unsigned)(a > 1.25f) + (unsigned)(a > 1.75f) + (unsigned)(a > 2.5f) + (unsigned)(a > 3.5f) + (unsigned)(a > 5.0f) + ((y < 0.f) ? 8u : 0u);
                    const int n = 4 * j + i; if (n < 8) wlo |= code << (4 * n); else whi |= code << (4 * (n - 8)); }
            unsigned char* dst = (tb ? EV4 : EU4) + ((size_t)(lane >> 4) * NEXP + e) * 128 + (lane & 15) * 8;
            if (tb) {
                LAS unsigned* cs4 = (LAS unsigned*)scr;
                cs4[lane * 2] = wlo; cs4[lane * 2 + 1] = whi;
                asm volatile("s_waitcnt lgkmcnt(0)" ::: "memory");
                const int q = lane & 15, sl = lane >> 4; unsigned tlo = 0u, thi = 0u;
#pragma unroll
                for (int n = 0; n < 16; ++n) { const int m = 4 * (n & 3);
                    const unsigned w = cs4[(sl * 16 + 4 * (q & 3) + (n >> 2)) * 2 + (m >> 3)]; const unsigned code = (w >> (4 * ((m & 7) + (q >> 2)))) & 0xfu;
                    if (n < 8) tlo |= code << (4 * n); else thi |= code << (4 * (n - 8)); }
                asm volatile("s_waitcnt lgkmcnt(0)" ::: "memory");
                wlo = tlo; whi = thi;
            }
            *(v2u*)dst = (v2u){wlo, whi};
            if (lane == 0) (tb ? SV : SU)[e] = sc;
        }
    }
    bf16* WSP = (bf16*)(p.ws + WS_WSP);
    for (int i = gt; i < 4 * 128 * 128; i += NGT) {
        const int pj = i & 127, ii = (i >> 7) & 127, g = i >> 14;
        const int ks = pj >> 4, hi = (pj >> 3) & 1, jj = pj & 7, j = 16 * ks + 4 * hi + (jj & 3) + 8 * (jj >> 2);
        WSP[i] = (bf16)((j <= ii) ? f2bf(p.w_sp[(g * 128 + ii) * 128 + j]) : 0u);
    }
    bf16* HN = (bf16*)(p.ws + WS_HN);
    {
        f32x4 g4[4];
#pragma unroll
        for (int j = 0; j < 4; ++j) g4[j] = *((const f32x4*)p.mix_g + lane + 64 * j);
        f32x4 nx[4];
        if (gw < T) {
#pragma unroll
            for (int j = 0; j < 4; ++j) nx[j] = ((const f32x4*)(p.x + (size_t)gw * D) + lane)[64 * j]; }
        for (int m = gw; m < T; m += NGW) {
            f32x4 v[4]; float s = 0.f;
#pragma unroll
            for (int j = 0; j < 4; ++j) v[j] = nx[j];
            const int mn = (m + NGW < T) ? m + NGW : m;
#pragma unroll
            for (int j = 0; j < 4; ++j) nx[j] = ((const f32x4*)(p.x + (size_t)mn * D) + lane)[64 * j];
#pragma unroll
            for (int j = 0; j < 4; ++j) s += (v[j].x * v[j].x + v[j].y * v[j].y) + (v[j].z * v[j].z + v[j].w * v[j].w);
            const float r = rsqrtf(wave_sum(s) * (1.f / D) + EPS);
            v2u* o8 = (v2u*)(HN + (size_t)m * D) + lane;
#pragma unroll
            for (int j = 0; j < 4; ++j) { const f32x4 g = g4[j]; v2u o; o.x = pk2(v[j].x * r * g.x, v[j].y * r * g.y); o.y = pk2(v[j].z * r * g.z, v[j].w * r * g.w); o8[64 * j] = o; }
        }
    }
}

struct EpiProj {
    static constexpr bool PERM = true, AFTER_DRAIN = false;
    bf16 *Q, *K, *V, *GU, *GV; const float *qg, *kg;
    __device__ __forceinline__ void operator()(const pg8::f32x4 (&acc)[2][2][4][2], const pg8::Unit& u, int wr, int wc, int fr, int fq) const {
        const int type = u.pn >> 1;
        bf16* base = type == 0 ? Q : type == 1 ? K : type == 2 ? V : type == 3 ? GU : GV;
        const int ct = (u.pn & 1) * 256 + wc * 64 + 8 * fq;
        const int row0 = u.pm * 256 + wr * 64 + fr;
        if (type <= 1) {
            const float* g = type == 0 ? qg : kg; const float sc = type == 0 ? QSCALE : 1.f;
            f32x4 gv[2][2];
#pragma unroll
            for (int bj = 0; bj < 2; ++bj)
#pragma unroll
                for (int n = 0; n < 2; ++n) gv[bj][n] = *(const f32x4*)(g + 32 * bj + 8 * fq + 4 * n);
#pragma unroll
            for (int ai = 0; ai < 2; ++ai)
#pragma unroll
                for (int m = 0; m < 4; ++m) {
                    float ss = 0.f;
#pragma unroll
                    for (int bj = 0; bj < 2; ++bj)
#pragma unroll
                        for (int n = 0; n < 2; ++n) { const f32x4 v = acc[ai][bj][m][n]; ss += (v[0] * v[0] + v[1] * v[1]) + (v[2] * v[2] + v[3] * v[3]); }
                    ss = sum_x32(sum_x16(ss));
                    const float r = rsqrtf(ss * (1.f / 64.f) + EPS) * sc;
                    bf16* rowp = base + (size_t)(row0 + ai * 128 + m * 16) * 512 + ct;
#pragma unroll
                    for (int bj = 0; bj < 2; ++bj) { const f32x4 v0 = acc[ai][bj][m][0] * gv[bj][0] * r, v1 = acc[ai][bj][m][1] * gv[bj][1] * r;
                        v4u w; w.x = pk2(v0[0], v0[1]); w.y = pk2(v0[2], v0[3]); w.z = pk2(v1[0], v1[1]); w.w = pk2(v1[2], v1[3]);
                        *(v4u*)(rowp + 32 * bj) = w; }
                }
        } else {
#pragma unroll
            for (int ai = 0; ai < 2; ++ai)
#pragma unroll
                for (int m = 0; m < 4; ++m) {
                    bf16* rowp = base + (size_t)(row0 + ai * 128 + m * 16) * 512 + ct;
#pragma unroll
                    for (int bj = 0; bj < 2; ++bj) { f32x4 v0 = acc[ai][bj][m][0], v1 = acc[ai][bj][m][1];
                        if (type >= 3) { pg8::f32x2 a = pg8::gelu_pk((pg8::f32x2){v0[0], v0[1]}), b = pg8::gelu_pk((pg8::f32x2){v0[2], v0[3]}), c = pg8::gelu_pk((pg8::f32x2){v1[0], v1[1]}), d = pg8::gelu_pk((pg8::f32x2){v1[2], v1[3]});
                            v0 = (f32x4){a.x, a.y, b.x, b.y}; v1 = (f32x4){c.x, c.y, d.x, d.y}; }
                        v4u w; w.x = pk2(v0[0], v0[1]); w.y = pk2(v0[2], v0[3]); w.z = pk2(v1[0], v1[1]); w.w = pk2(v1[2], v1[3]);
                        *(v4u*)(rowp + 32 * bj) = w; }
                }
        }
    }
};
struct EpiOut {
    static constexpr bool PERM = true, AFTER_DRAIN = false;
    const float* X; float* OUT; bf16* X1B; float* PART; unsigned char* XF8;
    __device__ __forceinline__ void operator()(const pg8::f32x4 (&acc)[2][2][4][2], const pg8::Unit& u, int wr, int wc, int fr, int fq) const {
        const int row0 = u.pm * 256 + wr * 64 + fr, col0 = u.pn * 256 + wc * 32 + 8 * fq;
#pragma unroll
        for (int ai = 0; ai < 2; ++ai) {
            f32x4 xv[4][2][2];
#pragma unroll
            for (int m = 0; m < 4; ++m)
#pragma unroll
                for (int bj = 0; bj < 2; ++bj)
#pragma unroll
                    for (int n = 0; n < 2; ++n) xv[m][bj][n] = *(const f32x4*)(X + (size_t)(row0 + ai * 128 + m * 16) * D + col0 + bj * 128 + n * 4);
#pragma unroll
            for (int m = 0; m < 4; ++m) {
                const int row = row0 + ai * 128 + m * 16; float ss = 0.f;
#pragma unroll
                for (int bj = 0; bj < 2; ++bj) { const size_t off = (size_t)row * D + col0 + bj * 128;
                    const f32x4 o0 = xv[m][bj][0] + acc[ai][bj][m][0], o1 = xv[m][bj][1] + acc[ai][bj][m][1];
                    ss += ((o0[0] * o0[0] + o0[1] * o0[1]) + (o0[2] * o0[2] + o0[3] * o0[3])) + ((o1[0] * o1[0] + o1[1] * o1[1]) + (o1[2] * o1[2] + o1[3] * o1[3]));
                    v4u w; w.x = pk2(o0[0], o0[1]); w.y = pk2(o0[2], o0[3]); w.z = pk2(o1[0], o1[1]); w.w = pk2(o1[2], o1[3]); *(v4u*)(X1B + off) = w;
                    int lo = 0, hi = 0;
                    lo = __builtin_amdgcn_cvt_pk_fp8_f32(o0[0] * 8.f, o0[1] * 8.f, lo, false); lo = __builtin_amdgcn_cvt_pk_fp8_f32(o0[2] * 8.f, o0[3] * 8.f, lo, true);
                    hi = __builtin_amdgcn_cvt_pk_fp8_f32(o1[0] * 8.f, o1[1] * 8.f, hi, false); hi = __builtin_amdgcn_cvt_pk_fp8_f32(o1[2] * 8.f, o1[3] * 8.f, hi, true);
                    *(v2u*)(XF8 + off) = (v2u){(unsigned)lo, (unsigned)hi}; }
                ss = sum_x32(sum_x16(ss));
                if (fq == 0) PART[(size_t)row * 16 + u.pn * 4 + wc] = ss;
            }
        }
    }
};
struct EpiF32 {
    static constexpr bool PERM = false, AFTER_DRAIN = false;
    float* C; int ldc;
    __device__ __forceinline__ void operator()(const pg8::f32x4 (&acc)[2][2][4][2], const pg8::Unit& u, int wr, int wc, int fr, int fq) const {
        const int row0 = u.pm * 256 + wr * 64 + fr, col0 = u.pn * 256 + wc * 32 + 4 * fq;
#pragma unroll
        for (int ai = 0; ai < 2; ++ai)
#pragma unroll
            for (int m = 0; m < 4; ++m) { float* rowp = C + (size_t)(row0 + ai * 128 + m * 16) * ldc + col0;
#pragma unroll
                for (int bj = 0; bj < 2; ++bj)
#pragma unroll
                    for (int n = 0; n < 2; ++n) *(f32x4*)(rowp + bj * 128 + n * 16) = acc[ai][bj][m][n]; }
    }
};

struct EpiTopk {
    static constexpr bool PERM = false, AFTER_DRAIN = false;
    float* TOPW;
    __device__ __forceinline__ void operator()(const pg8::f32x4 (&acc)[2][2][4][2], const pg8::Unit& u, int wr, int wc, int fr, int fq) const {
        const int row0 = u.pm * 256 + wr * 64 + fr; unsigned kb = 64u * (wc & 1) + 4u * fq;
        asm volatile("" : "+v"(kb));
#pragma unroll
        for (int ai = 0; ai < 2; ++ai) {
            float x[16], y[16], r[16];
#define TOPK_PACK(dst, m) do { _Pragma("unroll") for (int bj = 0; bj < 2; ++bj) _Pragma("unroll") for (int n = 0; n < 2; ++n) _Pragma("unroll") for (int i = 0; i < 4; ++i) \
                dst[8 * bj + 4 * n + i] = __uint_as_float(((__float_as_uint(acc[ai][bj][m][n][i]) & ~0x7fu) | kb) | (32u * bj + 16u * n + i));   \
                SORT16_DESC(dst); } while (0)
            TOPK_PACK(x, 0); TOPK_PACK(r, 1);
#pragma unroll
            for (int i = 0; i < 16; ++i) swap16(x[i], r[i]);
            MERGE16_REG(x, r);
            __builtin_amdgcn_sched_barrier(0);
            TOPK_PACK(y, 2); TOPK_PACK(r, 3);
#pragma unroll
            for (int i = 0; i < 16; ++i) swap16(y[i], r[i]);
            MERGE16_REG(y, r);
            __builtin_amdgcn_sched_barrier(0);
#pragma unroll
            for (int i = 0; i < 16; ++i) { r[i] = y[i]; swap32(x[i], r[i]); }
            MERGE16_REG(x, r);
#undef TOPK_PACK
            f32x4* o = (f32x4*)(TOPW + (((size_t)(row0 + ai * 128 + fq * 16) * 8 + u.pn) * 4 + wc) * 16);
            o[0] = (f32x4){x[0], x[1], x[2], x[3]}; o[1] = (f32x4){x[4], x[5], x[6], x[7]}; o[2] = (f32x4){x[8], x[9], x[10], x[11]}; o[3] = (f32x4){x[12], x[13], x[14], x[15]};
        }
    }
};

constexpr int A_KP = 1152, A_KT = 8 * A_KP;
constexpr int A_K = 0, A_V = 6 * A_KT, A_ST = A_V + 49152, A_STW = 32 * 144;
struct AttnU { int h, pat, dl, m0, jlo; size_t rowbase; };
__device__ __forceinline__ AttnU attn_decode(int unit) {
    AttnU u; const int bh = unit / 48, rem = unit % 48, k16 = rem & 15; u.pat = rem >> 4;
    const int b = bh >> 3, nb = 16 >> (2 * u.pat), r = k16 / nb, qb = k16 % nb;
    u.h = bh & 7; u.dl = 1 << (2 * u.pat); u.m0 = qb * 256; u.jlo = (qb == 0) ? 2 : 0; u.rowbase = (size_t)b * SEQ + r; return u;
}
__device__ __forceinline__ long attn_off(const AttnU& u, int m) { return (((long)u.rowbase + (long)m * u.dl) * 512 + u.h * 64) * 2; }
__device__ __forceinline__ void attn_dma16(const unsigned char* ubase, unsigned voff, LAS unsigned char* ldst) {
    asm volatile("s_mov_b32 m0, %0\n\ts_nop 0\n\tglobal_load_lds_dwordx4 %1, %2" :: "s"((unsigned)(unsigned long long)ldst), "v"(voff), "s"(ubase) : "memory", "m0");
}
__device__ __forceinline__ void attn_wait(int n) {
    switch (n) {
#define AW_(k) case k: asm volatile("s_waitcnt vmcnt(" #k ")" ::: "memory"); break;
        AW_(4) AW_(5) AW_(6) AW_(9) AW_(11)
#undef AW_
        default: asm volatile("s_waitcnt vmcnt(0)" ::: "memory"); break;
    }
}
__device__ __forceinline__ void attn_dma_k(const Ptrs& p, LAS unsigned char* lds, const AttnU& u, int lane, int w) {
    const unsigned char* kb = p.ws + WS_K + attn_off(u, u.m0 - 128 + 8 * w); const unsigned voff = (unsigned)((lane & 7) * u.dl) * 1024u + (lane >> 3) * 16u;
#pragma unroll
    for (int j = 0; j < 6; ++j) if (j >= u.jlo)
        attn_dma16(kb + (size_t)(j * 64 * u.dl) * 1024, voff, lds + A_K + j * A_KT + w * A_KP);
}
__device__ __forceinline__ void attn_dma_v(const Ptrs& p, LAS unsigned char* lds, const AttnU& u, int lane, int w) {
    const unsigned char* vb = p.ws + WS_V + attn_off(u, u.m0 - 128 + 8 * w); const unsigned voff = (unsigned)(((lane >> 2) & 7) * u.dl) * 1024u + (lane >> 5) * 64u + (lane & 3) * 16u;
#pragma unroll
    for (int j = 0; j < 6; ++j) if (j >= u.jlo)
        attn_dma16(vb + (size_t)(j * 64 * u.dl) * 1024, voff, lds + A_V + j * 8192 + w * 1024);
}
__device__ __forceinline__ void attn_dma_q(const Ptrs& p, LAS unsigned char* lds, const AttnU& u, int lane, int w) {
    const unsigned char* qb = p.ws + WS_Q + attn_off(u, u.m0 + 32 * w); const unsigned voff = (unsigned)((lane & 7) * u.dl) * 1024u + (lane >> 3) * 16u;
#pragma unroll
    for (int i = 0; i < 4; ++i)
        attn_dma16(qb + (size_t)(i * 8 * u.dl) * 1024, voff, lds + A_ST + w * A_STW + i * 1024);
}
__device__ __forceinline__ void attn_read_q(bf16x8 (&q)[4], LAS unsigned char* lds, int lane, int w) {
    const int r32 = lane & 31, hi = lane >> 5;
    const LAS unsigned char* qs = lds + A_ST + w * A_STW + (r32 >> 3) * 1024 + hi * 128 + (r32 & 7) * 16;
#pragma unroll
    for (int d0 = 0; d0 < 4; ++d0) q[d0] = *(const LAS bf16x8*)(qs + d0 * 256);
    asm volatile("s_waitcnt lgkmcnt(0)" ::: "memory");
}
#define ATT_BAR_VM() do { asm volatile("s_waitcnt vmcnt(0) lgkmcnt(0)" ::: "memory"); __builtin_amdgcn_s_barrier(); asm volatile("" ::: "memory"); } while (0)
#define ATT_BAR_LDS() do { asm volatile("s_waitcnt lgkmcnt(0)" ::: "memory"); __builtin_amdgcn_s_barrier(); asm volatile("" ::: "memory"); } while (0)
template <bool FIRST>
__device__ __forceinline__ void attn_pv_tile(f32x16 (&o)[2], const f32x16& zacc, const v4u (&pwi)[2], const LAS unsigned char* vb) {
#pragma unroll
    for (int ks = 0; ks < 2; ++ks) {
        const bf16x8 pa = __builtin_bit_cast(bf16x8, pwi[ks]);
#pragma unroll
        for (int d0 = 0; d0 < 2; ++d0) {
            const s16x4 lo = __builtin_bit_cast(s16x4, __builtin_amdgcn_ds_read_tr16_b64_v4i16((LAS v4i16_t*)(vb + d0 * 512 + ks * 2048)));
            const s16x4 hh = __builtin_bit_cast(s16x4, __builtin_amdgcn_ds_read_tr16_b64_v4i16((LAS v4i16_t*)(vb + d0 * 512 + ks * 2048 + 1024)));
            const bf16x8 vf = (bf16x8){lo[0], lo[1], lo[2], lo[3], hh[0], hh[1], hh[2], hh[3]};
            if (FIRST && ks == 0) o[d0] = __builtin_amdgcn_mfma_f32_32x32x16_bf16(vf, pa, zacc, 0, 0, 0);
            else o[d0] = __builtin_amdgcn_mfma_f32_32x32x16_bf16(vf, pa, o[d0], 0, 0, 0);
        }
    }
}
__device__ __forceinline__ void attn_compute(const Ptrs& p, LAS unsigned char* lds, const AttnU& u, const AttnU& un, bool has_next, bool first, bf16x8 (&qr)[4], int lane, int w) {
    const int r32 = lane & 31, hi = lane >> 5, glo = 2 * u.jlo;
    const float NEGINF = -INFINITY;
    attn_wait(first ? 0 : (6 - u.jlo) + 5);
    ATT_BAR_LDS();
    if (has_next) attn_dma_q(p, lds, un, lane, w);
    f32x16 zacc = {}; asm volatile("" : "+v"(zacc));
    f32x16 sc[5];
#pragma unroll
    for (int i = 0; i < 5; ++i) {
        const int g = w + i;
        f32x16 a;
        if (g >= glo) {
            const LAS unsigned char* kb = lds + A_K + (g >> 1) * A_KT + ((g & 1) * 4 + (r32 >> 3)) * A_KP + hi * 128 + (r32 & 7) * 16;
            a = __builtin_amdgcn_mfma_f32_32x32x16_bf16(*(const LAS bf16x8*)(kb), qr[0], zacc, 0, 0, 0);
#pragma unroll
            for (int d0 = 1; d0 < 4; ++d0) a = __builtin_amdgcn_mfma_f32_32x32x16_bf16(*(const LAS bf16x8*)(kb + d0 * 256), qr[d0], a, 0, 0, 0);
            if (i == 0) {
#pragma unroll
                for (int rr = 0; rr < 16; ++rr) a[rr] = (crow(rr, hi) >= r32) ? a[rr] : NEGINF; }
            if (i == 4) {
#pragma unroll
                for (int rr = 0; rr < 16; ++rr) a[rr] = (crow(rr, hi) <= r32) ? a[rr] : NEGINF; }
        } else {
#pragma unroll
            for (int rr = 0; rr < 16; ++rr) a[rr] = NEGINF; }
        sc[i] = a;
    }
    ATT_BAR_LDS();
    if (has_next) attn_dma_k(p, lds, un, lane, w);
    float mx = NEGINF;
#pragma unroll
    for (int i = 0; i < 5; ++i)
#pragma unroll
        for (int rr = 0; rr < 16; ++rr) mx = fmaxf(mx, sc[i][rr]);
    mx = max_x32(mx);
    const f32x2_t mx2 = {mx, mx};
    f32x2_t l2 = {0.f, 0.f};
    v4u pw[5][2];
#pragma unroll
    for (int i = 0; i < 5; ++i) {
        unsigned pk[8];
#pragma unroll
        for (int r2 = 0; r2 < 8; ++r2) { const f32x2_t d = (f32x2_t){sc[i][2 * r2], sc[i][2 * r2 + 1]} - mx2; const f32x2_t e = {__builtin_amdgcn_exp2f(d.x), __builtin_amdgcn_exp2f(d.y)}; l2 += e; pk[r2] = pk2(e.x, e.y); }
        pw[i][0] = (v4u){pk[0], pk[1], pk[2], pk[3]};
        pw[i][1] = (v4u){pk[4], pk[5], pk[6], pk[7]};
    }
    float l = l2.x + l2.y;
    l = sum_x32(l);
    attn_wait(has_next ? 6 - un.jlo : (first ? 0 : 5));
    if (has_next) attn_read_q(qr, lds, lane, w);
    ATT_BAR_LDS();
    f32x16 o[2];
    const int vlane = ((lane >> 4) & 1) * 32 + (lane & 3) * 8 + (4 * hi + ((lane & 15) >> 2)) * 64;
    { const int g = w + 4; attn_pv_tile<true>(o, zacc, pw[4], lds + A_V + (g >> 1) * 8192 + (g & 1) * 4096 + vlane); }
#pragma unroll
    for (int i = 0; i < 4; ++i) {
        const int g = w + i;
        if (g >= glo) attn_pv_tile<false>(o, zacc, pw[i], lds + A_V + (g >> 1) * 8192 + (g & 1) * 4096 + vlane);
    }
    ATT_BAR_LDS();
    if (has_next) attn_dma_v(p, lds, un, lane, w);
    const float rl = __builtin_amdgcn_rcpf(l);
    if (hi == 0) *(float*)(p.ws + WS_LSE + ((size_t)u.pat * T * 8 + (u.rowbase + (size_t)(u.m0 + 32 * w) * u.dl) * 8 + u.h) * 4 + (unsigned)(r32 * u.dl) * 32u) = mx + __builtin_amdgcn_logf(l);
    LAS unsigned char* stw = lds + A_ST + w * A_STW;
    LAS unsigned char* stg = stw + r32 * 144 + hi * 8;
#pragma unroll
    for (int d0 = 0; d0 < 2; ++d0)
#pragma unroll
        for (int q4 = 0; q4 < 4; ++q4)
            *(LAS v2u*)(stg + d0 * 64 + q4 * 16) = (v2u){pk2(o[d0][4 * q4] * rl, o[d0][4 * q4 + 1] * rl), pk2(o[d0][4 * q4 + 2] * rl, o[d0][4 * q4 + 3] * rl)};
    asm volatile("s_waitcnt lgkmcnt(0)" ::: "memory");
    unsigned char* pob = p.ws + WS_PO + (size_t)u.pat * T * 1024 + attn_off(u, u.m0 + 32 * w); const unsigned pvoff = (unsigned)((lane >> 3) * u.dl) * 1024u + (lane & 7) * 16u;
#pragma unroll
    for (int i = 0; i < 4; ++i) { const v4u v = *(const LAS v4u*)(stw + (i * 8 + (lane >> 3)) * 144 + (lane & 7) * 16);
        *(v4u*)(pob + (size_t)(i * 8 * u.dl) * 1024 + pvoff) = v; }
}
__device__ __forceinline__ void attn_phase(const Ptrs& p, LAS unsigned char* lds, int vcu, int G, int lane, int w) {
    const int NU = BATCH * NH * 48;
    if (vcu >= NU) return;
    AttnU u = attn_decode(vcu);
    bf16x8 qr[4];
    __builtin_amdgcn_s_waitcnt(0x0F70);
    attn_dma_k(p, lds, u, lane, w); attn_dma_v(p, lds, u, lane, w); attn_dma_q(p, lds, u, lane, w);
    asm volatile("s_waitcnt vmcnt(0)" ::: "memory");
    attn_read_q(qr, lds, lane, w);
    bool first = true;
    for (int unit = vcu; unit < NU; unit += G) {
        const bool has_next = unit + G < NU;
        const AttnU un = attn_decode(has_next ? unit + G : unit);
        attn_compute(p, lds, u, un, has_next, first, qr, lane, w);
        u = un; first = false;
    }
    ATT_BAR_VM();
}

__device__ __forceinline__ void gmlp_unit(const Ptrs& p, LAS unsigned char* lds, int unit, int tid, int lane, int w) {
    const size_t rowbase = (size_t)unit * 128;
    const bf16* GU = (const bf16*)(p.ws + WS_GU); const bf16* GV = (const bf16*)(p.ws + WS_GV); const bf16* WSP = (const bf16*)(p.ws + WS_WSP);
    bf16* MG = (bf16*)(p.ws + WS_HN);
    const int r32 = lane & 31, hi = lane >> 5;
    {
        const int g = lane >> 4; f32x4 ga = *(const f32x4*)(p.vg_g + g * 128 + (lane & 15) * 8), gb = *(const f32x4*)(p.vg_g + g * 128 + (lane & 15) * 8 + 4);
#pragma unroll 4
        for (int it = 0; it < 16; ++it) {
            const int j = it * 8 + w;
            const v4u raw = *(const v4u*)(GV + (rowbase + j) * 512 + lane * 8);
            float v[8] = {bflo(raw.x), bfhi(raw.x), bflo(raw.y), bfhi(raw.y), bflo(raw.z), bfhi(raw.z), bflo(raw.w), bfhi(raw.w)};
            float ss = 0.f;
#pragma unroll
            for (int i = 0; i < 8; ++i) ss += v[i] * v[i];
            ss = row_sum16(ss);
            const float rn = rsqrtf(ss * (1.f / 128.f) + EPS);
            v4u o; o.x = pk2(v[0] * rn * ga.x, v[1] * rn * ga.y); o.y = pk2(v[2] * rn * ga.z, v[3] * rn * ga.w); o.z = pk2(v[4] * rn * gb.x, v[5] * rn * gb.y); o.w = pk2(v[6] * rn * gb.z, v[7] * rn * gb.w);
            *(LAS v4u*)(lds + ((lane >> 2) * 8 + (j >> 4)) * 1024 + (j & 15) * 64 + (lane & 3) * 16) = o;
        }
    }
    __syncthreads();
    const int ib = w & 3, gp = w >> 2;
    f32x16 acc[8];
#pragma unroll
    for (int i = 0; i < 8; ++i) acc[i] = (f32x16){};
    const int vlane = ((lane >> 4) & 1) * 32 + (lane & 3) * 8 + (4 * hi + ((lane & 15) >> 2)) * 64;
#pragma unroll
    for (int g2 = 0; g2 < 2; ++g2) {
        const int g = 2 * gp + g2;
        for (int ks = 0; ks < 2 * ib + 2; ++ks) {
            const bf16x8 af = *(const bf16x8*)(WSP + (size_t)((g * 128 + 32 * ib + r32) * 128 + 16 * ks + 8 * hi));
#pragma unroll
            for (int ct = 0; ct < 4; ++ct) {
                const LAS unsigned char* vb = lds + ((g * 4 + ct) * 8 + ks) * 1024 + vlane;
                const s16x4 lo = __builtin_bit_cast(s16x4, __builtin_amdgcn_ds_read_tr16_b64_v4i16((LAS v4i16_t*)(vb)));
                const s16x4 hh = __builtin_bit_cast(s16x4, __builtin_amdgcn_ds_read_tr16_b64_v4i16((LAS v4i16_t*)(vb + 512)));
                const bf16x8 vf = (bf16x8){lo[0], lo[1], lo[2], lo[3], hh[0], hh[1], hh[2], hh[3]};
                acc[g2 * 4 + ct] = __builtin_amdgcn_mfma_f32_32x32x16_bf16(af, vf, acc[g2 * 4 + ct], 0, 0, 0);
            }
        }
    }
    __syncthreads();
#pragma unroll
    for (int g2 = 0; g2 < 2; ++g2) {
        const int g = 2 * gp + g2;
#pragma unroll
        for (int rr = 0; rr < 16; ++rr) {
            const int i = 32 * ib + crow(rr, hi); const float bias = p.b_sp[g * 128 + i];
#pragma unroll
            for (int ct = 0; ct < 4; ++ct) {
                const int c = g * 128 + ct * 32 + r32;
                *(LAS bf16*)(lds + (i * 512 + c) * 2) = (bf16)f2bf(acc[g2 * 4 + ct][rr] + bias);
            }
        }
    }
    __syncthreads();
    {
        const f32x4 ga = *(const f32x4*)(p.go_g + lane * 8), gb = *(const f32x4*)(p.go_g + lane * 8 + 4);
#pragma unroll 4
        for (int ii = 0; ii < 16; ++ii) {
            const int i = 16 * w + ii;
            const v4u raw = *(const LAS v4u*)(lds + (i * 512 + lane * 8) * 2);
            const v4u gur = *(const v4u*)(GU + (rowbase + i) * 512 + lane * 8);
            const unsigned z0 = raw.x, z1 = raw.y, z2 = raw.z, z3 = raw.w, u0 = gur.x, u1 = gur.y, u2 = gur.z, u3 = gur.w;
            float v[8] = {bflo(z0) * bflo(u0), bfhi(z0) * bfhi(u0), bflo(z1) * bflo(u1), bfhi(z1) * bfhi(u1), bflo(z2) * bflo(u2), bfhi(z2) * bfhi(u2), bflo(z3) * bflo(u3), bfhi(z3) * bfhi(u3)};
            float ss = 0.f;
#pragma unroll
            for (int k = 0; k < 8; ++k) ss += v[k] * v[k];
            const float rn = rsqrtf(wave_sum(ss) * (1.f / 512.f) + EPS);
            v4u o; o.x = pk2(v[0] * rn * ga.x, v[1] * rn * ga.y); o.y = pk2(v[2] * rn * ga.z, v[3] * rn * ga.w); o.z = pk2(v[4] * rn * gb.x, v[5] * rn * gb.y); o.w = pk2(v[6] * rn * gb.z, v[7] * rn * gb.w);
            *(v4u*)(MG + (rowbase + i) * 1024 + 512 + lane * 8) = o;
        }
    }
    __syncthreads();
}

struct CombIn { v4u a, b, c; float l0, l1, l2; };
__device__ __forceinline__ CombIn combine_load(const Ptrs& p, size_t row, int lane) {
    const bf16* PO = (const bf16*)(p.ws + WS_PO); const float* LSE = (const float*)(p.ws + WS_LSE); const int h = lane >> 3;
    CombIn k; k.l0 = LSE[row * 8 + h]; k.l1 = LSE[(size_t)T * 8 + row * 8 + h]; k.l2 = LSE[(size_t)2 * T * 8 + row * 8 + h];
    k.a = *(const v4u*)(PO + row * 512 + lane * 8); k.b = *(const v4u*)(PO + (size_t)T * 512 + row * 512 + lane * 8); k.c = *(const v4u*)(PO + (size_t)2 * T * 512 + row * 512 + lane * 8); return k;
}
__device__ __forceinline__ void combine_row(const Ptrs& p, const CombIn& k, const f32x4 ga, const f32x4 gb, size_t row, int lane) {
    bf16* MG = (bf16*)(p.ws + WS_HN);
    const float l0 = k.l0, l1 = k.l1, l2 = k.l2; const v4u a = k.a, b = k.b, c = k.c;
    const float mx = fmaxf(l0, fmaxf(l1, l2));
    float w0 = __builtin_amdgcn_exp2f(l0 - mx), w1 = __builtin_amdgcn_exp2f(l1 - mx), w2 = __builtin_amdgcn_exp2f(l2 - mx);
    const float inv = 1.f / (w0 + w1 + w2); w0 *= inv; w1 *= inv; w2 *= inv;
    const unsigned a0 = a.x, a1 = a.y, a2 = a.z, a3 = a.w, b0 = b.x, b1 = b.y, b2 = b.z, b3 = b.w, c0 = c.x, c1 = c.y, c2 = c.z, c3 = c.w;
    float v[8];
    v[0] = w0 * bflo(a0) + w1 * bflo(b0) + w2 * bflo(c0); v[1] = w0 * bfhi(a0) + w1 * bfhi(b0) + w2 * bfhi(c0);
    v[2] = w0 * bflo(a1) + w1 * bflo(b1) + w2 * bflo(c1); v[3] = w0 * bfhi(a1) + w1 * bfhi(b1) + w2 * bfhi(c1);
    v[4] = w0 * bflo(a2) + w1 * bflo(b2) + w2 * bflo(c2); v[5] = w0 * bfhi(a2) + w1 * bfhi(b2) + w2 * bfhi(c2);
    v[6] = w0 * bflo(a3) + w1 * bflo(b3) + w2 * bflo(c3); v[7] = w0 * bfhi(a3) + w1 * bfhi(b3) + w2 * bfhi(c3);
    float ss = 0.f;
#pragma unroll
    for (int q = 0; q < 8; ++q) ss += v[q] * v[q];
    const float rn = rsqrtf(wave_sum(ss) * (1.f / 512.f) + EPS);
    v4u o; o.x = pk2(v[0] * rn * ga.x, v[1] * rn * ga.y); o.y = pk2(v[2] * rn * ga.z, v[3] * rn * ga.w); o.z = pk2(v[4] * rn * gb.x, v[5] * rn * gb.y); o.w = pk2(v[6] * rn * gb.z, v[7] * rn * gb.w);
    *(v4u*)(MG + row * 1024 + lane * 8) = o;
}
__device__ __forceinline__ void combine_phase(const Ptrs& p, int gw, int NGW, int lane) {
    if (gw >= T) return;
    const f32x4 ga = *(const f32x4*)(p.ao_g + lane * 8), gb = *(const f32x4*)(p.ao_g + lane * 8 + 4);
    CombIn nx = combine_load(p, (size_t)gw, lane);
    for (int m = gw; m < T; m += NGW) {
        const CombIn cur = nx;
        nx = combine_load(p, (size_t)((m + NGW < T) ? m + NGW : m), lane);
        combine_row(p, cur, ga, gb, (size_t)m, lane);
    }
}

__device__ __forceinline__ void wqk_rowmax(const Ptrs& p, int gw, int NGW, int lane) {
    const bf16* WQK = (const bf16*)(p.ws + WS_WQK); float* RMAX = (float*)(p.ws + WS_CSC);
    for (int r = gw; r < 2048; r += NGW) {
        const v4u a = *(const v4u*)(WQK + (size_t)r * 1024 + lane * 16), b = *(const v4u*)(WQK + (size_t)r * 1024 + lane * 16 + 8);
        const unsigned w0 = a.x, w1 = a.y, w2 = a.z, w3 = a.w, w4 = b.x, w5 = b.y, w6 = b.z, w7 = b.w;
        float m = fmaxf(fmaxf(fmaxf(fabsf(bflo(w0)), fabsf(bfhi(w0))), fmaxf(fabsf(bflo(w1)), fabsf(bfhi(w1)))), fmaxf(fmaxf(fabsf(bflo(w2)), fabsf(bfhi(w2))), fmaxf(fabsf(bflo(w3)), fabsf(bfhi(w3)))));
        m = fmaxf(m, fmaxf(fmaxf(fmaxf(fabsf(bflo(w4)), fabsf(bfhi(w4))), fmaxf(fabsf(bflo(w5)), fabsf(bfhi(w5)))), fmaxf(fmaxf(fabsf(bflo(w6)), fabsf(bfhi(w6))), fmaxf(fabsf(bflo(w7)), fabsf(bfhi(w7))))));
        m = wave_max(m);
        if (lane == 0) RMAX[r] = m;
    }
}
__device__ __forceinline__ void wqk_to_fp8(const Ptrs& p, int gw, int NGW, int lane) {
    const bf16* WQK = (const bf16*)(p.ws + WS_WQK); unsigned char* W8 = p.ws + WS_WQK8; const float* RMAX = (const float*)(p.ws + WS_CSC);
    if (gw >= 2048) return;
    float m = 0.f;
#pragma unroll
    for (int q = 0; q < 8; ++q) { const f32x4 v = *(const f32x4*)(RMAX + q * 256 + lane * 4); m = fmaxf(m, fmaxf(fmaxf(v[0], v[1]), fmaxf(v[2], v[3]))); }
    m = wave_max(m);
    const int ex = (int)((__float_as_uint(m) >> 23) & 0xffu);
    const bool ok = ex > 16 && ex < 250;
    const float S = ok ? __uint_as_float((unsigned)(127 + 7 + 127 - ex) << 23) : 1.f, Si = ok ? __uint_as_float((unsigned)(ex - 7 - 3) << 23) : 0.125f;
    if (gw == 0 && lane == 0) ((float*)(p.ws + WS_CSC))[2048] = Si;
    for (int r = gw; r < 2048; r += NGW) {
        const v4u a = *(const v4u*)(WQK + (size_t)r * 1024 + lane * 16), b = *(const v4u*)(WQK + (size_t)r * 1024 + lane * 16 + 8);
        const unsigned w0 = a.x, w1 = a.y, w2 = a.z, w3 = a.w, w4 = b.x, w5 = b.y, w6 = b.z, w7 = b.w;
        const float v[16] = {bflo(w0), bfhi(w0), bflo(w1), bfhi(w1), bflo(w2), bfhi(w2), bflo(w3), bfhi(w3), bflo(w4), bfhi(w4), bflo(w5), bfhi(w5), bflo(w6), bfhi(w6), bflo(w7), bfhi(w7)};
        unsigned wd[4];
#pragma unroll
        for (int q = 0; q < 4; ++q) { int pk = 0; pk = __builtin_amdgcn_cvt_pk_fp8_f32(v[4 * q] * S, v[4 * q + 1] * S, pk, false); pk = __builtin_amdgcn_cvt_pk_fp8_f32(v[4 * q + 2] * S, v[4 * q + 3] * S, pk, true); wd[q] = (unsigned)pk; }
        *(v4u*)(W8 + (size_t)r * 1024 + lane * 16) = (v4u){wd[0], wd[1], wd[2], wd[3]};
    }
}

__device__ __forceinline__ void ins16(float (&l)[16], float x) {
#pragma unroll
    for (int i = 15; i >= 1; --i) l[i] = __builtin_amdgcn_fmed3f(l[i - 1], l[i], x);
    l[0] = fmaxf(l[0], x);
}
#define DPP_F(v, ctrl) __builtin_bit_cast(float, __builtin_amdgcn_update_dpp(0, __builtin_bit_cast(int, (v)), (ctrl), 0xF, 0xF, true))
__device__ __forceinline__ void topk_ld16(float (&d)[16], const f32x4* q) { const f32x4 a = q[0], b = q[1], c = q[2], e = q[3];
    d[0] = a[0]; d[1] = a[1]; d[2] = a[2]; d[3] = a[3]; d[4] = b[0]; d[5] = b[1]; d[6] = b[2]; d[7] = b[3]; d[8] = c[0]; d[9] = c[1]; d[10] = c[2]; d[11] = c[3]; d[12] = e[0]; d[13] = e[1]; d[14] = e[2]; d[15] = e[3]; }
__device__ __forceinline__ void topk_phase(const Ptrs& p, LAS unsigned char* lds, int vcu, int G, int tid) {
    const float* TOPW = (const float*)(p.ws + WS_SC); const float* PART = (const float*)(p.ws + WS_PART);
    unsigned short* IDX = (unsigned short*)(p.ws + WS_IDX); unsigned short* GATE = (unsigned short*)(p.ws + WS_GATE);
    LAS unsigned* L = (LAS unsigned*)lds + tid * 32;
    const int NU = T / 64, tk = tid >> 3, hd = tid & 7;
    for (int unit = vcu; unit < NU; unit += G) {
        const size_t t = (size_t)unit * 64 + tk;
        float ss;
        { const f32x4* pp = (const f32x4*)(PART + t * 16); const f32x4 a = pp[0], b = pp[1], c = pp[2], d = pp[3];
          ss = ((a[0] + a[1]) + (a[2] + a[3])) + ((b[0] + b[1]) + (b[2] + b[3])) + ((c[0] + c[1]) + (c[2] + c[3])) + ((d[0] + d[1]) + (d[2] + d[3])); }
        const float rn = rsqrtf(ss * (1.f / D) + EPS);
        if (hd == 0) ((float*)(p.ws + WS_RN))[t] = rn;
        const f32x4* tp = (const f32x4*)(TOPW + ((t * 8 + hd) * 4) * 16);
        float la[16], lb[16], lo_[16];
        topk_ld16(la, tp); topk_ld16(lo_, tp + 4); MERGE16_REG(la, lo_);
        topk_ld16(lb, tp + 8); topk_ld16(lo_, tp + 12); MERGE16_REG(lb, lo_);
#pragma unroll
        for (int i = 0; i < 16; ++i) { L[i] = __float_as_uint(la[i]); L[16 + i] = __float_as_uint(lb[i]); }
        float fa[16], fb[16];
#pragma unroll
        for (int i = 0; i < 16; ++i) { fa[i] = __uint_as_float(__float_as_uint(la[i]) & ~0x7fu); fb[i] = __uint_as_float(__float_as_uint(lb[i]) & ~0x7fu); }
        float l[16];
#pragma unroll
        for (int j = 0; j < 16; ++j) l[j] = __uint_as_float((__float_as_uint(fa[0] + fb[j]) & ~0xffu) | (unsigned)(255 - j));
#pragma unroll
        for (int i = 1; i < 16; ++i)
#pragma unroll
            for (int j = 0; j < 16; ++j) if ((i + 1) * (j + 1) <= 16) ins16(l, __uint_as_float((__float_as_uint(fa[i] + fb[j]) & ~0xffu) | (unsigned)(255 - (i * 16 + j))));
        const float rt = rn * 1.4426950408889634f * ((const float*)(p.ws + WS_CSC))[2048];
        float sv[16], den = 0.f; const float s0 = __uint_as_float(__float_as_uint(l[0]) & ~0xffu);
#pragma unroll
        for (int k = 0; k < 16; ++k) { sv[k] = __builtin_amdgcn_exp2f((__uint_as_float(__float_as_uint(l[k]) & ~0xffu) - s0) * rt); den += sv[k]; }
        const float inv = 1.f / den;
        unsigned ids[16];
#pragma unroll
        for (int k = 0; k < 16; ++k) { const unsigned code = 255u - (__float_as_uint(l[k]) & 0xffu); ids[k] = (L[code >> 4] & 0x7fu) * 128u + (L[16 + (code & 15u)] & 0x7fu); sv[k] *= inv; }
        v4u* ip = (v4u*)(IDX + t * 128 + hd * 16);
        ip[0] = (v4u){ids[0] | (ids[1] << 16), ids[2] | (ids[3] << 16), ids[4] | (ids[5] << 16), ids[6] | (ids[7] << 16)};
        ip[1] = (v4u){ids[8] | (ids[9] << 16), ids[10] | (ids[11] << 16), ids[12] | (ids[13] << 16), ids[14] | (ids[15] << 16)};
        v4u* gp = (v4u*)(GATE + t * 128 + hd * 16);
        gp[0] = (v4u){pk2(sv[0], sv[1]), pk2(sv[2], sv[3]), pk2(sv[4], sv[5]), pk2(sv[6], sv[7])}; gp[1] = (v4u){pk2(sv[8], sv[9]), pk2(sv[10], sv[11]), pk2(sv[12], sv[13]), pk2(sv[14], sv[15])};
    }
}

__device__ __forceinline__ float dot2bf(unsigned u, unsigned x, float acc) { return __builtin_amdgcn_fdot2_f32_bf16(__builtin_bit_cast(bf16x2_t, u), __builtin_bit_cast(bf16x2_t, x), acc, false); }
#define DPP_ADD(v, ctrl) ((v) + __builtin_bit_cast(float, __builtin_amdgcn_update_dpp(0, __builtin_bit_cast(int, (v)), (ctrl), 0xF, 0xF, true)))
__device__ __forceinline__ float red8(float v) {
    float a = v; a = DPP_ADD(a, 0xB1); a = DPP_ADD(a, 0x4E); a = DPP_ADD(a, 0x141); return a;
}
constexpr int PB_ROW = 144, PB_WAVE = 128 * PB_ROW;
typedef int v8i __attribute__((ext_vector_type(8)));
struct TokI { v4u ia, ib; };
struct TokX { v4u xa, xb; };
__device__ __forceinline__ TokI peer_tokI(const unsigned short* IDX, int t, int lane) {
    TokI k; const unsigned short* ip = IDX + (size_t)t * 128 + (lane >> 3) * 16; k.ia = *(const v4u*)ip; k.ib = *(const v4u*)(ip + 8); return k;
}
__device__ __forceinline__ TokX peer_tokX(const unsigned char* XF8, int t, int s, int lane) {
    TokX k; const v4u z = {0u, 0u, 0u, 0u};
    if ((lane & 15) < 2) { const unsigned char* xp = XF8 + (size_t)t * 1024 + s * SLW + (lane & 15) * 128 + (lane >> 4) * 16; k.xa = *(const v4u*)xp; k.xb = *(const v4u*)(xp + 64); } else { k.xa = z; k.xb = z; }
    return k;
}
__device__ __forceinline__ void peer_gather(v4u (&u)[16], const v4u ia, const v4u ib, const unsigned char* base, unsigned coff) {
    const unsigned i0 = ia.x, i1 = ia.y, i2 = ia.z, i3 = ia.w, i4 = ib.x, i5 = ib.y, i6 = ib.z, i7 = ib.w;
#define PG_LD(j, w) u[2 * (j)] = *(const v4u*)(base + (((w) & 0xffffu) * 128u + coff)); u[2 * (j) + 1] = *(const v4u*)(base + (((w) >> 16) * 128u + coff))
    PG_LD(0, i0); PG_LD(1, i1); PG_LD(2, i2); PG_LD(3, i3); PG_LD(4, i4); PG_LD(5, i5); PG_LD(6, i6); PG_LD(7, i7);
#undef PG_LD
}
struct DotRes { float v0[16], v1[16]; };
__device__ __forceinline__ void peer_dot_store(const DotRes& r, unsigned short* dst, int lane) {
    if ((lane & 15) == 0) {
        v4u* o = (v4u*)(dst + (lane >> 4) * 32);
#pragma unroll
        for (int q = 0; q < 2; ++q) { o[q] = (v4u){pk2(r.v0[8 * q], r.v0[8 * q + 1]), pk2(r.v0[8 * q + 2], r.v0[8 * q + 3]), pk2(r.v0[8 * q + 4], r.v0[8 * q + 5]), pk2(r.v0[8 * q + 6], r.v0[8 * q + 7])};
            o[2 + q] = (v4u){pk2(r.v1[8 * q], r.v1[8 * q + 1]), pk2(r.v1[8 * q + 2], r.v1[8 * q + 3]), pk2(r.v1[8 * q + 4], r.v1[8 * q + 5]), pk2(r.v1[8 * q + 6], r.v1[8 * q + 7])}; } }
}
__device__ __forceinline__ void peer_tile_write(const v4u (&u)[16], LAS unsigned char* tb, int lane) {
    const int g = lane >> 3, c = lane & 7;
#pragma unroll
    for (int i = 0; i < 16; ++i) *(LAS v4u*)(tb + (8 * i + g) * PB_ROW + 16 * c) = u[i];
    asm volatile("s_waitcnt lgkmcnt(0)" ::: "memory");
}
__device__ __forceinline__ void peer_mfma(DotRes& r, const v4u xa, const v4u xb, LAS unsigned char* tb, int lane) {
    const v8i bop = {(int)xa.x, (int)xa.y, (int)xa.z, (int)xa.w, (int)xb.x, (int)xb.y, (int)xb.z, (int)xb.w};
    const LAS unsigned char* ra = tb + ((lane & 15) >> 1) * PB_ROW + (lane & 1) * 64 + (lane >> 4) * 16;
#pragma unroll
    for (int i = 0; i < 16; ++i) { const v4u w = *(const LAS v4u*)(ra + i * 8 * PB_ROW); const v8i aop = {(int)w.x, (int)w.y, (int)w.z, (int)w.w, 0, 0, 0, 0};
        const f32x4 z = {0.f, 0.f, 0.f, 0.f};
        const f32x4 a = __builtin_amdgcn_mfma_scale_f32_16x16x128_f8f6f4(aop, bop, z, 4  , 0  , 0, 0, 0, 0);
        const float a0 = a[0], a1 = a[1], a2 = a[2], a3 = a[3];
        r.v0[i] = a0 + DPP_F(a1, 0xB1); r.v1[i] = a2 + DPP_F(a3, 0xB1); }
    asm volatile("s_waitcnt lgkmcnt(0)" ::: "memory");
}
__device__ __forceinline__ void peer_dots(const Ptrs& p, LAS unsigned char* lds, int bx, int G, int wave, int lane) {
    const unsigned char* XF8 = p.ws + WS_XF8; const unsigned short* IDX = (const unsigned short*)(p.ws + WS_IDX);
    unsigned short* PACT = (unsigned short*)(p.ws + WS_PACT);
    const int s = (bx & 7) >> 1, wx = ((bx >> 3) * NWAVES + wave) * 2 + (bx & 1), NWX = (G >> 3) * NWAVES * 2;
    const int NT = (T - wx + NWX - 1) / NWX;
    const unsigned char* eus = p.ws + WS_EU + (size_t)s * NEXP * 128; const unsigned coff = (lane & 7) * 16; unsigned short* pact = PACT + (size_t)s * T * 128;
    LAS unsigned char* tb = lds + wave * PB_WAVE;
#define TOK(n) (wx + ((n) < NT ? (n) : NT - 1) * NWX)
    v4u u[16];
    DotRes pend;
    TokI iN = peer_tokI(IDX, TOK(0), lane);
    peer_gather(u, iN.ia, iN.ib, eus, coff);
    TokX xC = peer_tokX(XF8, TOK(0), s, lane);
    iN = peer_tokI(IDX, TOK(1), lane);
    for (int n = 0; n < NT; ++n) {
        peer_tile_write(u, tb, lane);
        peer_gather(u, iN.ia, iN.ib, eus, coff);
        const TokX xN = peer_tokX(XF8, TOK(n + 1), s, lane);
        iN = peer_tokI(IDX, TOK(n + 2), lane);
        if (n > 0) peer_dot_store(pend, pact + (size_t)TOK(n - 1) * 128, lane);
        peer_mfma(pend, xC.xa, xC.xb, tb, lane);
        xC = xN;
    }
    if (NT > 0) peer_dot_store(pend, pact + (size_t)TOK(NT - 1) * 128, lane);
#undef TOK
}
struct CoefIn { float pa[NSLICE], pb[NSLICE], g0, g1, rn; int e0, e1; };
struct CoefSc { float su0, su1, sv0, sv1; };
__device__ __forceinline__ CoefIn coef_load(const Ptrs& p, int t, int lane) {
    const unsigned short* PACT = (const unsigned short*)(p.ws + WS_PACT); const unsigned short* GATE = (const unsigned short*)(p.ws + WS_GATE); const unsigned short* IDX = (const unsigned short*)(p.ws + WS_IDX);
    CoefIn k;
#pragma unroll
    for (int s = 0; s < NSLICE; ++s) { k.pa[s] = __uint_as_float((unsigned)PACT[((size_t)s * T + t) * 128 + lane] << 16); k.pb[s] = __uint_as_float((unsigned)PACT[((size_t)s * T + t) * 128 + 64 + lane] << 16); }
    k.g0 = __uint_as_float((unsigned)GATE[(size_t)t * 128 + lane] << 16); k.g1 = __uint_as_float((unsigned)GATE[(size_t)t * 128 + 64 + lane] << 16); k.e0 = IDX[(size_t)t * 128 + lane]; k.e1 = IDX[(size_t)t * 128 + 64 + lane]; k.rn = ((const float*)(p.ws + WS_RN))[t]; return k;
}
__device__ __forceinline__ CoefSc coef_scales(const Ptrs& p, const CoefIn& k) {
    const float* SU = (const float*)(p.ws + WS_SU); const float* SV = (const float*)(p.ws + WS_SV);
    CoefSc c; c.su0 = SU[k.e0]; c.su1 = SU[k.e1]; c.sv0 = SV[k.e0]; c.sv1 = SV[k.e1]; return c;
}
__device__ __forceinline__ void coef_finish(const CoefIn& k, const CoefSc& c, float& c0, float& c1, float& m) {
    float a0 = 0.f, a1 = 0.f;
#pragma unroll
    for (int s = 0; s < NSLICE; ++s) { a0 += k.pa[s]; a1 += k.pb[s]; }
    const float rt = 0.125f * k.rn;
    const pg8::f32x2 gl = pg8::gelu_pk((pg8::f32x2){a0 * rt * c.su0, a1 * rt * c.su1});
    c0 = k.g0 * gl.x * c.sv0; c1 = k.g1 * gl.y * c.sv1; m = fmaxf(fabsf(c0), fabsf(c1));
}
__device__ __forceinline__ void coef_store(unsigned char* COEF8, float* CS, int t, int lane, float c0, float c1, float m) {
    const int ex = (int)((__float_as_uint(m) >> 23) & 0xffu);
    const float S = (ex > 0 && ex < 200) ? __uint_as_float((unsigned)(127 + 7 + 127 - ex) << 23) : 1.f, Si = (ex > 0 && ex < 200) ? __uint_as_float((unsigned)(ex - 7) << 23) : 1.f;
    const int pk = __builtin_amdgcn_cvt_pk_fp8_f32(c0 * S, c1 * S, 0, false);
    COEF8[(size_t)t * 128 + lane] = (unsigned char)(pk & 0xff); COEF8[(size_t)t * 128 + 64 + lane] = (unsigned char)((pk >> 8) & 0xff);
    if (lane == 0) CS[t] = Si;
}
__device__ __forceinline__ void peer_coef(const Ptrs& p, int gw, int NGW, int lane) {
    unsigned char* COEF8 = p.ws + WS_COEF; float* CS = (float*)(p.ws + WS_CS);
    const int NTW = (T - gw + NGW - 1) / NGW;
    if (NTW <= 0) return;
#define CTOK(n_) (gw + (((n_) < NTW) ? (n_) : (NTW - 1)) * NGW)
    CoefIn ka = coef_load(p, CTOK(0), lane), kb = coef_load(p, CTOK(1), lane);
    for (int n = 0; n < NTW; n += 2) {
        const CoefSc ca = coef_scales(p, ka), cb = coef_scales(p, kb);
        const CoefIn na = coef_load(p, CTOK(n + 2), lane), nb = coef_load(p, CTOK(n + 3), lane);
        float a0, a1, am, b0, b1, bm;
        coef_finish(ka, ca, a0, a1, am); coef_finish(kb, cb, b0, b1, bm);
#pragma unroll
        for (int o = 0; o < 1; ++o) { am = wave_max(am); bm = wave_max(bm); }
        coef_store(COEF8, CS, CTOK(n), lane, a0, a1, am);
        if (n + 1 < NTW) coef_store(COEF8, CS, CTOK(n + 1), lane, b0, b1, bm);
        ka = na; kb = nb;
    }
#undef CTOK
}
typedef int v2i __attribute__((ext_vector_type(2)));
struct TokB { v4u ia, ib, ca, cb; v2u xr; float cs; };
__device__ __forceinline__ TokB peer_tokB(const unsigned short* IDX, const unsigned char* COEF8, const float* CS, const bf16* xb, int t, int lane) {
    TokB k; const int g = lane >> 3; k.ia = *(const v4u*)(IDX + (size_t)t * 128 + 16 * g); k.ib = *(const v4u*)(IDX + (size_t)t * 128 + 16 * g + 8);
    const v4u z = {0u, 0u, 0u, 0u};
    if ((lane & 15) == 0) { const unsigned char* cp = COEF8 + (size_t)t * 128 + (lane >> 4) * 16; k.ca = *(const v4u*)cp; k.cb = *(const v4u*)(cp + 64); } else { k.ca = z; k.cb = z; }
    k.cs = CS[t]; k.xr = *(const v2u*)(xb + (size_t)t * 1024 + 4 * lane); return k;
}
__device__ __forceinline__ float pack_rows(float a, float b, float c, float d) {
    const v2u s1 = __builtin_amdgcn_permlane32_swap(__float_as_uint(a), __float_as_uint(c), false, false); const unsigned ac = s1.x;
    const v2u s2 = __builtin_amdgcn_permlane32_swap(__float_as_uint(b), __float_as_uint(d), false, false); const unsigned bd = s2.x;
    const v2u s3 = __builtin_amdgcn_permlane16_swap(ac, bd, false, false); const unsigned r = s3.x;
    return __uint_as_float(r);
}
__device__ __forceinline__ void peer_axpy_mfma(const v4u (&v)[16], const TokB& k, LAS unsigned char* tb, float* o, int lane) {
    const int g = lane >> 3, c = lane & 7, n = lane & 15, kg = lane >> 4;
#pragma unroll
    for (int i = 0; i < 16; ++i) *(LAS v4u*)(tb + (16 * g + i) * PB_ROW + 16 * c) = v[i];
    asm volatile("s_waitcnt lgkmcnt(0)" ::: "memory");
    const v8i aop = {(int)k.ca.x, (int)k.ca.y, (int)k.ca.z, (int)k.ca.w, (int)k.cb.x, (int)k.cb.y, (int)k.cb.z, (int)k.cb.w};
    const LAS unsigned char* ra = tb + (32 * kg + n) * PB_ROW;
    float pk[4];
#pragma unroll
    for (int q = 0; q < 4; ++q) {
        float val[4];
#pragma unroll
        for (int r = 0; r < 4; ++r) { const int nt = 4 * q + r;
            const v2i lo = __builtin_amdgcn_ds_read_tr4_b64_v2i32((LAS v2i*)(ra + nt * 8)), hi = __builtin_amdgcn_ds_read_tr4_b64_v2i32((LAS v2i*)(ra + 16 * PB_ROW + nt * 8));
            const v8i bop = {lo.x, lo.y, hi.x, hi.y, 0, 0, 0, 0};
            const f32x4 z = {0.f, 0.f, 0.f, 0.f};
            const f32x4 d = __builtin_amdgcn_mfma_scale_f32_16x16x128_f8f6f4(aop, bop, z, 0  , 4  , 0, 0, 0, 0);
            val[r] = d[0]; }
        pk[q] = pack_rows(val[0], val[1], val[2], val[3]);
    }
    asm volatile("s_waitcnt lgkmcnt(0)" ::: "memory");
    const unsigned r0 = k.xr.x, r1 = k.xr.y; const float cs = k.cs;
    *(f32x4*)(o + 4 * lane) = (f32x4){bflo(r0) + pk[0] * cs, bfhi(r0) + pk[1] * cs, bflo(r1) + pk[2] * cs, bfhi(r1) + pk[3] * cs};
}
__device__ __forceinline__ void peer_axpy(const Ptrs& p, LAS unsigned char* lds, int bx, int G, int wave, int lane) {
    const unsigned short* IDX = (const unsigned short*)(p.ws + WS_IDX); const unsigned char* COEF8 = p.ws + WS_COEF; const float* CS = (const float*)(p.ws + WS_CS);
    const int s = (bx & 7) >> 1, wx = ((bx >> 3) * NWAVES + wave) * 2 + (bx & 1), NWX = (G >> 3) * NWAVES * 2, c = lane & 7;
    const int NT = (T - wx + NWX - 1) / NWX;
    const unsigned char* evs = p.ws + WS_EV + (size_t)s * NEXP * 128; const unsigned coff = c * 16; float* ob = p.out + s * SLW; const bf16* xb = (const bf16*)(p.ws + WS_X1B) + s * SLW;
    LAS unsigned char* tb = lds + wave * PB_WAVE;
#define TOK(n) (wx + ((n) < NT ? (n) : NT - 1) * NWX)
    v4u va[16], vb[16];
    TokB kA = peer_tokB(IDX, COEF8, CS, xb, TOK(0), lane);
    peer_gather(va, kA.ia, kA.ib, evs, coff);
    TokB kB = peer_tokB(IDX, COEF8, CS, xb, TOK(1), lane);
    for (int n = 0; n < NT; n += 2) {
        peer_gather(vb, kB.ia, kB.ib, evs, coff);
        TokB kC = peer_tokB(IDX, COEF8, CS, xb, TOK(n + 2), lane);
        peer_axpy_mfma(va, kA, tb, ob + (size_t)TOK(n) * 1024, lane);
        peer_gather(va, kC.ia, kC.ib, evs, coff);
        kA = peer_tokB(IDX, COEF8, CS, xb, TOK(n + 3), lane);
        if (n + 1 < NT) peer_axpy_mfma(vb, kB, tb, ob + (size_t)TOK(n + 1) * 1024, lane);
        kB = kA; kA = kC;
    }
#undef TOK
}

#define XB_TMO      128
#define XB_XCNT(j)  (256  + 64 * (j))
#define XB_XSUB(j)  (1280 + 64 * (j))
#define XB_XGEN(j)  (2304 + 64 * (j))
#define XB_TOP      3328
#define XB_TOPGEN   3392
#define XCD_BAR_WORDS 3456
#define XB_SPIN_CAP (1u << 18)

__device__ __forceinline__ unsigned xb_ld(unsigned* p)              { return __hip_atomic_load(p, __ATOMIC_RELAXED, __HIP_MEMORY_SCOPE_AGENT); }
__device__ __forceinline__ unsigned xb_add(unsigned* p, unsigned v) { return __hip_atomic_fetch_add(p, v, __ATOMIC_RELAXED, __HIP_MEMORY_SCOPE_AGENT); }
__device__ __forceinline__ unsigned xb_xcc_id() { return (unsigned)__builtin_amdgcn_s_getreg((3 << 11) | 20) & 0xFu; }
#define XB_SPIN(cond, bar) do { unsigned _sp = 0; while (cond) { __builtin_amdgcn_s_sleep(1); \
    if ((++_sp & 255u) == 0u) { if (xb_ld(&(bar)[XB_TMO])) break; if (_sp > XB_SPIN_CAP) { atomicAdd(&(bar)[XB_TMO], 1u); break; } } } } while (0)

struct XcdBarrier {
    unsigned* bar; unsigned x;
    volatile LAS unsigned* st;
};

__device__ __forceinline__ XcdBarrier xcd_barrier_post(unsigned* bar, volatile LAS unsigned* st) {
    XcdBarrier b; b.bar = bar; b.x = xb_xcc_id(); b.st = st;
    if (threadIdx.x == 0) (void)xb_add(&bar[XB_XCNT(b.x)], 1u);
    return b;
}
__device__ __forceinline__ void xcd_barrier_complete(unsigned* bar, unsigned x, unsigned& nloc, unsigned& nx) {
    const unsigned G = gridDim.x * gridDim.y * gridDim.z;
    unsigned sum, cnt, mine, sp = 0u;
    for (;;) {
        sum = 0u; cnt = 0u; mine = 0u;
#pragma unroll
        for (unsigned j = 0; j < 16; ++j) { const unsigned c = xb_ld(&bar[XB_XCNT(j)]); sum += c; cnt += (c > 0u) ? 1u : 0u; mine = (j == x) ? c : mine; }
        if (sum == G) break;
        __builtin_amdgcn_s_sleep(1);
        if ((++sp & 255u) == 0u) { if (xb_ld(&bar[XB_TMO])) break; if (sp > XB_SPIN_CAP) { atomicAdd(&bar[XB_TMO], 1u); break; } }
    }
    nloc = mine > 0u ? mine : 1u; nx = cnt > 0u ? cnt : 1u;
}

__device__ __forceinline__ void xcd_barrier(const XcdBarrier& b) {
    asm volatile("s_waitcnt vmcnt(0)" ::: "memory");
    __syncthreads();
    if (threadIdx.x == 0) {
        unsigned* bar = b.bar;
        __builtin_amdgcn_s_waitcnt(0);
        unsigned nloc = b.st[0], nx = b.st[1];
        if (nloc == 0u) { xcd_barrier_complete(bar, b.x, nloc, nx); b.st[0] = nloc; b.st[1] = nx; }
        const unsigned old = xb_add(&bar[XB_XSUB(b.x)], 1u);
        const unsigned gen = old / nloc;
        if (old + 1u == (gen + 1u) * nloc) {
            __builtin_amdgcn_fence(__ATOMIC_RELEASE, "agent");
            asm volatile("s_waitcnt vmcnt(0)" ::: "memory");
            const unsigned og = xb_add(&bar[XB_TOP], 1u);
            const unsigned tg = og / nx;
            if (og + 1u == (tg + 1u) * nx) xb_add(&bar[XB_TOPGEN], 1u);
            else XB_SPIN(xb_ld(&bar[XB_TOPGEN]) == tg, bar);
            __builtin_amdgcn_fence(__ATOMIC_ACQUIRE, "agent");
            xb_add(&bar[XB_XGEN(b.x)], 1u);
            asm volatile("s_waitcnt vmcnt(0)" ::: "memory");
        } else {
            XB_SPIN(xb_ld(&bar[XB_XGEN(b.x)]) == gen, bar);
            __builtin_amdgcn_fence(__ATOMIC_ACQUIRE, "agent");
            asm volatile("s_waitcnt vmcnt(0)" ::: "memory");
        }
    }
    __syncthreads();
}

constexpr int N_PHASES = 8;
#ifndef PROBE
#define PROBE 0
#endif
__global__ void __launch_bounds__(NTHR, 2) hymba_fwd(Args args) {
    extern __shared__ __attribute__((aligned(16))) unsigned char lds_raw[];
    LAS unsigned char* lds = (LAS unsigned char*)lds_raw;
    const Ptrs& p = args.p;
    const int tid = threadIdx.x, lane = tid & 63, wave = __builtin_amdgcn_readfirstlane(tid >> 6);
    const int G = gridDim.x, bx = blockIdx.x, vcu = (G % 8 == 0) ? (bx % 8) * (G / 8) + bx / 8 : bx;
    const int gw = vcu * NWAVES + wave, NGW = G * NWAVES;
    const int lo = args.ph_lo, hi = args.ph_hi;
    volatile LAS unsigned* MISC = (volatile LAS unsigned*)(lds + MISC_OFF);
    if (tid < 64) MISC[tid] = 0u;
    __syncthreads();
    XcdBarrier bar = xcd_barrier_post((unsigned*)(p.ws + WS_CTL) + CW_BAR, MISC + 8);
#define IN(k) (lo <= (k) && (k) < hi)
#define SEAM(k) do { if (IN(k) && IN((k) + 1)) xcd_barrier(bar); } while (0)
    if (IN(0)) p0_prologue(p, lds, tid, lane, wave, vcu, G);
    SEAM(0);
    if (IN(1)) {
        pg8::Gemm g{(const bf16*)(p.ws + WS_HN), (const bf16*)(p.ws + WS_WIN), T, INW, D}; pg8::StaticOrder S; S.init(T, INW, G, bx);
        EpiProj E{(bf16*)(p.ws + WS_Q), (bf16*)(p.ws + WS_K), (bf16*)(p.ws + WS_V), (bf16*)(p.ws + WS_GU), (bf16*)(p.ws + WS_GV), p.q_g, p.k_g};
        pg8::gemm_phase<EpiProj, pg8::StaticOrder, true, true>(lds, g, S, E);
    }
    SEAM(1);
    if (IN(2)) attn_phase(p, lds, vcu, G, lane, wave);
    SEAM(2);
    if (IN(3)) {
        for (int u = vcu; u < T / 128; u += G) gmlp_unit(p, lds, u, tid, lane, wave);
        combine_phase(p, gw, NGW, lane);
        wqk_rowmax(p, gw, NGW, lane);
    }
    SEAM(3);
    if (IN(4)) {
        wqk_to_fp8(p, gw, NGW, lane);
        pg8::Gemm g{(const bf16*)(p.ws + WS_HN), (const bf16*)(p.ws + WS_WOUT), T, D, D}; pg8::StaticOrder S; S.init(T, D, G, bx);
        EpiOut E{p.x, p.out, (bf16*)(p.ws + WS_X1B), (float*)(p.ws + WS_PART), p.ws + WS_XF8};
        pg8::gemm_phase<EpiOut, pg8::StaticOrder, true, true>(lds, g, S, E);
    }
    SEAM(4);
    if (IN(5)) {
        pg8::Gemm g{(const bf16*)(p.ws + WS_XF8), (const bf16*)(p.ws + WS_WQK8), T, 2048, D / 2}; pg8::StaticOrder S; S.init(T, 2048, G, bx);
        EpiTopk E{(float*)(p.ws + WS_SC)};
        pg8::gemm_phase<EpiTopk, pg8::StaticOrder, true, true, true>(lds, g, S, E);
    }
    SEAM(5);
    if (IN(6)) topk_phase(p, lds, vcu, G, tid);
    SEAM(6);
    if (IN(7)) {
        __syncthreads();
        peer_dots(p, lds, bx, G, wave, lane);
        if (args.probe == 1) peer_dots(p, lds, bx, G, wave, lane);
        xcd_barrier(bar);
        peer_coef(p, gw, NGW, lane);
        if (args.probe == 2) peer_coef(p, gw, NGW, lane);
        xcd_barrier(bar);
        if (args.probe == 3) { xcd_barrier(bar); xcd_barrier(bar); xcd_barrier(bar); xcd_barrier(bar); xcd_barrier(bar); xcd_barrier(bar); xcd_barrier(bar); xcd_barrier(bar); xcd_barrier(bar); xcd_barrier(bar); }
        __syncthreads();
        peer_axpy(p, lds, bx, G, wave, lane);
        if (args.probe == 5) peer_axpy(p, lds, bx, G, wave, lane);
    }
#undef IN
#undef SEAM
}

extern "C" void kernel_launch(void* const* d_in, const int* in_sizes, int n_in, void* d_out, int out_size, void* d_ws, size_t ws_size, hipStream_t stream) {
    static int grid = 0;
    if (grid == 0) {
        if (n_in != 17 || in_sizes[0] != T * D || out_size != T * D || ws_size < WS_END) { fprintf(stderr, "kernel_launch: unexpected shapes (n_in %d, in0 %d, out %d, ws %zu); nothing launched\n", n_in, n_in > 0 ? in_sizes[0] : -1, out_size, ws_size); grid = -1; return; }
        int dev = 0, cus = 0, per_cu = 0;
        if (hipGetDevice(&dev) != hipSuccess || hipDeviceGetAttribute(&cus, hipDeviceAttributeMultiprocessorCount, dev) != hipSuccess) { grid = -1; return; }
        if (hipFuncSetAttribute((const void*)hymba_fwd, hipFuncAttributeMaxDynamicSharedMemorySize, LDS_BYTES) != hipSuccess) { fprintf(stderr, "kernel_launch: hipFuncSetAttribute failed\n"); grid = -1; return; }
        if (hipOccupancyMaxActiveBlocksPerMultiprocessor(&per_cu, (const void*)hymba_fwd, NTHR, LDS_BYTES) != hipSuccess || per_cu < 1) fprintf(stderr, "kernel_launch: occupancy query reports %d\n", per_cu);
        (void)hipGetLastError();
        grid = cus;
    }
    if (grid < 0) return;
    Args a{};
    const float** pp = (const float**)&a.p;
    for (int i = 0; i < 17; ++i) pp[i] = (const float*)d_in[i];
    a.p.out = (float*)d_out; a.p.ws = (unsigned char*)d_ws;
    if (hipMemsetAsync((char*)d_ws + WS_CTL, 0, CTL_ZERO_BYTES, stream) != hipSuccess) { fprintf(stderr, "kernel_launch: hipMemsetAsync failed\n"); return; }
    a.ph_lo = 0; a.ph_hi = N_PHASES; a.probe = PROBE;
    hipLaunchKernelGGL(hymba_fwd, dim3(grid), dim3(NTHR), LDS_BYTES, stream, a);
}
```

```cpp
#include <hip/hip_runtime.h>
#include <cstdio>
#include <cstdint>
#include <cmath>
namespace pg8 {
#define PG8_LAS __attribute__((address_space(3)))
typedef unsigned short bf16_t;
typedef short bf16x8 __attribute__((ext_vector_type(8)));
typedef float f32x4 __attribute__((ext_vector_type(4)));
typedef unsigned u32x4 __attribute__((ext_vector_type(4)));
typedef int i32x4 __attribute__((ext_vector_type(4)));
typedef int i32x8 __attribute__((ext_vector_type(8)));
constexpr int BM = 256, BK = 64, HALF = 128, HTB = HALF * BK * 2  , STAGE_BYTES = 8 * HTB, NXCD = 8, WGM = 8;

__host__ __device__ __forceinline__ int lds_byte(int r, int c) { return (r >> 3) * 1024 + (r & 7) * 128 + ((((c >> 3) ^ (r >> 1)) & 7) * 16) + (c & 7) * 2; }
__host__ __device__ __forceinline__ void stage_rc(int b, int& R, int& C) { const int st = b / 1024, sb = b % 1024; R = st * 8 + sb / 128; C = ((((sb % 128) / 16) ^ (R >> 1)) & 7) * 8 + (sb % 16) / 2; }
__host__ __device__ __forceinline__ int perm32(int rho) { const int n = rho >> 4, i = rho & 15; return 8 * (i >> 2) + 4 * n + (i & 3); }

struct Unit { int pm, pn; };
struct Gemm { const bf16_t* A; const bf16_t* Bt; int M, N, K; };

struct StaticOrder {
    int nM, nN, nwg, G, c;
    __host__ __device__ void init(int M, int N, int G_, int c_) { nM = M / BM; nN = N / BM; nwg = nM * nN; G = G_; c = c_; }
    __host__ __device__ bool next(int i, Unit& u) const {
        const long L = (long)i * G + c; if (L >= nwg) return false;
        int wgid = (int)L; { const int q = nwg / NXCD, r = nwg % NXCD, xcd = wgid % NXCD, off = wgid / NXCD; wgid = (xcd < r ? xcd * (q + 1) : r * (q + 1) + (xcd - r) * q) + off; }
        const int nig = WGM * nN, gid = wgid / nig, fm = gid * WGM, gsz = (nM - fm) < WGM ? (nM - fm) : WGM;
        u.pm = fm + ((wgid % nig) % gsz); u.pn = (wgid % nig) / gsz; return true;
    }
    __device__ __forceinline__ void a_ready(const Unit&) const {}
    __device__ __forceinline__ void done(const Unit&) const {}
};

__device__ __forceinline__ unsigned cvt_pk_bf16(float lo, float hi) { unsigned r; asm volatile("v_cvt_pk_bf16_f32 %0, %1, %2" : "=v"(r) : "v"(lo), "v"(hi)); return r; }
typedef float f32x2 __attribute__((ext_vector_type(2)));
__device__ __forceinline__ f32x2 gelu_pk(f32x2 v) {
    const f32x2 av = __builtin_elementwise_abs(v), d = av * 0.2316418882f + 1.0f;
    f32x2 t; t.x = __builtin_amdgcn_rcpf(d.x); t.y = __builtin_amdgcn_rcpf(d.y);
    f32x2 q = t * 0.5307027145f + (-0.7265760135f); q = q * t + 0.7107068705f; q = q * t + (-0.142248368f); q = q * t + 0.127414796f; q = q * t;
    const f32x2 s = (v * v) * (-0.72134752044f);
    f32x2 e; e.x = __builtin_amdgcn_exp2f(s.x); e.y = __builtin_amdgcn_exp2f(s.y);
    const f32x2 t2 = av * (q * e);
    f32x2 o; o.x = fmaxf(v.x, 0.f) - t2.x; o.y = fmaxf(v.y, 0.f) - t2.y; return o;
}

template <class Epi, class Sched, bool ALIGN_EPI = false, bool SP2 = false, bool FP8 = false>
__device__ __forceinline__ void gemm_phase(PG8_LAS unsigned char* lds, const Gemm g, const Sched& S, const Epi& E) {
    const int tid = threadIdx.x, wid = __builtin_amdgcn_readfirstlane(tid >> 6), lane = tid & 63, wr = wid >> 2, wc = wid & 3, fr = lane & 15, fq = lane >> 4;
    const int K = g.K, nt = K / BK;
    unsigned voffA[2], voffB[2];
#pragma unroll
    for (int i = 0; i < 2; ++i) { int R, C; stage_rc(tid * 16 + i * 8192, R, C); const int Rb = Epi::PERM ? ((R & ~31) + perm32(R & 31)) : R;
        voffA[i] = (unsigned)(R * K + C) * 2u; voffB[i] = (unsigned)(Rb * K + C) * 2u; }
    const size_t kstep = (size_t)(BK * 2);
    const size_t hstep = (size_t)HALF * K * 2;
    const size_t tstep = 2 * hstep;
    const unsigned ldsw = (unsigned)wid * 1024u;
    const int aoff = lds_byte(wr * 64 + fr, fq * 8), boff = lds_byte(wc * 32 + fr, fq * 8);
    const int aofk[2] = {aoff, aoff ^ 64}, bofk[2] = {boff, boff ^ 64};
#define PG8_SA(b, h) (((b) * 2 + (h)) * HTB)
#define PG8_SB(b, h) ((4 + (b) * 2 + (h)) * HTB)
#define PG8_STAGE(bufoff, gbase, voff) do { _Pragma("unroll") for (int _i = 0; _i < 2; ++_i) \
        __builtin_amdgcn_global_load_lds((const unsigned*)((const char*)(gbase) + (voff)[_i]), (PG8_LAS unsigned*)(lds + (bufoff) + ldsw + _i * 8192), 16, 0, 0); } while (0)
#define PG8_LD8(p0_, p1_) __builtin_shufflevector(*(const PG8_LAS i32x4*)(p0_), *(const PG8_LAS i32x4*)(p1_), 0, 1, 2, 3, 4, 5, 6, 7)
#define PG8_LDA(dst, b, h) do { if constexpr (FP8) { _Pragma("unroll") for (int m = 0; m < 4; ++m) dst##8[m] = PG8_LD8(lds + PG8_SA(b, h) + aofk[0] + m * 2048, lds + PG8_SA(b, h) + aofk[1] + m * 2048); } \
        else { _Pragma("unroll") for (int m = 0; m < 4; ++m) _Pragma("unroll") for (int k = 0; k < 2; ++k) dst[m][k] = *(const PG8_LAS bf16x8*)(lds + PG8_SA(b, h) + aofk[k] + m * 2048); } } while (0)
#define PG8_LDB(dst, b, h) do { if constexpr (FP8) { _Pragma("unroll") for (int n = 0; n < 2; ++n) dst##8[n] = PG8_LD8(lds + PG8_SB(b, h) + bofk[0] + n * 2048, lds + PG8_SB(b, h) + bofk[1] + n * 2048); } \
        else { _Pragma("unroll") for (int n = 0; n < 2; ++n) _Pragma("unroll") for (int k = 0; k < 2; ++k) dst[n][k] = *(const PG8_LAS bf16x8*)(lds + PG8_SB(b, h) + bofk[k] + n * 2048); } } while (0)
#define PG8_MMA(ai, bj, At, Bt) do { __builtin_amdgcn_s_setprio(1); \
        if constexpr (FP8) { _Pragma("unroll") for (int m = 0; m < 4; ++m) _Pragma("unroll") for (int n = 0; n < 2; ++n) \
            asm volatile("v_mfma_f32_16x16x128_f8f6f4 %0, %1, %2, %0" : "+v"(acc[ai][bj][m][n]) : "v"(Bt##8[n]), "v"(At##8[m])); }   \
        else { _Pragma("unroll") for (int m = 0; m < 4; ++m) _Pragma("unroll") for (int n = 0; n < 2; ++n) _Pragma("unroll") for (int k = 0; k < 2; ++k) \
            acc[ai][bj][m][n] = __builtin_amdgcn_mfma_f32_16x16x32_bf16(Bt[n][k], At[m][k], acc[ai][bj][m][n], 0, 0, 0); } \
        __builtin_amdgcn_s_setprio(0); } while (0)
#define PG8_WAIT_V(n) asm volatile("s_waitcnt vmcnt(" #n ")" ::: "memory")
#define PG8_WAIT_L(n) asm volatile("s_waitcnt lgkmcnt(" #n ")" ::: "memory")
#define PG8_BAR __builtin_amdgcn_s_barrier()
#define PG8_SCHED __builtin_amdgcn_sched_barrier(0)
    Unit cur, nxt; int ui = 0;
    if (!S.next(0, cur)) return;
    f32x4 acc[2][2][4][2];
#pragma unroll
    for (int a = 0; a < 2; ++a)
#pragma unroll
        for (int b = 0; b < 2; ++b)
#pragma unroll
            for (int m = 0; m < 4; ++m)
#pragma unroll
                for (int n = 0; n < 2; ++n) acc[a][b][m][n] = (f32x4){0.f, 0.f, 0.f, 0.f};
    bf16x8 At[4][2], B0[2][2], B1[2][2];
    i32x8 At8[4], B08[2], B18[2];
    const char* cA = (const char*)g.A + (size_t)cur.pm * tstep; const char* cB = (const char*)g.Bt + (size_t)cur.pn * tstep;
    S.a_ready(cur);
    if constexpr (SP2) {
        PG8_STAGE(PG8_SB(0, 0), cB, voffB); PG8_STAGE(PG8_SB(0, 1), cB + hstep, voffB); PG8_STAGE(PG8_SA(0, 0), cA, voffA); PG8_STAGE(PG8_SA(0, 1), cA + hstep, voffA);
        if (wr == 1) PG8_BAR;
        PG8_WAIT_V(2); PG8_BAR;
        PG8_STAGE(PG8_SB(1, 0), cB + kstep, voffB); PG8_STAGE(PG8_SA(1, 0), cA + kstep, voffA); PG8_STAGE(PG8_SB(1, 1), cB + hstep + kstep, voffB);
        PG8_WAIT_V(6); PG8_BAR;
    } else {
        PG8_STAGE(PG8_SB(0, 0), cB, voffB); PG8_STAGE(PG8_SA(0, 0), cA, voffA); PG8_STAGE(PG8_SB(0, 1), cB + hstep, voffB); PG8_STAGE(PG8_SA(0, 1), cA + hstep, voffA);
        if (wr == 1) PG8_BAR;
        PG8_WAIT_V(4); PG8_BAR;
        PG8_STAGE(PG8_SB(1, 0), cB + kstep, voffB); PG8_STAGE(PG8_SA(1, 0), cA + kstep, voffA); PG8_STAGE(PG8_SB(1, 1), cB + hstep + kstep, voffB);
        PG8_WAIT_V(6); PG8_BAR;
    }
    for (;;) {
        const bool has_next = S.next(ui + 1, nxt);
        const char* nA = has_next ? (const char*)g.A + (size_t)nxt.pm * tstep : cA; const char* nB = has_next ? (const char*)g.Bt + (size_t)nxt.pn * tstep : cB;
        for (int t = 0; t < nt; t += 2) {
            const bool last = (t == nt - 2);
            const char* a1 = cA + (size_t)(t + 1) * kstep;
            const char* a2 = last ? nA : cA + (size_t)(t + 2) * kstep; const char* b2 = last ? nB : cB + (size_t)(t + 2) * kstep;
            const char* a3 = a2 + kstep; const char* b3 = b2 + kstep;
            if (last && has_next) S.a_ready(nxt);
            if constexpr (SP2) {
            PG8_LDB(B0, 0, 0); PG8_LDB(B1, 0, 1); PG8_SCHED; PG8_LDA(At, 0, 0); PG8_STAGE(PG8_SA(1, 1), a1 + hstep, voffA);
            PG8_WAIT_V(8); PG8_WAIT_L(0); PG8_BAR; PG8_MMA(0, 0, At, B0); PG8_MMA(0, 1, At, B1); PG8_BAR; PG8_SCHED;
            PG8_LDA(At, 0, 1); PG8_STAGE(PG8_SB(0, 0), b2, voffB); PG8_STAGE(PG8_SB(0, 1), b2 + hstep, voffB); PG8_STAGE(PG8_SA(0, 0), a2, voffA);
            PG8_WAIT_V(8); PG8_WAIT_L(0); PG8_BAR; PG8_MMA(1, 0, At, B0); PG8_MMA(1, 1, At, B1); PG8_BAR; PG8_SCHED;
            PG8_LDB(B0, 1, 0); PG8_LDB(B1, 1, 1); PG8_SCHED; PG8_LDA(At, 1, 0); PG8_STAGE(PG8_SA(0, 1), a2 + hstep, voffA);
            PG8_WAIT_V(8); PG8_WAIT_L(0); PG8_BAR; PG8_MMA(0, 0, At, B0); PG8_MMA(0, 1, At, B1); PG8_BAR; PG8_SCHED;
            PG8_LDA(At, 1, 1); PG8_STAGE(PG8_SB(1, 0), b3, voffB); PG8_STAGE(PG8_SB(1, 1), b3 + hstep, voffB); PG8_STAGE(PG8_SA(1, 0), a3, voffA);
            PG8_WAIT_V(8); PG8_WAIT_L(0); PG8_BAR; PG8_MMA(1, 0, At, B0); PG8_MMA(1, 1, At, B1); PG8_BAR; PG8_SCHED;
            } else {
            PG8_LDB(B0, 0, 0); PG8_SCHED; PG8_LDA(At, 0, 0); PG8_STAGE(PG8_SA(1, 1), a1 + hstep, voffA);
            PG8_WAIT_L(8); PG8_BAR; PG8_WAIT_L(0); PG8_MMA(0, 0, At, B0); PG8_BAR; PG8_SCHED;
            PG8_LDB(B1, 0, 1); PG8_STAGE(PG8_SB(0, 0), b2, voffB);
            PG8_BAR; PG8_WAIT_L(0); PG8_MMA(0, 1, At, B1); PG8_BAR;
            PG8_LDA(At, 0, 1); PG8_STAGE(PG8_SA(0, 0), a2, voffA);
            PG8_BAR; PG8_WAIT_L(0); PG8_MMA(1, 0, At, B0); PG8_BAR; PG8_SCHED;
            PG8_STAGE(PG8_SB(0, 1), b2 + hstep, voffB);
            PG8_WAIT_V(6); PG8_BAR; PG8_MMA(1, 1, At, B1); PG8_BAR;
            PG8_LDB(B0, 1, 0); PG8_SCHED; PG8_LDA(At, 1, 0); PG8_STAGE(PG8_SA(0, 1), a2 + hstep, voffA);
            PG8_WAIT_L(8); PG8_BAR; PG8_WAIT_L(0); PG8_MMA(0, 0, At, B0); PG8_BAR; PG8_SCHED;
            PG8_LDB(B1, 1, 1); PG8_STAGE(PG8_SB(1, 0), b3, voffB);
            PG8_BAR; PG8_WAIT_L(0); PG8_MMA(0, 1, At, B1); PG8_BAR;
            PG8_LDA(At, 1, 1); PG8_STAGE(PG8_SA(1, 0), a3, voffA);
            PG8_BAR; PG8_WAIT_L(0); PG8_MMA(1, 0, At, B0); PG8_BAR; PG8_SCHED;
            PG8_STAGE(PG8_SB(1, 1), b3 + hstep, voffB);
            PG8_WAIT_V(6); PG8_BAR; PG8_MMA(1, 1, At, B1); PG8_BAR;
            }
        }
        if constexpr (ALIGN_EPI) { if (wr == 0) PG8_BAR; }
        if constexpr (FP8) { asm volatile("s_nop 15\n\ts_nop 15" ::: "memory"); }
        if constexpr (!Epi::AFTER_DRAIN) { E(acc, cur, wr, wc, fr, fq); S.done(cur); }
        if (!has_next) break;
#pragma unroll
        for (int a = 0; a < 2; ++a)
#pragma unroll
            for (int b = 0; b < 2; ++b)
#pragma unroll
                for (int m = 0; m < 4; ++m)
#pragma unroll
                    for (int n = 0; n < 2; ++n) acc[a][b][m][n] = (f32x4){0.f, 0.f, 0.f, 0.f};
        cur = nxt; cA = nA; cB = nB; ++ui;
        if constexpr (ALIGN_EPI) { if (wr == 1) PG8_BAR; }
    }
    PG8_WAIT_V(0);
    if constexpr (!ALIGN_EPI) { if (wr == 0) PG8_BAR; }
    PG8_BAR;
    if constexpr (Epi::AFTER_DRAIN) { E.fused(acc, cur, wr, wc, fr, fq, lds, wid, lane); S.done(cur); }
#undef PG8_SA
#undef PG8_SB
#undef PG8_STAGE
#undef PG8_LD8
#undef PG8_LDA
#undef PG8_LDB
#undef PG8_MMA
#undef PG8_WAIT_V
#undef PG8_WAIT_L
#undef PG8_BAR
#undef PG8_SCHED
}
}

constexpr int BATCH = 16, SEQ = 4096, D = 1024, T = BATCH * SEQ;
constexpr int AW = 512, NH = 8, HD = 64, GWID = 512, INW = 2560;
constexpr int NKEYS = 128, NEXP = 16384, PH = 8, TOPK = 16, NSEL = PH * TOPK;
constexpr float EPS = 1e-6f;
constexpr float QSCALE = 0.125f * 1.4426950408889634f;
constexpr int NWAVES = 8, NTHR = 512;

constexpr size_t MiB = 1u << 20;
constexpr size_t WS_CTL = 0, CTL_ZERO_BYTES = 32 * 1024;
constexpr size_t WS_WIN = 2 * MiB;
constexpr size_t WS_WOUT = 8 * MiB;
constexpr size_t WS_WQK = 10 * MiB;
constexpr size_t WS_WSP = 14 * MiB;
constexpr size_t WS_PART = 15 * MiB;
constexpr size_t WS_EU = 20 * MiB;
constexpr size_t WS_EV = 52 * MiB;
constexpr size_t WS_SU = 36 * MiB, WS_SV = 37 * MiB;
constexpr size_t WS_HN = 84 * MiB;
constexpr size_t WS_X1B = 212 * MiB;
constexpr size_t WS_Q = 340 * MiB, WS_K = 404 * MiB, WS_V = 468 * MiB, WS_GU = 532 * MiB, WS_GV = 596 * MiB;
constexpr size_t WS_PO = 660 * MiB;
constexpr size_t WS_LSE = 852 * MiB;
constexpr size_t WS_SC = 340 * MiB;
constexpr size_t WS_IDX = 860 * MiB;
constexpr size_t WS_PACT = 340 * MiB;
constexpr size_t WS_COEF = 924 * MiB;
constexpr size_t WS_CS = 940 * MiB;
constexpr size_t WS_WQK8 = 1010 * MiB;
constexpr size_t WS_CSC = 1012 * MiB;
constexpr size_t WS_RN = 941 * MiB;
constexpr size_t WS_GATE = 892 * MiB;
constexpr size_t WS_XF8 = 944 * MiB;
constexpr size_t WS_END = 1013 * MiB;
constexpr int NSLICE = 4, SLW = D / NSLICE;
constexpr int CW_BAR = 4096;

constexpr int LDS_BYTES = 163840 - 2048;
constexpr int MISC_OFF = 160 * 1024 - 2048 - 256;

#define GAS __attribute__((address_space(1)))
#define LAS __attribute__((address_space(3)))
typedef unsigned short bf16;
typedef unsigned v4u __attribute__((ext_vector_type(4)));
typedef unsigned v2u __attribute__((ext_vector_type(2)));
typedef float f32x4 __attribute__((ext_vector_type(4)));
typedef float f32x16 __attribute__((ext_vector_type(16)));
typedef short bf16x8 __attribute__((ext_vector_type(8)));
typedef short s16x4 __attribute__((ext_vector_type(4)));
typedef short v4i16_t __attribute__((ext_vector_type(4)));
typedef __bf16 bf16x2_t __attribute__((ext_vector_type(2)));

typedef float f32x2_t __attribute__((ext_vector_type(2)));
__device__ __forceinline__ unsigned pk2(float lo, float hi) { const f32x2_t v = {lo, hi}; const bf16x2_t b = __builtin_convertvector(v, bf16x2_t); return __builtin_bit_cast(unsigned, b); }
__device__ __forceinline__ unsigned f2bf(float f) { return pk2(f, f) & 0xffffu; }
__device__ __forceinline__ float bflo(unsigned u) { return __uint_as_float(u << 16); }
__device__ __forceinline__ float bfhi(unsigned u) { return __uint_as_float(u & 0xffff0000u); }
#define DPPV(v, ctrl) __builtin_bit_cast(float, __builtin_amdgcn_update_dpp(0, __builtin_bit_cast(int, (v)), (ctrl), 0xF, 0xF, true))
__device__ __forceinline__ void swap16(float& a, float& b) { const v2u s = __builtin_amdgcn_permlane16_swap(__float_as_uint(a), __float_as_uint(b), false, false); const unsigned x = s.x, y = s.y; a = __uint_as_float(x); b = __uint_as_float(y); }
__device__ __forceinline__ void swap32(float& a, float& b) { const v2u s = __builtin_amdgcn_permlane32_swap(__float_as_uint(a), __float_as_uint(b), false, false); const unsigned x = s.x, y = s.y; a = __uint_as_float(x); b = __uint_as_float(y); }
__device__ __forceinline__ float sum_x16(float v) { float a = v, b = v; swap16(a, b); return a + b; }
__device__ __forceinline__ float sum_x32(float v) { float a = v, b = v; swap32(a, b); return a + b; }
__device__ __forceinline__ float max_x16(float v) { float a = v, b = v; swap16(a, b); return fmaxf(a, b); }
__device__ __forceinline__ float max_x32(float v) { float a = v, b = v; swap32(a, b); return fmaxf(a, b); }
__device__ __forceinline__ float row_sum16(float v) { float a = v; a += DPPV(a, 0xB1); a += DPPV(a, 0x4E); a += DPPV(a, 0x141); a += DPPV(a, 0x140); return a; }
__device__ __forceinline__ float row_max16(float v) { float a = v; a = fmaxf(a, DPPV(a, 0xB1)); a = fmaxf(a, DPPV(a, 0x4E)); a = fmaxf(a, DPPV(a, 0x141)); a = fmaxf(a, DPPV(a, 0x140)); return a; }
__device__ __forceinline__ float wave_sum(float v) { return sum_x32(sum_x16(row_sum16(v))); }
__device__ __forceinline__ float wave_max(float v) { return max_x32(max_x16(row_max16(v))); }
__device__ __forceinline__ int crow(int r, int hi) { return (r & 3) + 8 * (r >> 2) + 4 * hi; }
__device__ __forceinline__ float gelu_exact(float v) { return 0.5f * v * (1.0f + erff(v * 0.70710678118654752f)); }

__device__ __forceinline__ float vmaxf(float a, float b) { float r; asm("v_max_f32 %0, %1, %2" : "=v"(r) : "v"(a), "v"(b)); return r; }
__device__ __forceinline__ float vminf(float a, float b) { float r; asm("v_min_f32 %0, %1, %2" : "=v"(r) : "v"(a), "v"(b)); return r; }
#define CE16(l, a, b) { const float hi_ = vmaxf(l[a], l[b]), lo_ = vminf(l[a], l[b]); l[a] = hi_; l[b] = lo_; }
#define SORT16_DESC(l) do { CE16(l,0,1) CE16(l,2,3) CE16(l,0,2) CE16(l,1,3) CE16(l,1,2) CE16(l,4,5) CE16(l,6,7) CE16(l,4,6) CE16(l,5,7) CE16(l,5,6) CE16(l,0,4) CE16(l,2,6) CE16(l,2,4) CE16(l,1,5) CE16(l,3,7) CE16(l,3,5) CE16(l,1,2) CE16(l,3,4) CE16(l,5,6) CE16(l,8,9) CE16(l,10,11) CE16(l,8,10) CE16(l,9,11) CE16(l,9,10) CE16(l,12,13) CE16(l,14,15) CE16(l,12,14) CE16(l,13,15) CE16(l,13,14) CE16(l,8,12) CE16(l,10,14) CE16(l,10,12) CE16(l,9,13) CE16(l,11,15) CE16(l,11,13) CE16(l,9,10) CE16(l,11,12) CE16(l,13,14) CE16(l,0,8) CE16(l,4,12) CE16(l,4,8) CE16(l,2,10) CE16(l,6,14) CE16(l,6,10) CE16(l,2,4) CE16(l,6,8) CE16(l,10,12) CE16(l,1,9) CE16(l,5,13) CE16(l,5,9) CE16(l,3,11) CE16(l,7,15) CE16(l,7,11) CE16(l,3,5) CE16(l,7,9) CE16(l,11,13) CE16(l,1,2) CE16(l,3,4) CE16(l,5,6) CE16(l,7,8) CE16(l,9,10) CE16(l,11,12) CE16(l,13,14) } while (0)
#define BITONIC16_DESC(l) do { _Pragma("unroll") for (int d_ = 8; d_ >= 1; d_ >>= 1) _Pragma("unroll") for (int i_ = 0; i_ < 16; ++i_) if ((i_ & d_) == 0) { const float hi_ = vmaxf(l[i_], l[i_ + d_]), lo_ = vminf(l[i_], l[i_ + d_]); l[i_] = hi_; l[i_ + d_] = lo_; } } while (0)
#define MERGE16_REG(l, o) do { _Pragma("unroll") for (int i_ = 0; i_ < 16; ++i_) l[i_] = vmaxf(l[i_], o[15 - i_]); BITONIC16_DESC(l); } while (0)
#define MERGE16_XOR(l, mask) do { float o_[16]; _Pragma("unroll") for (int i_ = 0; i_ < 16; ++i_) o_[i_] = __shfl_xor(l[i_], (mask)); MERGE16_REG(l, o_); } while (0)

struct Ptrs {
    const float *x, *mix_g, *w_in, *q_g, *k_g, *vg_g, *w_sp, *b_sp, *ao_g, *go_g, *w_out, *ffn_g, *w_query, *keys_a, *keys_b, *exp_u, *exp_v;
    float* out; unsigned char* ws;
};
struct Args { Ptrs p; int ph_lo, ph_hi, probe, pad; };

__device__ __forceinline__ void p0_transpose_item(const float* W, int K, int N, bf16* WT, bool perm, LAS float* scr, int item, int lane) {
    const int nblk = N / 32, kb = item / nblk, nb = item % nblk, k0 = 64 * kb, n0 = 32 * nb;
    int pn0 = n0;
    if (perm) { const int tile = n0 >> 8, lb = (n0 & 255) >> 5; pn0 = (tile << 8) + 32 * (4 * (lb & 1) + (lb >> 1)); }
#pragma unroll 8
    for (int i = 0; i < 32; ++i) { const int kk = 2 * i + (lane >> 5); scr[kk * 33 + (lane & 31)] = W[(size_t)(k0 + kk) * N + n0 + (lane & 31)]; }
    asm volatile("s_waitcnt lgkmcnt(0)" ::: "memory");
    const int c = lane & 7;
#pragma unroll
    for (int j = 0; j < 4; ++j) { const int n = (lane >> 3) + 8 * j; const LAS float* s = scr + (8 * c) * 33 + n;
        v4u o; o.x = pk2(s[0 * 33], s[1 * 33]); o.y = pk2(s[2 * 33], s[3 * 33]); o.z = pk2(s[4 * 33], s[5 * 33]); o.w = pk2(s[6 * 33], s[7 * 33]);
        *(v4u*)(WT + (size_t)(pn0 + n) * K + k0 + 8 * c) = o; }
    asm volatile("s_waitcnt lgkmcnt(0)" ::: "memory");
}

__device__ __forceinline__ void p0_fold_item(const Ptrs& p, LAS unsigned char* lds, int it, int tid) {
    const int h = it >> 5, half = (it >> 4) & 1, d0 = (it & 15) * 64;
    LAS float* A = (LAS float*)lds;
    LAS float* Kt = (LAS float*)(lds + 64 * 132 * 4);
    const float* wq = p.w_query + h * 256 + half * 128;
    for (int i = tid; i < 8192; i += NTHR) { const int dd = i >> 7, c = i & 127; A[dd * 132 + c] = wq[(size_t)(d0 + dd) * 2048 + c]; }
    const float* keys = half ? p.keys_b : p.keys_a;
    for (int i = tid; i < 16384; i += NTHR) Kt[(i >> 7) * 132 + (i & 127)] = keys[i];
    __syncthreads();
    const int w = tid >> 6, lane = tid & 63, r32 = lane & 31, hi = lane >> 5, mt = w >> 1, nt = w & 1;
    const LAS float* ka = Kt + (32 * mt + r32) * 132 + 8 * hi; const LAS float* wb = A + (32 * nt + r32) * 132 + 8 * hi;
    f32x16 acc = {};
#pragma unroll
    for (int ks = 0; ks < 8; ++ks) {
        const f32x4 a0 = *(const LAS f32x4*)(ka + 16 * ks), a1 = *(const LAS f32x4*)(ka + 16 * ks + 4), b0 = *(const LAS f32x4*)(wb + 16 * ks), b1 = *(const LAS f32x4*)(wb + 16 * ks + 4);
        const bf16x8 af = __builtin_bit_cast(bf16x8, (v4u){pk2(a0[0], a0[1]), pk2(a0[2], a0[3]), pk2(a1[0], a1[1]), pk2(a1[2], a1[3])});
        const bf16x8 bfr = __builtin_bit_cast(bf16x8, (v4u){pk2(b0[0], b0[1]), pk2(b0[2], b0[3]), pk2(b1[0], b1[1]), pk2(b1[2], b1[3])});
        acc = __builtin_amdgcn_mfma_f32_32x32x16_bf16(af, bfr, acc, 0, 0, 0);
    }
    const float g = p.ffn_g[d0 + 32 * nt + r32];
    bf16* WQK = (bf16*)(p.ws + WS_WQK);
#pragma unroll
    for (int rr = 0; rr < 16; ++rr) { const int key = 32 * mt + crow(rr, hi), wcq = 2 * half + (key >> 6), kidx = key & 63;
        const int prow = 128 * (kidx >> 5) + 32 * wcq + 16 * ((kidx >> 4) & 1) + 4 * ((kidx >> 2) & 3) + (kidx & 3);
        WQK[(size_t)(h * 256 + prow) * 1024 + d0 + 32 * nt + r32] = (bf16)f2bf(acc[rr] * g); }
    __syncthreads();
}

__device__ __forceinline__ void p0_prologue(const Ptrs& p, LAS unsigned char* lds, int tid, int lane, int wave, int vcu, int G) {
    if (!(blockIdx.x & 1)) { for (int it = blockIdx.x; it < 256; it += G) p0_fold_item(p, lds, it, tid); }
    __syncthreads();
    const int gw = vcu * NWAVES + wave, NGW = G * NWAVES;
    LAS float* scr = (LAS float*)(lds + wave * 16384);
    constexpr int I_IN = (D / 64) * (INW / 32), I_OUT = (D / 64) * (D / 32);
    bf16* WIN = (bf16*)(p.ws + WS_WIN); bf16* WOUT = (bf16*)(p.ws + WS_WOUT);
    for (int it = gw; it < I_IN + I_OUT; it += NGW) {
        if (it < I_IN) p0_transpose_item(p.w_in, D, INW, WIN, true, scr, it, lane);
        else p0_transpose_item(p.w_out, D, D, WOUT, false, scr, it - I_IN, lane);
    }
    const int gt = gw * 64 + lane, NGT = NGW * 64;
    {
        unsigned char* EU4 = p.ws + WS_EU; unsigned char* EV4 = p.ws + WS_EV; float* SU = (float*)(p.ws + WS_SU); float* SV = (float*)(p.ws + WS_SV);
        f32x4 gf[4];
#pragma unroll
        for (int j = 0; j < 4; ++j) gf[j] = *(const f32x4*)(p.ffn_g + lane * 16 + 4 * j);
        f32x4 nv[4], nw[4];
        if (gw < 2 * NEXP) { const float* src0 = ((gw & 1) ? p.exp_v : p.exp_u) + (size_t)(gw >> 1) * D + lane * 16;
            const int r1 = (gw + NGW < 2 * NEXP) ? gw + NGW : gw; const float* src1 = ((r1 & 1) ? p.exp_v : p.exp_u) + (size_t)(r1 >> 1) * D + lane * 16;
#pragma unroll
            for (int j = 0; j < 4; ++j) { nv[j] = *(const f32x4*)(src0 + 4 * j); nw[j] = *(const f32x4*)(src1 + 4 * j); } }
        for (int r = gw; r < 2 * NEXP; r += NGW) {
            const int e = r >> 1, tb = r & 1;
            f32x4 v[4]; float ss = 0.f;
#pragma unroll
            for (int j = 0; j < 4; ++j) { v[j] = nv[j]; nv[j] = nw[j]; }
            { const int rn = (r + 2 * NGW < 2 * NEXP) ? r + 2 * NGW : r; const float* srcn = ((rn & 1) ? p.exp_v : p.exp_u) + (size_t)(rn >> 1) * D + lane * 16;
#pragma unroll
              for (int j = 0; j < 4; ++j) nw[j] = *(const f32x4*)(srcn + 4 * j); }
#pragma unroll
            for (int j = 0; j < 4; ++j) { if (!tb) v[j] = v[j] * gf[j];
                ss += (v[j][0] * v[j][0] + v[j][1] * v[j][1]) + (v[j][2] * v[j][2] + v[j][3] * v[j][3]); }
            ss = wave_sum(ss);
            const float sc = (ss > 0.f) ? 0.5f * sqrtf(ss * (1.f / D)) : 1.f, inv = 1.f / sc;
            unsigned wlo = 0u, whi = 0u;
#pragma unroll
            for (int j = 0; j < 4; ++j)
#pragma unroll
                for (int i = 0; i < 4; ++i) { const float y = v[j][i] * inv, a = fabsf(y);
                    const unsigned code = (unsigned)(a > 0.25f) + (unsigned)(a > 0.75f) + (unsigned)(a > 1.25f) + (unsigned)(a > 1.75f) + (unsigned)(a > 2.5f) + (unsigned)(a > 3.5f) + (unsigned)(a > 5.0f) + ((y < 0.f) ? 8u : 0u);
                    const int n = 4 * j + i; if (n < 8) wlo |= code << (4 * n); else whi |= code << (4 * (n - 8)); }
            unsigned char* dst = (tb ? EV4 : EU4) + ((size_t)(lane >> 4) * NEXP + e) * 128 + (lane & 15) * 8;
            if (tb) {
                LAS unsigned* cs4 = (LAS unsigned*)scr;
                cs4[lane * 2] = wlo; cs4[lane * 2 + 1] = whi;
                asm volatile("s_waitcnt lgkmcnt(0)" ::: "memory");
                const int q = lane & 15, sl = lane >> 4; unsigned tlo = 0u, thi = 0u;
#pragma unroll
                for (int n = 0; n < 16; ++n) { const int m = 4 * (n & 3);
                    const unsigned w = cs4[(sl * 16 + 4 * (q & 3) + (n >> 2)) * 2 + (m >> 3)]; const unsigned code = (w >> (4 * ((m & 7) + (q >> 2)))) & 0xfu;
                    if (n < 8) tlo |= code << (4 * n); else thi |= code << (4 * (n - 8)); }
                asm volatile("s_waitcnt lgkmcnt(0)" ::: "memory");
                wlo = tlo; whi = thi;
            }
            *(v2u*)dst = (v2u){wlo, whi};
            if (lane == 0) (tb ? SV : SU)[e] = sc;
        }
    }
    bf16* WSP = (bf16*)(p.ws + WS_WSP);
    for (int i = gt; i < 4 * 128 * 128; i += NGT) {
        const int pj = i & 127, ii = (i >> 7) & 127, g = i >> 14;
        const int ks = pj >> 4, hi = (pj >> 3) & 1, jj = pj & 7, j = 16 * ks + 4 * hi + (jj & 3) + 8 * (jj >> 2);
        WSP[i] = (bf16)((j <= ii) ? f2bf(p.w_sp[(g * 128 + ii) * 128 + j]) : 0u);
    }
    bf16* HN = (bf16*)(p.ws + WS_HN);
    {
        f32x4 g4[4];
#pragma unroll
        for (int j = 0; j < 4; ++j) g4[j] = *((const f32x4*)p.mix_g + lane + 64 * j);
        f32x4 nx[4], ny[4];
        if (gw < T) { const int m1 = (gw + NGW < T) ? gw + NGW : gw;
#pragma unroll
            for (int j = 0; j < 4; ++j) { nx[j] = __builtin_nontemporal_load((const f32x4*)(p.x + (size_t)gw * D) + lane + 64 * j); ny[j] = __builtin_nontemporal_load((const f32x4*)(p.x + (size_t)m1 * D) + lane + 64 * j); } }
        for (int m = gw; m < T; m += NGW) {
            f32x4 v[4]; float s = 0.f;
#pragma unroll
            for (int j = 0; j < 4; ++j) { v[j] = nx[j]; nx[j] = ny[j]; }
            const int mn = (m + 2 * NGW < T) ? m + 2 * NGW : m;
#pragma unroll
            for (int j = 0; j < 4; ++j) ny[j] = __builtin_nontemporal_load((const f32x4*)(p.x + (size_t)mn * D) + lane + 64 * j);
#pragma unroll
            for (int j = 0; j < 4; ++j) s += (v[j].x * v[j].x + v[j].y * v[j].y) + (v[j].z * v[j].z + v[j].w * v[j].w);
            const float r = rsqrtf(wave_sum(s) * (1.f / D) + EPS);
            v2u* o8 = (v2u*)(HN + (size_t)m * D) + lane;
#pragma unroll
            for (int j = 0; j < 4; ++j) { const f32x4 g = g4[j]; v2u o; o.x = pk2(v[j].x * r * g.x, v[j].y * r * g.y); o.y = pk2(v[j].z * r * g.z, v[j].w * r * g.w); o8[64 * j] = o; }
        }
    }
    if (blockIdx.x & 1) { __syncthreads(); for (int it = blockIdx.x; it < 256; it += G) p0_fold_item(p, lds, it, tid); }
}

struct EpiProj {
    static constexpr bool PERM = true, AFTER_DRAIN = false;
    bf16 *Q, *K, *V, *GU, *GV; const float *qg, *kg;
    __device__ __forceinline__ void operator()(const pg8::f32x4 (&acc)[2][2][4][2], const pg8::Unit& u, int wr, int wc, int fr, int fq) const {
        const int type = u.pn >> 1;
        bf16* base = type == 0 ? Q : type == 1 ? K : type == 2 ? V : type == 3 ? GU : GV;
        const int ct = (u.pn & 1) * 256 + wc * 64 + 8 * fq;
        const int row0 = u.pm * 256 + wr * 64 + fr;
        if (type <= 1) {
            const float* g = type == 0 ? qg : kg; const float sc = type == 0 ? QSCALE : 1.f;
            f32x4 gv[2][2];
#pragma unroll
            for (int bj = 0; bj < 2; ++bj)
#pragma unroll
                for (int n = 0; n < 2; ++n) gv[bj][n] = *(const f32x4*)(g + 32 * bj + 8 * fq + 4 * n);
#pragma unroll
            for (int ai = 0; ai < 2; ++ai)
#pragma unroll
                for (int m = 0; m < 4; ++m) {
                    float ss = 0.f;
#pragma unroll
                    for (int bj = 0; bj < 2; ++bj)
#pragma unroll
                        for (int n = 0; n < 2; ++n) { const f32x4 v = acc[ai][bj][m][n]; ss += (v[0] * v[0] + v[1] * v[1]) + (v[2] * v[2] + v[3] * v[3]); }
                    ss = sum_x32(sum_x16(ss));
                    const float r = rsqrtf(ss * (1.f / 64.f) + EPS) * sc;
                    bf16* rowp = base + (size_t)(row0 + ai * 128 + m * 16) * 512 + ct;
#pragma unroll
                    for (int bj = 0; bj < 2; ++bj) { const f32x4 v0 = acc[ai][bj][m][0] * gv[bj][0] * r, v1 = acc[ai][bj][m][1] * gv[bj][1] * r;
                        v4u w; w.x = pk2(v0[0], v0[1]); w.y = pk2(v0[2], v0[3]); w.z = pk2(v1[0], v1[1]); w.w = pk2(v1[2], v1[3]);
                        *(v4u*)(rowp + 32 * bj) = w; }
                }
        } else {
#pragma unroll
            for (int ai = 0; ai < 2; ++ai)
#pragma unroll
                for (int m = 0; m < 4; ++m) {
                    bf16* rowp = base + (size_t)(row0 + ai * 128 + m * 16) * 512 + ct;
#pragma unroll
                    for (int bj = 0; bj < 2; ++bj) { f32x4 v0 = acc[ai][bj][m][0], v1 = acc[ai][bj][m][1];
                        if (type >= 3) { pg8::f32x2 a = pg8::gelu_pk((pg8::f32x2){v0[0], v0[1]}), b = pg8::gelu_pk((pg8::f32x2){v0[2], v0[3]}), c = pg8::gelu_pk((pg8::f32x2){v1[0], v1[1]}), d = pg8::gelu_pk((pg8::f32x2){v1[2], v1[3]});
                            v0 = (f32x4){a.x, a.y, b.x, b.y}; v1 = (f32x4){c.x, c.y, d.x, d.y}; }
                        v4u w; w.x = pk2(v0[0], v0[1]); w.y = pk2(v0[2], v0[3]); w.z = pk2(v1[0], v1[1]); w.w = pk2(v1[2], v1[3]);
                        *(v4u*)(rowp + 32 * bj) = w; }
                }
        }
    }
};
struct EpiOut {
    static constexpr bool PERM = true, AFTER_DRAIN = false;
    const float* X; float* OUT; bf16* X1B; float* PART; unsigned char* XF8;
    __device__ __forceinline__ void operator()(const pg8::f32x4 (&acc)[2][2][4][2], const pg8::Unit& u, int wr, int wc, int fr, int fq) const {
        const int row0 = u.pm * 256 + wr * 64 + fr, col0 = u.pn * 256 + wc * 32 + 8 * fq;
#pragma unroll
        for (int ai = 0; ai < 2; ++ai) {
            f32x4 xv[4][2][2];
#pragma unroll
            for (int m = 0; m < 4; ++m)
#pragma unroll
                for (int bj = 0; bj < 2; ++bj)
#pragma unroll
                    for (int n = 0; n < 2; ++n) xv[m][bj][n] = __builtin_nontemporal_load((const f32x4*)(X + (size_t)(row0 + ai * 128 + m * 16) * D + col0 + bj * 128 + n * 4));
#pragma unroll
            for (int m = 0; m < 4; ++m) {
                const int row = row0 + ai * 128 + m * 16; float ss = 0.f;
#pragma unroll
                for (int bj = 0; bj < 2; ++bj) { const size_t off = (size_t)row * D + col0 + bj * 128;
                    const f32x4 o0 = xv[m][bj][0] + acc[ai][bj][m][0], o1 = xv[m][bj][1] + acc[ai][bj][m][1];
                    ss += ((o0[0] * o0[0] + o0[1] * o0[1]) + (o0[2] * o0[2] + o0[3] * o0[3])) + ((o1[0] * o1[0] + o1[1] * o1[1]) + (o1[2] * o1[2] + o1[3] * o1[3]));
                    v4u w; w.x = pk2(o0[0], o0[1]); w.y = pk2(o0[2], o0[3]); w.z = pk2(o1[0], o1[1]); w.w = pk2(o1[2], o1[3]); *(v4u*)(X1B + off) = w;
                    int lo = 0, hi = 0;
                    lo = __builtin_amdgcn_cvt_pk_fp8_f32(o0[0] * 8.f, o0[1] * 8.f, lo, false); lo = __builtin_amdgcn_cvt_pk_fp8_f32(o0[2] * 8.f, o0[3] * 8.f, lo, true);
                    hi = __builtin_amdgcn_cvt_pk_fp8_f32(o1[0] * 8.f, o1[1] * 8.f, hi, false); hi = __builtin_amdgcn_cvt_pk_fp8_f32(o1[2] * 8.f, o1[3] * 8.f, hi, true);
                    *(v2u*)(XF8 + off) = (v2u){(unsigned)lo, (unsigned)hi}; }
                ss = sum_x32(sum_x16(ss));
                if (fq == 0) PART[(size_t)row * 16 + u.pn * 4 + wc] = ss;
            }
        }
    }
};
struct EpiF32 {
    static constexpr bool PERM = false, AFTER_DRAIN = false;
    float* C; int ldc;
    __device__ __forceinline__ void operator()(const pg8::f32x4 (&acc)[2][2][4][2], const pg8::Unit& u, int wr, int wc, int fr, int fq) const {
        const int row0 = u.pm * 256 + wr * 64 + fr, col0 = u.pn * 256 + wc * 32 + 4 * fq;
#pragma unroll
        for (int ai = 0; ai < 2; ++ai)
#pragma unroll
            for (int m = 0; m < 4; ++m) { float* rowp = C + (size_t)(row0 + ai * 128 + m * 16) * ldc + col0;
#pragma unroll
                for (int bj = 0; bj < 2; ++bj)
#pragma unroll
                    for (int n = 0; n < 2; ++n) *(f32x4*)(rowp + bj * 128 + n * 16) = acc[ai][bj][m][n]; }
    }
};

struct EpiTopk {
    static constexpr bool PERM = false, AFTER_DRAIN = false;
    float* TOPW;
    __device__ __forceinline__ void operator()(const pg8::f32x4 (&acc)[2][2][4][2], const pg8::Unit& u, int wr, int wc, int fr, int fq) const {
        const int row0 = u.pm * 256 + wr * 64 + fr; unsigned kb = 64u * (wc & 1) + 4u * fq;
#pragma unroll
        for (int ai = 0; ai < 2; ++ai) {
            float x[16], y[16], r[16];
#define TOPK_PACK(dst, m) do { _Pragma("unroll") for (int bj = 0; bj < 2; ++bj) _Pragma("unroll") for (int n = 0; n < 2; ++n) _Pragma("unroll") for (int i = 0; i < 4; ++i) \
                dst[8 * bj + 4 * n + i] = __uint_as_float((__float_as_uint(acc[ai][bj][m][n][i]) & ~0x7fu) | (kb + 32u * bj + 16u * n + i));   \
                SORT16_DESC(dst); } while (0)
            TOPK_PACK(x, 0); TOPK_PACK(r, 1);
#pragma unroll
            for (int i = 0; i < 16; ++i) swap16(x[i], r[i]);
            MERGE16_REG(x, r);
            __builtin_amdgcn_sched_barrier(0);
            TOPK_PACK(y, 2); TOPK_PACK(r, 3);
#pragma unroll
            for (int i = 0; i < 16; ++i) swap16(y[i], r[i]);
            MERGE16_REG(y, r);
            __builtin_amdgcn_sched_barrier(0);
#pragma unroll
            for (int i = 0; i < 16; ++i) { r[i] = y[i]; swap32(x[i], r[i]); }
            MERGE16_REG(x, r);
#undef TOPK_PACK
            f32x4* o = (f32x4*)(TOPW + (((size_t)(row0 + ai * 128 + fq * 16) * 8 + u.pn) * 4 + wc) * 16);
            o[0] = (f32x4){x[0], x[1], x[2], x[3]}; o[1] = (f32x4){x[4], x[5], x[6], x[7]}; o[2] = (f32x4){x[8], x[9], x[10], x[11]}; o[3] = (f32x4){x[12], x[13], x[14], x[15]};
        }
    }
};

constexpr int A_KP = 1152, A_KT = 8 * A_KP;
constexpr int A_K = 0, A_V = 6 * A_KT, A_ST = A_V + 49152, A_STW = 32 * 144;
struct AttnU { int h, pat, dl, m0, jlo; size_t rowbase; };
__device__ __forceinline__ AttnU attn_decode(int unit) {
    AttnU u; const int bh = unit / 48, rem = unit % 48, k16 = rem & 15; u.pat = rem >> 4;
    const int b = bh >> 3, nb = 16 >> (2 * u.pat), r = k16 / nb, qb = k16 % nb;
    u.h = bh & 7; u.dl = 1 << (2 * u.pat); u.m0 = qb * 256; u.jlo = (qb == 0) ? 2 : 0; u.rowbase = (size_t)b * SEQ + r; return u;
}
__device__ __forceinline__ long attn_off(const AttnU& u, int m) { return (((long)u.rowbase + (long)m * u.dl) * 512 + u.h * 64) * 2; }
__device__ __forceinline__ void attn_dma_k(const Ptrs& p, LAS unsigned char* lds, const AttnU& u, int lane, int w) {
    const unsigned char* kb = p.ws + WS_K + attn_off(u, u.m0 - 128 + 8 * w); const unsigned voff = (unsigned)((lane >> 3) * u.dl) * 1024u + (unsigned)((lane ^ (lane >> 3)) & 7) * 16u;
#pragma unroll
    for (int j = 0; j < 6; ++j) if (j >= u.jlo)
        __builtin_amdgcn_global_load_lds((const unsigned*)(kb + (size_t)(j * 64 * u.dl) * 1024 + voff), (LAS unsigned*)(lds + A_K + j * A_KT + w * A_KP), 16, 0, 0);
}
__device__ __forceinline__ void attn_dma_v(const Ptrs& p, LAS unsigned char* lds, const AttnU& u, int lane, int w) {
    const unsigned char* vb = p.ws + WS_V + attn_off(u, u.m0 - 128 + 8 * w); const unsigned voff = (unsigned)(((lane >> 2) & 7) * u.dl) * 1024u + (lane >> 5) * 64u + (lane & 3) * 16u;
#pragma unroll
    for (int j = 0; j < 6; ++j) if (j >= u.jlo)
        __builtin_amdgcn_global_load_lds((const unsigned*)(vb + (size_t)(j * 64 * u.dl) * 1024 + voff), (LAS unsigned*)(lds + A_V + j * 8192 + w * 1024), 16, 0, 0);
}
__device__ __forceinline__ void attn_dma_q(const Ptrs& p, LAS unsigned char* lds, const AttnU& u, int lane, int w) {
    const unsigned char* qb = p.ws + WS_Q + attn_off(u, u.m0 + 32 * w); const unsigned voff = (unsigned)((lane >> 3) * u.dl) * 1024u + (unsigned)((lane ^ (lane >> 3)) & 7) * 16u;
#pragma unroll
    for (int i = 0; i < 4; ++i)
        __builtin_amdgcn_global_load_lds((const unsigned*)(qb + (size_t)(i * 8 * u.dl) * 1024 + voff), (LAS unsigned*)(lds + A_ST + w * A_STW + i * 1152), 16, 0, 0);
}
__device__ __forceinline__ void attn_read_q(bf16x8 (&q)[4], LAS unsigned char* lds, int lane, int w) {
    const int r32 = lane & 31, hi = lane >> 5;
    const LAS unsigned char* qs = lds + A_ST + w * A_STW + (r32 >> 3) * 1152 + (r32 & 7) * 128;
    asm volatile("s_waitcnt vmcnt(0)" ::: "memory");
#pragma unroll
    for (int d0 = 0; d0 < 4; ++d0) q[d0] = *(const LAS bf16x8*)(qs + (((2 * d0 + hi) ^ r32) & 7) * 16);
    asm volatile("s_waitcnt lgkmcnt(0)" ::: "memory");
}
#define ATT_BAR_VM() do { asm volatile("s_waitcnt vmcnt(0) lgkmcnt(0)" ::: "memory"); __builtin_amdgcn_s_barrier(); asm volatile("" ::: "memory"); } while (0)
#define ATT_BAR_LDS() do { asm volatile("s_waitcnt lgkmcnt(0)" ::: "memory"); __builtin_amdgcn_s_barrier(); asm volatile("" ::: "memory"); } while (0)
template <bool FIRST>
__device__ __forceinline__ void attn_pv_tile(f32x16 (&o)[2], f32x16& ls, const f32x16& zacc, const bf16x8 ones, const v4u (&pwi)[2], const LAS unsigned char* vb) {
#pragma unroll
    for (int ks = 0; ks < 2; ++ks) {
        const bf16x8 pa = __builtin_bit_cast(bf16x8, pwi[ks]);
        if (FIRST && ks == 0) ls = __builtin_amdgcn_mfma_f32_32x32x16_bf16(ones, pa, zacc, 0, 0, 0);
        else ls = __builtin_amdgcn_mfma_f32_32x32x16_bf16(ones, pa, ls, 0, 0, 0);
#pragma unroll
        for (int d0 = 0; d0 < 2; ++d0) {
            const s16x4 lo = __builtin_bit_cast(s16x4, __builtin_amdgcn_ds_read_tr16_b64_v4i16((LAS v4i16_t*)(vb + d0 * 512 + ks * 2048)));
            const s16x4 hh = __builtin_bit_cast(s16x4, __builtin_amdgcn_ds_read_tr16_b64_v4i16((LAS v4i16_t*)(vb + d0 * 512 + ks * 2048 + 1024)));
            const bf16x8 vf = (bf16x8){lo[0], lo[1], lo[2], lo[3], hh[0], hh[1], hh[2], hh[3]};
            if (FIRST && ks == 0) o[d0] = __builtin_amdgcn_mfma_f32_32x32x16_bf16(vf, pa, zacc, 0, 0, 0);
            else o[d0] = __builtin_amdgcn_mfma_f32_32x32x16_bf16(vf, pa, o[d0], 0, 0, 0);
        }
    }
}
__device__ __forceinline__ void attn_compute(const Ptrs& p, LAS unsigned char* lds, const AttnU& u, const AttnU& un, bool has_next, bf16x8 (&qr)[4], const f32x16& macc, float M, bool usemax, int lane, int w) {
    const int r32 = lane & 31, hi = lane >> 5, glo = 2 * u.jlo;
    const float NEGINF = -INFINITY;
    f32x16 zacc = {}; asm volatile("" : "+v"(zacc));
    int xo[4];
#pragma unroll
    for (int d0 = 0; d0 < 4; ++d0) xo[d0] = (((2 * d0 + hi) ^ r32) & 7) * 16;
    f32x16 sc[5];
#pragma unroll
    for (int i = 0; i < 5; ++i) {
        const int g = w + i;
        f32x16 a;
        if (g >= glo) {
            const LAS unsigned char* kb = lds + A_K + (g >> 1) * A_KT + ((g & 1) * 4 + (r32 >> 3)) * A_KP + (r32 & 7) * 128;
            a = __builtin_amdgcn_mfma_f32_32x32x16_bf16(*(const LAS bf16x8*)(kb + xo[0]), qr[0], macc, 0, 0, 0);
#pragma unroll
            for (int d0 = 1; d0 < 4; ++d0) a = __builtin_amdgcn_mfma_f32_32x32x16_bf16(*(const LAS bf16x8*)(kb + xo[d0]), qr[d0], a, 0, 0, 0);
            if (i == 0) {
#pragma unroll
                for (int rr = 0; rr < 16; ++rr) a[rr] = (crow(rr, hi) >= r32) ? a[rr] : NEGINF; }
            if (i == 4) {
#pragma unroll
                for (int rr = 0; rr < 16; ++rr) a[rr] = (crow(rr, hi) <= r32) ? a[rr] : NEGINF; }
        } else {
#pragma unroll
            for (int rr = 0; rr < 16; ++rr) a[rr] = NEGINF; }
        sc[i] = a;
    }
    ATT_BAR_LDS();
    if (has_next) { attn_dma_k(p, lds, un, lane, w); attn_dma_q(p, lds, un, lane, w); }
    float mx = 0.f;
    if (usemax) {
        mx = NEGINF;
#pragma unroll
        for (int i = 0; i < 5; ++i)
#pragma unroll
            for (int rr = 0; rr < 16; ++rr) mx = fmaxf(mx, sc[i][rr]);
        mx = max_x32(mx);
#pragma unroll
        for (int i = 0; i < 5; ++i)
#pragma unroll
            for (int rr = 0; rr < 16; ++rr) sc[i][rr] -= mx;
    }
    v4u pw[5][2];
#pragma unroll
    for (int i = 0; i < 5; ++i) {
        unsigned pk[8];
#pragma unroll
        for (int r2 = 0; r2 < 8; ++r2) pk[r2] = pk2(__builtin_amdgcn_exp2f(sc[i][2 * r2]), __builtin_amdgcn_exp2f(sc[i][2 * r2 + 1]));
        pw[i][0] = (v4u){pk[0], pk[1], pk[2], pk[3]};
        pw[i][1] = (v4u){pk[4], pk[5], pk[6], pk[7]};
    }
    if (has_next) attn_read_q(qr, lds, lane, w);
    f32x16 o[2], ls;
    const bf16x8 ones = __builtin_bit_cast(bf16x8, (v4u){0x3f803f80u, 0x3f803f80u, 0x3f803f80u, 0x3f803f80u});
    const int vlane = ((lane >> 4) & 1) * 32 + (lane & 3) * 8 + (4 * hi + ((lane & 15) >> 2)) * 64;
    { const int g = w + 4; attn_pv_tile<true>(o, ls, zacc, ones, pw[4], lds + A_V + (g >> 1) * 8192 + (g & 1) * 4096 + vlane); }
#pragma unroll
    for (int i = 0; i < 4; ++i) {
        const int g = w + i;
        if (g >= glo) attn_pv_tile<false>(o, ls, zacc, ones, pw[i], lds + A_V + (g >> 1) * 8192 + (g & 1) * 4096 + vlane);
    }
    ATT_BAR_LDS();
    if (has_next) attn_dma_v(p, lds, un, lane, w);
    const float l = ls[0];
    const float rl = __builtin_amdgcn_rcpf(l);
    if (hi == 0) *(float*)(p.ws + WS_LSE + ((size_t)u.pat * T * 8 + (u.rowbase + (size_t)(u.m0 + 32 * w) * u.dl) * 8 + u.h) * 4 + (unsigned)(r32 * u.dl) * 32u) = (M + mx) + __builtin_amdgcn_logf(l);
    LAS unsigned char* stw = lds + A_ST + w * A_STW;
    LAS unsigned char* stg = stw + r32 * 144 + hi * 8;
#pragma unroll
    for (int d0 = 0; d0 < 2; ++d0)
#pragma unroll
        for (int q4 = 0; q4 < 4; ++q4)
            *(LAS v2u*)(stg + d0 * 64 + q4 * 16) = (v2u){pk2(o[d0][4 * q4] * rl, o[d0][4 * q4 + 1] * rl), pk2(o[d0][4 * q4 + 2] * rl, o[d0][4 * q4 + 3] * rl)};
    asm volatile("s_waitcnt lgkmcnt(0)" ::: "memory");
    unsigned char* pob = p.ws + WS_PO + (size_t)u.pat * T * 1024 + attn_off(u, u.m0 + 32 * w); const unsigned pvoff = (unsigned)((lane >> 3) * u.dl) * 1024u + (lane & 7) * 16u;
#pragma unroll
    for (int i = 0; i < 4; ++i) { const v4u v = *(const LAS v4u*)(stw + (i * 8 + (lane >> 3)) * 144 + (lane & 7) * 16);
        __builtin_nontemporal_store(v, (v4u*)(pob + (size_t)(i * 8 * u.dl) * 1024 + pvoff)); }
}
__device__ __forceinline__ void attn_phase(const Ptrs& p, LAS unsigned char* lds, int vcu, int G, int lane, int w) {
    const int NU = BATCH * NH * 48;
    if (vcu >= NU) return;
    AttnU u = attn_decode(vcu);
    bf16x8 qr[4];
    const float M = 64.f * QSCALE * 1.01f * wave_max(fabsf(p.q_g[lane])) * wave_max(fabsf(p.k_g[lane])) + 0.125f;
    const bool usemax = !(M < 60.f);
    f32x16 macc;
#pragma unroll
    for (int r = 0; r < 16; ++r) macc[r] = -M;
    asm volatile("" : "+v"(macc));
    attn_dma_k(p, lds, u, lane, w); attn_dma_v(p, lds, u, lane, w); attn_dma_q(p, lds, u, lane, w); attn_read_q(qr, lds, lane, w);
    for (int unit = vcu; unit < NU; unit += G) {
        const bool has_next = unit + G < NU;
        const AttnU un = attn_decode(has_next ? unit + G : unit);
        ATT_BAR_VM();
        attn_compute(p, lds, u, un, has_next, qr, macc, M, usemax, lane, w);
        u = un;
    }
    ATT_BAR_VM();
}

__device__ __forceinline__ void gmlp_unit(const Ptrs& p, LAS unsigned char* lds, int unit, int tid, int lane, int w) {
    const size_t rowbase = (size_t)unit * 128;
    const bf16* GU = (const bf16*)(p.ws + WS_GU); const bf16* GV = (const bf16*)(p.ws + WS_GV); const bf16* WSP = (const bf16*)(p.ws + WS_WSP);
    bf16* MG = (bf16*)(p.ws + WS_HN);
    const int r32 = lane & 31, hi = lane >> 5;
    {
        const int g = lane >> 4; f32x4 ga = *(const f32x4*)(p.vg_g + g * 128 + (lane & 15) * 8), gb = *(const f32x4*)(p.vg_g + g * 128 + (lane & 15) * 8 + 4);
#pragma unroll 4
        for (int it = 0; it < 16; ++it) {
            const int j = it * 8 + w;
            const v4u raw = *(const v4u*)(GV + (rowbase + j) * 512 + lane * 8);
            float v[8] = {bflo(raw.x), bfhi(raw.x), bflo(raw.y), bfhi(raw.y), bflo(raw.z), bfhi(raw.z), bflo(raw.w), bfhi(raw.w)};
            float ss = 0.f;
#pragma unroll
            for (int i = 0; i < 8; ++i) ss += v[i] * v[i];
            ss = row_sum16(ss);
            const float rn = rsqrtf(ss * (1.f / 128.f) + EPS);
            v4u o; o.x = pk2(v[0] * rn * ga.x, v[1] * rn * ga.y); o.y = pk2(v[2] * rn * ga.z, v[3] * rn * ga.w); o.z = pk2(v[4] * rn * gb.x, v[5] * rn * gb.y); o.w = pk2(v[6] * rn * gb.z, v[7] * rn * gb.w);
            *(LAS v4u*)(lds + ((lane >> 2) * 8 + (j >> 4)) * 1024 + (j & 15) * 64 + (lane & 3) * 16) = o;
        }
    }
    __syncthreads();
    const int ib = w & 3, gp = w >> 2;
    f32x16 acc[8];
#pragma unroll
    for (int i = 0; i < 8; ++i) acc[i] = (f32x16){};
    const int vlane = ((lane >> 4) & 1) * 32 + (lane & 3) * 8 + (4 * hi + ((lane & 15) >> 2)) * 64;
#pragma unroll
    for (int g2 = 0; g2 < 2; ++g2) {
        const int g = 2 * gp + g2;
        for (int ks = 0; ks < 2 * ib + 2; ++ks) {
            const bf16x8 af = *(const bf16x8*)(WSP + (size_t)((g * 128 + 32 * ib + r32) * 128 + 16 * ks + 8 * hi));
#pragma unroll
            for (int ct = 0; ct < 4; ++ct) {
                const LAS unsigned char* vb = lds + ((g * 4 + ct) * 8 + ks) * 1024 + vlane;
                const s16x4 lo = __builtin_bit_cast(s16x4, __builtin_amdgcn_ds_read_tr16_b64_v4i16((LAS v4i16_t*)(vb)));
                const s16x4 hh = __builtin_bit_cast(s16x4, __builtin_amdgcn_ds_read_tr16_b64_v4i16((LAS v4i16_t*)(vb + 512)));
                const bf16x8 vf = (bf16x8){lo[0], lo[1], lo[2], lo[3], hh[0], hh[1], hh[2], hh[3]};
                acc[g2 * 4 + ct] = __builtin_amdgcn_mfma_f32_32x32x16_bf16(af, vf, acc[g2 * 4 + ct], 0, 0, 0);
            }
        }
    }
    __syncthreads();
#pragma unroll
    for (int g2 = 0; g2 < 2; ++g2) {
        const int g = 2 * gp + g2;
#pragma unroll
        for (int rr = 0; rr < 16; ++rr) {
            const int i = 32 * ib + crow(rr, hi); const float bias = p.b_sp[g * 128 + i];
#pragma unroll
            for (int ct = 0; ct < 4; ++ct) {
                const int c = g * 128 + ct * 32 + r32;
                *(LAS bf16*)(lds + (i * 512 + c) * 2) = (bf16)f2bf(acc[g2 * 4 + ct][rr] + bias);
            }
        }
    }
    __syncthreads();
    {
        const f32x4 ga = *(const f32x4*)(p.go_g + lane * 8), gb = *(const f32x4*)(p.go_g + lane * 8 + 4);
#pragma unroll 4
        for (int ii = 0; ii < 16; ++ii) {
            const int i = 16 * w + ii;
            const v4u raw = *(const LAS v4u*)(lds + (i * 512 + lane * 8) * 2);
            const v4u gur = *(const v4u*)(GU + (rowbase + i) * 512 + lane * 8);
            const unsigned z0 = raw.x, z1 = raw.y, z2 = raw.z, z3 = raw.w, u0 = gur.x, u1 = gur.y, u2 = gur.z, u3 = gur.w;
            float v[8] = {bflo(z0) * bflo(u0), bfhi(z0) * bfhi(u0), bflo(z1) * bflo(u1), bfhi(z1) * bfhi(u1), bflo(z2) * bflo(u2), bfhi(z2) * bfhi(u2), bflo(z3) * bflo(u3), bfhi(z3) * bfhi(u3)};
            float ss = 0.f;
#pragma unroll
            for (int k = 0; k < 8; ++k) ss += v[k] * v[k];
            const float rn = rsqrtf(wave_sum(ss) * (1.f / 512.f) + EPS);
            v4u o; o.x = pk2(v[0] * rn * ga.x, v[1] * rn * ga.y); o.y = pk2(v[2] * rn * ga.z, v[3] * rn * ga.w); o.z = pk2(v[4] * rn * gb.x, v[5] * rn * gb.y); o.w = pk2(v[6] * rn * gb.z, v[7] * rn * gb.w);
            *(v4u*)(MG + (rowbase + i) * 1024 + 512 + lane * 8) = o;
        }
    }
    __syncthreads();
}

struct CombIn { v4u a, b, c; float l0, l1, l2; };
__device__ __forceinline__ CombIn combine_load(const Ptrs& p, size_t row, int lane) {
    const bf16* PO = (const bf16*)(p.ws + WS_PO); const float* LSE = (const float*)(p.ws + WS_LSE); const int h = lane >> 3;
    CombIn k; k.l0 = LSE[row * 8 + h]; k.l1 = LSE[(size_t)T * 8 + row * 8 + h]; k.l2 = LSE[(size_t)2 * T * 8 + row * 8 + h];
    k.a = *(const v4u*)(PO + row * 512 + lane * 8); k.b = *(const v4u*)(PO + (size_t)T * 512 + row * 512 + lane * 8); k.c = *(const v4u*)(PO + (size_t)2 * T * 512 + row * 512 + lane * 8); return k;
}
__device__ __forceinline__ void combine_row(const Ptrs& p, const CombIn& k, const f32x4 ga, const f32x4 gb, size_t row, int lane) {
    bf16* MG = (bf16*)(p.ws + WS_HN);
    const float l0 = k.l0, l1 = k.l1, l2 = k.l2; const v4u a = k.a, b = k.b, c = k.c;
    const float mx = fmaxf(l0, fmaxf(l1, l2));
    float w0 = __builtin_amdgcn_exp2f(l0 - mx), w1 = __builtin_amdgcn_exp2f(l1 - mx), w2 = __builtin_amdgcn_exp2f(l2 - mx);
    const float inv = 1.f / (w0 + w1 + w2); w0 *= inv; w1 *= inv; w2 *= inv;
    const unsigned a0 = a.x, a1 = a.y, a2 = a.z, a3 = a.w, b0 = b.x, b1 = b.y, b2 = b.z, b3 = b.w, c0 = c.x, c1 = c.y, c2 = c.z, c3 = c.w;
    float v[8];
    v[0] = w0 * bflo(a0) + w1 * bflo(b0) + w2 * bflo(c0); v[1] = w0 * bfhi(a0) + w1 * bfhi(b0) + w2 * bfhi(c0);
    v[2] = w0 * bflo(a1) + w1 * bflo(b1) + w2 * bflo(c1); v[3] = w0 * bfhi(a1) + w1 * bfhi(b1) + w2 * bfhi(c1);
    v[4] = w0 * bflo(a2) + w1 * bflo(b2) + w2 * bflo(c2); v[5] = w0 * bfhi(a2) + w1 * bfhi(b2) + w2 * bfhi(c2);
    v[6] = w0 * bflo(a3) + w1 * bflo(b3) + w2 * bflo(c3); v[7] = w0 * bfhi(a3) + w1 * bfhi(b3) + w2 * bfhi(c3);
    float ss = 0.f;
#pragma unroll
    for (int q = 0; q < 8; ++q) ss += v[q] * v[q];
    const float rn = rsqrtf(wave_sum(ss) * (1.f / 512.f) + EPS);
    v4u o; o.x = pk2(v[0] * rn * ga.x, v[1] * rn * ga.y); o.y = pk2(v[2] * rn * ga.z, v[3] * rn * ga.w); o.z = pk2(v[4] * rn * gb.x, v[5] * rn * gb.y); o.w = pk2(v[6] * rn * gb.z, v[7] * rn * gb.w);
    *(v4u*)(MG + row * 1024 + lane * 8) = o;
}
__device__ __forceinline__ void combine_phase(const Ptrs& p, int gw, int NGW, int lane) {
    if (gw >= T) return;
    const f32x4 ga = *(const f32x4*)(p.ao_g + lane * 8), gb = *(const f32x4*)(p.ao_g + lane * 8 + 4);
    CombIn nx = combine_load(p, (size_t)gw, lane);
    for (int m = gw; m < T; m += NGW) {
        const CombIn cur = nx;
        nx = combine_load(p, (size_t)((m + NGW < T) ? m + NGW : m), lane);
        combine_row(p, cur, ga, gb, (size_t)m, lane);
    }
}

__device__ __forceinline__ void wqk_rowmax(const Ptrs& p, int gw, int NGW, int lane) {
    const bf16* WQK = (const bf16*)(p.ws + WS_WQK); float* RMAX = (float*)(p.ws + WS_CSC);
    for (int r = gw; r < 2048; r += NGW) {
        const v4u a = *(const v4u*)(WQK + (size_t)r * 1024 + lane * 16), b = *(const v4u*)(WQK + (size_t)r * 1024 + lane * 16 + 8);
        const unsigned w0 = a.x, w1 = a.y, w2 = a.z, w3 = a.w, w4 = b.x, w5 = b.y, w6 = b.z, w7 = b.w;
        float m = fmaxf(fmaxf(fmaxf(fabsf(bflo(w0)), fabsf(bfhi(w0))), fmaxf(fabsf(bflo(w1)), fabsf(bfhi(w1)))), fmaxf(fmaxf(fabsf(bflo(w2)), fabsf(bfhi(w2))), fmaxf(fabsf(bflo(w3)), fabsf(bfhi(w3)))));
        m = fmaxf(m, fmaxf(fmaxf(fmaxf(fabsf(bflo(w4)), fabsf(bfhi(w4))), fmaxf(fabsf(bflo(w5)), fabsf(bfhi(w5)))), fmaxf(fmaxf(fabsf(bflo(w6)), fabsf(bfhi(w6))), fmaxf(fabsf(bflo(w7)), fabsf(bfhi(w7))))));
        m = wave_max(m);
        if (lane == 0) RMAX[r] = m;
    }
}
__device__ __forceinline__ void wqk_to_fp8(const Ptrs& p, int gw, int NGW, int lane) {
    const bf16* WQK = (const bf16*)(p.ws + WS_WQK); unsigned char* W8 = p.ws + WS_WQK8; const float* RMAX = (const float*)(p.ws + WS_CSC);
    if (gw >= 2048) return;
    float m = 0.f;
#pragma unroll
    for (int q = 0; q < 8; ++q) { const f32x4 v = *(const f32x4*)(RMAX + q * 256 + lane * 4); m = fmaxf(m, fmaxf(fmaxf(v[0], v[1]), fmaxf(v[2], v[3]))); }
    m = wave_max(m);
    const int ex = (int)((__float_as_uint(m) >> 23) & 0xffu);
    const bool ok = ex > 16 && ex < 250;
    const float S = ok ? __uint_as_float((unsigned)(127 + 7 + 127 - ex) << 23) : 1.f, Si = ok ? __uint_as_float((unsigned)(ex - 7 - 3) << 23) : 0.125f;
    if (gw == 0 && lane == 0) ((float*)(p.ws + WS_CSC))[2048] = Si;
    for (int r = gw; r < 2048; r += NGW) {
        const v4u a = *(const v4u*)(WQK + (size_t)r * 1024 + lane * 16), b = *(const v4u*)(WQK + (size_t)r * 1024 + lane * 16 + 8);
        const unsigned w0 = a.x, w1 = a.y, w2 = a.z, w3 = a.w, w4 = b.x, w5 = b.y, w6 = b.z, w7 = b.w;
        const float v[16] = {bflo(w0), bfhi(w0), bflo(w1), bfhi(w1), bflo(w2), bfhi(w2), bflo(w3), bfhi(w3), bflo(w4), bfhi(w4), bflo(w5), bfhi(w5), bflo(w6), bfhi(w6), bflo(w7), bfhi(w7)};
        unsigned wd[4];
#pragma unroll
        for (int q = 0; q < 4; ++q) { int pk = 0; pk = __builtin_amdgcn_cvt_pk_fp8_f32(v[4 * q] * S, v[4 * q + 1] * S, pk, false); pk = __builtin_amdgcn_cvt_pk_fp8_f32(v[4 * q + 2] * S, v[4 * q + 3] * S, pk, true); wd[q] = (unsigned)pk; }
        *(v4u*)(W8 + (size_t)r * 1024 + lane * 16) = (v4u){wd[0], wd[1], wd[2], wd[3]};
    }
}

__device__ __forceinline__ void ins16(float (&l)[16], float x) {
#pragma unroll
    for (int i = 15; i >= 1; --i) l[i] = __builtin_amdgcn_fmed3f(l[i - 1], l[i], x);
    l[0] = vmaxf(l[0], x);
}
#define DPP_F(v, ctrl) __builtin_bit_cast(float, __builtin_amdgcn_update_dpp(0, __builtin_bit_cast(int, (v)), (ctrl), 0xF, 0xF, true))
__device__ __forceinline__ void topk_ld16(float (&d)[16], const f32x4* q) { const f32x4 a = q[0], b = q[1], c = q[2], e = q[3];
    d[0] = a[0]; d[1] = a[1]; d[2] = a[2]; d[3] = a[3]; d[4] = b[0]; d[5] = b[1]; d[6] = b[2]; d[7] = b[3]; d[8] = c[0]; d[9] = c[1]; d[10] = c[2]; d[11] = c[3]; d[12] = e[0]; d[13] = e[1]; d[14] = e[2]; d[15] = e[3]; }
__device__ __forceinline__ void topk_phase(const Ptrs& p, LAS unsigned char* lds, int vcu, int G, int tid) {
    const float* TOPW = (const float*)(p.ws + WS_SC); const float* PART = (const float*)(p.ws + WS_PART);
    unsigned short* IDX = (unsigned short*)(p.ws + WS_IDX); unsigned short* GATE = (unsigned short*)(p.ws + WS_GATE);
    LAS unsigned* L = (LAS unsigned*)lds + tid * 32;
    const int NU = T / 64, tk = tid >> 3, hd = tid & 7;
    for (int unit = vcu; unit < NU; unit += G) {
        const size_t t = (size_t)unit * 64 + tk;
        float ss;
        { const f32x4* pp = (const f32x4*)(PART + t * 16); const f32x4 a = pp[0], b = pp[1], c = pp[2], d = pp[3];
          ss = ((a[0] + a[1]) + (a[2] + a[3])) + ((b[0] + b[1]) + (b[2] + b[3])) + ((c[0] + c[1]) + (c[2] + c[3])) + ((d[0] + d[1]) + (d[2] + d[3])); }
        const float rn = rsqrtf(ss * (1.f / D) + EPS);
        if (hd == 0) ((float*)(p.ws + WS_RN))[t] = rn;
        const f32x4* tp = (const f32x4*)(TOPW + ((t * 8 + hd) * 4) * 16);
        float la[16], lb[16], lo_[16];
        topk_ld16(la, tp); topk_ld16(lo_, tp + 4); MERGE16_REG(la, lo_);
        topk_ld16(lb, tp + 8); topk_ld16(lo_, tp + 12); MERGE16_REG(lb, lo_);
#pragma unroll
        for (int i = 0; i < 16; ++i) { L[i] = __float_as_uint(la[i]); L[16 + i] = __float_as_uint(lb[i]); }
        float fa[16], fb[16];
#pragma unroll
        for (int i = 0; i < 16; ++i) { fa[i] = __uint_as_float(__float_as_uint(la[i]) & ~0x7fu); fb[i] = __uint_as_float(__float_as_uint(lb[i]) & ~0x7fu); }
        float l[16];
#pragma unroll
        for (int j = 0; j < 16; ++j) l[j] = __uint_as_float((__float_as_uint(fa[0] + fb[j]) & ~0xffu) | (unsigned)(255 - j));
#pragma unroll
        for (int i = 1; i < 16; ++i)
#pragma unroll
            for (int j = 0; j < 16; ++j) if ((i + 1) * (j + 1) <= 16) ins16(l, __uint_as_float((__float_as_uint(fa[i] + fb[j]) & ~0xffu) | (unsigned)(255 - (i * 16 + j))));
        const float rt = rn * 1.4426950408889634f * ((const float*)(p.ws + WS_CSC))[2048];
        float sv[16], den = 0.f; const float s0 = __uint_as_float(__float_as_uint(l[0]) & ~0xffu);
#pragma unroll
        for (int k = 0; k < 16; ++k) { sv[k] = __builtin_amdgcn_exp2f((__uint_as_float(__float_as_uint(l[k]) & ~0xffu) - s0) * rt); den += sv[k]; }
        const float inv = 1.f / den;
        unsigned ids[16];
#pragma unroll
        for (int k = 0; k < 16; ++k) { const unsigned code = 255u - (__float_as_uint(l[k]) & 0xffu); ids[k] = (L[code >> 4] & 0x7fu) * 128u + (L[16 + (code & 15u)] & 0x7fu); sv[k] *= inv; }
        v4u* ip = (v4u*)(IDX + t * 128 + hd * 16);
        ip[0] = (v4u){ids[0] | (ids[1] << 16), ids[2] | (ids[3] << 16), ids[4] | (ids[5] << 16), ids[6] | (ids[7] << 16)};
        ip[1] = (v4u){ids[8] | (ids[9] << 16), ids[10] | (ids[11] << 16), ids[12] | (ids[13] << 16), ids[14] | (ids[15] << 16)};
        v4u* gp = (v4u*)(GATE + t * 128 + hd * 16);
        gp[0] = (v4u){pk2(sv[0], sv[1]), pk2(sv[2], sv[3]), pk2(sv[4], sv[5]), pk2(sv[6], sv[7])}; gp[1] = (v4u){pk2(sv[8], sv[9]), pk2(sv[10], sv[11]), pk2(sv[12], sv[13]), pk2(sv[14], sv[15])};
    }
}

__device__ __forceinline__ float dot2bf(unsigned u, unsigned x, float acc) { return __builtin_amdgcn_fdot2_f32_bf16(__builtin_bit_cast(bf16x2_t, u), __builtin_bit_cast(bf16x2_t, x), acc, false); }
#define DPP_ADD(v, ctrl) ((v) + __builtin_bit_cast(float, __builtin_amdgcn_update_dpp(0, __builtin_bit_cast(int, (v)), (ctrl), 0xF, 0xF, true)))
__device__ __forceinline__ float red8(float v) {
    float a = v; a = DPP_ADD(a, 0xB1); a = DPP_ADD(a, 0x4E); a = DPP_ADD(a, 0x141); return a;
}
constexpr int PB_ROW = 144, PB_WAVE = 128 * PB_ROW;
typedef int v8i __attribute__((ext_vector_type(8)));
struct TokI { v4u ia, ib; };
struct TokX { v4u xa, xb; };
__device__ __forceinline__ TokI peer_tokI(const unsigned short* IDX, int t, int lane) {
    TokI k; const unsigned short* ip = IDX + (size_t)t * 128 + (lane >> 3) * 16; k.ia = *(const v4u*)ip; k.ib = *(const v4u*)(ip + 8); return k;
}
__device__ __forceinline__ TokX peer_tokX(const unsigned char* XF8, int t, int s, int lane) {
    TokX k; const v4u z = {0u, 0u, 0u, 0u};
    if ((lane & 15) < 2) { const unsigned char* xp = XF8 + (size_t)t * 1024 + s * SLW + (lane & 15) * 128 + (lane >> 4) * 16; k.xa = *(const v4u*)xp; k.xb = *(const v4u*)(xp + 64); } else { k.xa = z; k.xb = z; }
    return k;
}
__device__ __forceinline__ void peer_gather(v4u (&u)[16], const v4u ia, const v4u ib, const unsigned char* base, unsigned coff) {
    const unsigned i0 = ia.x, i1 = ia.y, i2 = ia.z, i3 = ia.w, i4 = ib.x, i5 = ib.y, i6 = ib.z, i7 = ib.w;
#define PG_LD(j, w) u[2 * (j)] = *(const v4u*)(base + (((w) & 0xffffu) * 128u + coff)); u[2 * (j) + 1] = *(const v4u*)(base + (((w) >> 16) * 128u + coff))
    PG_LD(0, i0); PG_LD(1, i1); PG_LD(2, i2); PG_LD(3, i3); PG_LD(4, i4); PG_LD(5, i5); PG_LD(6, i6); PG_LD(7, i7);
#undef PG_LD
}
struct DotRes { float v0[16], v1[16]; };
__device__ __forceinline__ void peer_dot_store(const DotRes& r, unsigned short* dst, int lane) {
    if ((lane & 15) == 0) {
        v4u* o = (v4u*)(dst + (lane >> 4) * 32);
#pragma unroll
        for (int q = 0; q < 2; ++q) { o[q] = (v4u){pk2(r.v0[8 * q], r.v0[8 * q + 1]), pk2(r.v0[8 * q + 2], r.v0[8 * q + 3]), pk2(r.v0[8 * q + 4], r.v0[8 * q + 5]), pk2(r.v0[8 * q + 6], r.v0[8 * q + 7])};
            o[2 + q] = (v4u){pk2(r.v1[8 * q], r.v1[8 * q + 1]), pk2(r.v1[8 * q + 2], r.v1[8 * q + 3]), pk2(r.v1[8 * q + 4], r.v1[8 * q + 5]), pk2(r.v1[8 * q + 6], r.v1[8 * q + 7])}; } }
}
__device__ __forceinline__ void peer_tile_write(const v4u (&u)[16], LAS unsigned char* tb, int lane) {
    const int g = lane >> 3, c = lane & 7;
#pragma unroll
    for (int i = 0; i < 16; ++i) *(LAS v4u*)(tb + (8 * i + g) * PB_ROW + 16 * c) = u[i];
    asm volatile("s_waitcnt lgkmcnt(0)" ::: "memory");
}
__device__ __forceinline__ void peer_mfma(DotRes& r, const v4u xa, const v4u xb, LAS unsigned char* tb, int lane) {
    const v8i bop = {(int)xa.x, (int)xa.y, (int)xa.z, (int)xa.w, (int)xb.x, (int)xb.y, (int)xb.z, (int)xb.w};
    const LAS unsigned char* ra = tb + ((lane & 15) >> 1) * PB_ROW + (lane & 1) * 64 + (lane >> 4) * 16;
#pragma unroll
    for (int i = 0; i < 16; ++i) { const v4u w = *(const LAS v4u*)(ra + i * 8 * PB_ROW); const v8i aop = {(int)w.x, (int)w.y, (int)w.z, (int)w.w, 0, 0, 0, 0};
        const f32x4 z = {0.f, 0.f, 0.f, 0.f};
        const f32x4 a = __builtin_amdgcn_mfma_scale_f32_16x16x128_f8f6f4(aop, bop, z, 4  , 0  , 0, 0, 0, 0);
        const float a0 = a[0], a1 = a[1], a2 = a[2], a3 = a[3];
        r.v0[i] = a0 + DPP_F(a1, 0xB1); r.v1[i] = a2 + DPP_F(a3, 0xB1); }
    asm volatile("s_waitcnt lgkmcnt(0)" ::: "memory");
}
__device__ __forceinline__ void peer_dots(const Ptrs& p, LAS unsigned char* lds, int bx, int G, int wave, int lane) {
    const unsigned char* XF8 = p.ws + WS_XF8; const unsigned short* IDX = (const unsigned short*)(p.ws + WS_IDX);
    unsigned short* PACT = (unsigned short*)(p.ws + WS_PACT);
    const int s = (bx & 7) >> 1, wx = ((bx >> 3) * NWAVES + wave) * 2 + (bx & 1), NWX = (G >> 3) * NWAVES * 2;
    const int NT = (T - wx + NWX - 1) / NWX;
    const unsigned char* eus = p.ws + WS_EU + (size_t)s * NEXP * 128; const unsigned coff = (lane & 7) * 16; unsigned short* pact = PACT + (size_t)s * T * 128;
    LAS unsigned char* tb = lds + wave * PB_WAVE;
#define TOK(n) (wx + ((n) < NT ? (n) : NT - 1) * NWX)
    v4u u[16];
    DotRes pend;
    TokI iN = peer_tokI(IDX, TOK(0), lane);
    peer_gather(u, iN.ia, iN.ib, eus, coff);
    TokX xC = peer_tokX(XF8, TOK(0), s, lane);
    iN = peer_tokI(IDX, TOK(1), lane);
    for (int n = 0; n < NT; ++n) {
        peer_tile_write(u, tb, lane);
        peer_gather(u, iN.ia, iN.ib, eus, coff);
        const TokX xN = peer_tokX(XF8, TOK(n + 1), s, lane);
        iN = peer_tokI(IDX, TOK(n + 2), lane);
        if (n > 0) peer_dot_store(pend, pact + (size_t)TOK(n - 1) * 128, lane);
        peer_mfma(pend, xC.xa, xC.xb, tb, lane);
        xC = xN;
    }
    if (NT > 0) peer_dot_store(pend, pact + (size_t)TOK(NT - 1) * 128, lane);
#undef TOK
}
struct CoefIn { float pa[NSLICE], pb[NSLICE], g0, g1, rn; int e0, e1; };
struct CoefSc { float su0, su1, sv0, sv1; };
__device__ __forceinline__ CoefIn coef_load(const Ptrs& p, int t, int lane) {
    const unsigned short* PACT = (const unsigned short*)(p.ws + WS_PACT); const unsigned short* GATE = (const unsigned short*)(p.ws + WS_GATE); const unsigned short* IDX = (const unsigned short*)(p.ws + WS_IDX);
    CoefIn k;
#pragma unroll
    for (int s = 0; s < NSLICE; ++s) { k.pa[s] = __uint_as_float((unsigned)PACT[((size_t)s * T + t) * 128 + lane] << 16); k.pb[s] = __uint_as_float((unsigned)PACT[((size_t)s * T + t) * 128 + 64 + lane] << 16); }
    k.g0 = __uint_as_float((unsigned)GATE[(size_t)t * 128 + lane] << 16); k.g1 = __uint_as_float((unsigned)GATE[(size_t)t * 128 + 64 + lane] << 16); k.e0 = IDX[(size_t)t * 128 + lane]; k.e1 = IDX[(size_t)t * 128 + 64 + lane]; k.rn = ((const float*)(p.ws + WS_RN))[t]; return k;
}
__device__ __forceinline__ CoefSc coef_scales(const Ptrs& p, const CoefIn& k) {
    const float* SU = (const float*)(p.ws + WS_SU); const float* SV = (const float*)(p.ws + WS_SV);
    CoefSc c; c.su0 = SU[k.e0]; c.su1 = SU[k.e1]; c.sv0 = SV[k.e0]; c.sv1 = SV[k.e1]; return c;
}
__device__ __forceinline__ void coef_finish(const CoefIn& k, const CoefSc& c, float& c0, float& c1, float& m) {
    float a0 = 0.f, a1 = 0.f;
#pragma unroll
    for (int s = 0; s < NSLICE; ++s) { a0 += k.pa[s]; a1 += k.pb[s]; }
    const float rt = 0.125f * k.rn;
    const pg8::f32x2 gl = pg8::gelu_pk((pg8::f32x2){a0 * rt * c.su0, a1 * rt * c.su1});
    c0 = k.g0 * gl.x * c.sv0; c1 = k.g1 * gl.y * c.sv1; m = fmaxf(fabsf(c0), fabsf(c1));
}
__device__ __forceinline__ void coef_store(unsigned char* COEF8, float* CS, int t, int lane, float c0, float c1, float m) {
    const int ex = (int)((__float_as_uint(m) >> 23) & 0xffu);
    const float S = (ex > 0 && ex < 200) ? __uint_as_float((unsigned)(127 + 7 + 127 - ex) << 23) : 1.f, Si = (ex > 0 && ex < 200) ? __uint_as_float((unsigned)(ex - 7) << 23) : 1.f;
    const int pk = __builtin_amdgcn_cvt_pk_fp8_f32(c0 * S, c1 * S, 0, false);
    COEF8[(size_t)t * 128 + lane] = (unsigned char)(pk & 0xff); COEF8[(size_t)t * 128 + 64 + lane] = (unsigned char)((pk >> 8) & 0xff);
    if (lane == 0) CS[t] = Si;
}
__device__ __forceinline__ void peer_coef(const Ptrs& p, int gw, int NGW, int lane) {
    unsigned char* COEF8 = p.ws + WS_COEF; float* CS = (float*)(p.ws + WS_CS);
    const int NTW = (T - gw + NGW - 1) / NGW;
    if (NTW <= 0) return;
#define CTOK(n_) (gw + (((n_) < NTW) ? (n_) : (NTW - 1)) * NGW)
    CoefIn ka = coef_load(p, CTOK(0), lane), kb = coef_load(p, CTOK(1), lane);
    for (int n = 0; n < NTW; n += 2) {
        const CoefSc ca = coef_scales(p, ka), cb = coef_scales(p, kb);
        const CoefIn na = coef_load(p, CTOK(n + 2), lane), nb = coef_load(p, CTOK(n + 3), lane);
        float a0, a1, am, b0, b1, bm;
        coef_finish(ka, ca, a0, a1, am); coef_finish(kb, cb, b0, b1, bm);
#pragma unroll
        for (int o = 0; o < 1; ++o) { am = wave_max(am); bm = wave_max(bm); }
        coef_store(COEF8, CS, CTOK(n), lane, a0, a1, am);
        if (n + 1 < NTW) coef_store(COEF8, CS, CTOK(n + 1), lane, b0, b1, bm);
        ka = na; kb = nb;
    }
#undef CTOK
}
typedef int v2i __attribute__((ext_vector_type(2)));
struct TokB { v4u ia, ib, ca, cb; v2u xr; float cs; };
__device__ __forceinline__ TokB peer_tokB(const unsigned short* IDX, const unsigned char* COEF8, const float* CS, const bf16* xb, int t, int lane) {
    TokB k; const int g = lane >> 3; k.ia = *(const v4u*)(IDX + (size_t)t * 128 + 16 * g); k.ib = *(const v4u*)(IDX + (size_t)t * 128 + 16 * g + 8);
    const v4u z = {0u, 0u, 0u, 0u};
    if ((lane & 15) == 0) { const unsigned char* cp = COEF8 + (size_t)t * 128 + (lane >> 4) * 16; k.ca = *(const v4u*)cp; k.cb = *(const v4u*)(cp + 64); } else { k.ca = z; k.cb = z; }
    k.cs = CS[t]; k.xr = __builtin_nontemporal_load((const v2u*)(xb + (size_t)t * 1024 + 4 * lane)); return k;
}
__device__ __forceinline__ float pack_rows(float a, float b, float c, float d) {
    const v2u s1 = __builtin_amdgcn_permlane32_swap(__float_as_uint(a), __float_as_uint(c), false, false); const unsigned ac = s1.x;
    const v2u s2 = __builtin_amdgcn_permlane32_swap(__float_as_uint(b), __float_as_uint(d), false, false); const unsigned bd = s2.x;
    const v2u s3 = __builtin_amdgcn_permlane16_swap(ac, bd, false, false); const unsigned r = s3.x;
    return __uint_as_float(r);
}
__device__ __forceinline__ void peer_axpy_mfma(const v4u (&v)[16], const TokB& k, LAS unsigned char* tb, float* o, int lane) {
    const int g = lane >> 3, c = lane & 7, n = lane & 15, kg = lane >> 4;
#pragma unroll
    for (int i = 0; i < 16; ++i) *(LAS v4u*)(tb + (16 * g + i) * PB_ROW + 16 * c) = v[i];
    asm volatile("s_waitcnt lgkmcnt(0)" ::: "memory");
    const v8i aop = {(int)k.ca.x, (int)k.ca.y, (int)k.ca.z, (int)k.ca.w, (int)k.cb.x, (int)k.cb.y, (int)k.cb.z, (int)k.cb.w};
    const LAS unsigned char* ra = tb + (32 * kg + n) * PB_ROW;
    float pk[4];
#pragma unroll
    for (int q = 0; q < 4; ++q) {
        float val[4];
#pragma unroll
        for (int r = 0; r < 4; ++r) { const int nt = 4 * q + r;
            const v2i lo = __builtin_amdgcn_ds_read_tr4_b64_v2i32((LAS v2i*)(ra + nt * 8)), hi = __builtin_amdgcn_ds_read_tr4_b64_v2i32((LAS v2i*)(ra + 16 * PB_ROW + nt * 8));
            const v8i bop = {lo.x, lo.y, hi.x, hi.y, 0, 0, 0, 0};
            const f32x4 z = {0.f, 0.f, 0.f, 0.f};
            const f32x4 d = __builtin_amdgcn_mfma_scale_f32_16x16x128_f8f6f4(aop, bop, z, 0  , 4  , 0, 0, 0, 0);
            val[r] = d[0]; }
        pk[q] = pack_rows(val[0], val[1], val[2], val[3]);
    }
    asm volatile("s_waitcnt lgkmcnt(0)" ::: "memory");
    const unsigned r0 = k.xr.x, r1 = k.xr.y; const float cs = k.cs;
    __builtin_nontemporal_store((f32x4){bflo(r0) + pk[0] * cs, bfhi(r0) + pk[1] * cs, bflo(r1) + pk[2] * cs, bfhi(r1) + pk[3] * cs}, (f32x4*)(o + 4 * lane));
}
__device__ __forceinline__ void peer_axpy(const Ptrs& p, LAS unsigned char* lds, int bx, int G, int wave, int lane) {
    const unsigned short* IDX = (const unsigned short*)(p.ws + WS_IDX); const unsigned char* COEF8 = p.ws + WS_COEF; const float* CS = (const float*)(p.ws + WS_CS);
    const int s = (bx & 7) >> 1, wx = ((bx >> 3) * NWAVES + wave) * 2 + (bx & 1), NWX = (G >> 3) * NWAVES * 2, c = lane & 7;
    const int NT = (T - wx + NWX - 1) / NWX;
    const unsigned char* evs = p.ws + WS_EV + (size_t)s * NEXP * 128; const unsigned coff = c * 16; float* ob = p.out + s * SLW; const bf16* xb = (const bf16*)(p.ws + WS_X1B) + s * SLW;
    LAS unsigned char* tb = lds + wave * PB_WAVE;
#define TOK(n) (wx + ((n) < NT ? (n) : NT - 1) * NWX)
    v4u va[16], vb[16];
    TokB kA = peer_tokB(IDX, COEF8, CS, xb, TOK(0), lane);
    peer_gather(va, kA.ia, kA.ib, evs, coff);
    TokB kB = peer_tokB(IDX, COEF8, CS, xb, TOK(1), lane);
    for (int n = 0; n < NT; n += 2) {
        peer_gather(vb, kB.ia, kB.ib, evs, coff);
        TokB kC = peer_tokB(IDX, COEF8, CS, xb, TOK(n + 2), lane);
        peer_axpy_mfma(va, kA, tb, ob + (size_t)TOK(n) * 1024, lane);
        peer_gather(va, kC.ia, kC.ib, evs, coff);
        kA = peer_tokB(IDX, COEF8, CS, xb, TOK(n + 3), lane);
        if (n + 1 < NT) peer_axpy_mfma(vb, kB, tb, ob + (size_t)TOK(n + 1) * 1024, lane);
        kB = kA; kA = kC;
    }
#undef TOK
}

#define XB_TMO      128
#define XB_XCNT(j)  (256  + 64 * (j))
#define XB_XSUB(j)  (1280 + 64 * (j))
#define XB_XGEN(j)  (2304 + 64 * (j))
#define XB_TOP      3328
#define XB_TOPGEN   3392
#define XCD_BAR_WORDS 3456
#define XB_SPIN_CAP (1u << 18)

__device__ __forceinline__ unsigned xb_ld(unsigned* p)              { return __hip_atomic_load(p, __ATOMIC_RELAXED, __HIP_MEMORY_SCOPE_AGENT); }
__device__ __forceinline__ unsigned xb_add(unsigned* p, unsigned v) { return __hip_atomic_fetch_add(p, v, __ATOMIC_RELAXED, __HIP_MEMORY_SCOPE_AGENT); }
__device__ __forceinline__ unsigned xb_xcc_id() { return (unsigned)__builtin_amdgcn_s_getreg((3 << 11) | 20) & 0xFu; }
#define XB_SPIN(cond, bar) do { unsigned _sp = 0; while (cond) { __builtin_amdgcn_s_sleep(1); \
    if ((++_sp & 255u) == 0u) { if (xb_ld(&(bar)[XB_TMO])) break; if (_sp > XB_SPIN_CAP) { atomicAdd(&(bar)[XB_TMO], 1u); break; } } } } while (0)

struct XcdBarrier {
    unsigned* bar; unsigned x;
    volatile LAS unsigned* st;
};

__device__ __forceinline__ XcdBarrier xcd_barrier_post(unsigned* bar, volatile LAS unsigned* st) {
    XcdBarrier b; b.bar = bar; b.x = xb_xcc_id(); b.st = st;
    if (threadIdx.x == 0) (void)xb_add(&bar[XB_XCNT(b.x)], 1u);
    return b;
}
__device__ __forceinline__ void xcd_barrier_complete(unsigned* bar, unsigned x, unsigned& nloc, unsigned& nx) {
    const unsigned G = gridDim.x * gridDim.y * gridDim.z;
    unsigned sum, cnt, mine, sp = 0u;
    for (;;) {
        sum = 0u; cnt = 0u; mine = 0u;
#pragma unroll
        for (unsigned j = 0; j < 16; ++j) { const unsigned c = xb_ld(&bar[XB_XCNT(j)]); sum += c; cnt += (c > 0u) ? 1u : 0u; mine = (j == x) ? c : mine; }
        if (sum == G) break;
        __builtin_amdgcn_s_sleep(1);
        if ((++sp & 255u) == 0u) { if (xb_ld(&bar[XB_TMO])) break; if (sp > XB_SPIN_CAP) { atomicAdd(&bar[XB_TMO], 1u); break; } }
    }
    nloc = mine > 0u ? mine : 1u; nx = cnt > 0u ? cnt : 1u;
}

__device__ __forceinline__ void xcd_barrier(const XcdBarrier& b) {
    asm volatile("s_waitcnt vmcnt(0)" ::: "memory");
    __syncthreads();
    if (threadIdx.x == 0) {
        unsigned* bar = b.bar;
        __builtin_amdgcn_s_waitcnt(0);
        unsigned nloc = b.st[0], nx = b.st[1];
        if (nloc == 0u) { xcd_barrier_complete(bar, b.x, nloc, nx); b.st[0] = nloc; b.st[1] = nx; }
        const unsigned old = xb_add(&bar[XB_XSUB(b.x)], 1u);
        const unsigned gen = old / nloc;
        if (old + 1u == (gen + 1u) * nloc) {
            __builtin_amdgcn_fence(__ATOMIC_RELEASE, "agent");
            asm volatile("s_waitcnt vmcnt(0)" ::: "memory");
            const unsigned og = xb_add(&bar[XB_TOP], 1u);
            const unsigned tg = og / nx;
            if (og + 1u == (tg + 1u) * nx) xb_add(&bar[XB_TOPGEN], 1u);
            else XB_SPIN(xb_ld(&bar[XB_TOPGEN]) == tg, bar);
            __builtin_amdgcn_fence(__ATOMIC_ACQUIRE, "agent");
            xb_add(&bar[XB_XGEN(b.x)], 1u);
            asm volatile("s_waitcnt vmcnt(0)" ::: "memory");
        } else {
            XB_SPIN(xb_ld(&bar[XB_XGEN(b.x)]) == gen, bar);
            __builtin_amdgcn_fence(__ATOMIC_ACQUIRE, "agent");
            asm volatile("s_waitcnt vmcnt(0)" ::: "memory");
        }
    }
    __syncthreads();
}

constexpr int N_PHASES = 8;
#ifndef PROBE
#define PROBE 0
#endif
__global__ void __launch_bounds__(NTHR, 2) hymba_fwd(Args args) {
    extern __shared__ __attribute__((aligned(16))) unsigned char lds_raw[];
    LAS unsigned char* lds = (LAS unsigned char*)lds_raw;
    const Ptrs& p = args.p;
    const int tid = threadIdx.x, lane = tid & 63, wave = __builtin_amdgcn_readfirstlane(tid >> 6);
    const int G = gridDim.x, bx = blockIdx.x, vcu = (G % 8 == 0) ? (bx % 8) * (G / 8) + bx / 8 : bx;
    const int gw = vcu * NWAVES + wave, NGW = G * NWAVES;
    const int lo = args.ph_lo, hi = args.ph_hi;
    volatile LAS unsigned* MISC = (volatile LAS unsigned*)(lds + MISC_OFF);
    if (tid < 64) MISC[tid] = 0u;
    __syncthreads();
    XcdBarrier bar = xcd_barrier_post((unsigned*)(p.ws + WS_CTL) + CW_BAR, MISC + 8);
#define IN(k) (lo <= (k) && (k) < hi)
#define SEAM(k) do { if (IN(k) && IN((k) + 1)) xcd_barrier(bar); } while (0)
    if (IN(0)) p0_prologue(p, lds, tid, lane, wave, vcu, G);
    SEAM(0);
    if (IN(1)) {
        pg8::Gemm g{(const bf16*)(p.ws + WS_HN), (const bf16*)(p.ws + WS_WIN), T, INW, D}; pg8::StaticOrder S; S.init(T, INW, G, bx);
        EpiProj E{(bf16*)(p.ws + WS_Q), (bf16*)(p.ws + WS_K), (bf16*)(p.ws + WS_V), (bf16*)(p.ws + WS_GU), (bf16*)(p.ws + WS_GV), p.q_g, p.k_g};
        pg8::gemm_phase<EpiProj, pg8::StaticOrder, true, true>(lds, g, S, E);
    }
    SEAM(1);
    if (IN(2)) attn_phase(p, lds, vcu, G, lane, wave);
    SEAM(2);
    if (IN(3)) {
        if (bx & 1) combine_phase(p, gw, NGW, lane);
        for (int u = vcu; u < T / 128; u += G) gmlp_unit(p, lds, u, tid, lane, wave);
        if (!(bx & 1)) combine_phase(p, gw, NGW, lane);
        wqk_rowmax(p, gw, NGW, lane);
    }
    SEAM(3);
    if (IN(4)) {
        wqk_to_fp8(p, gw, NGW, lane);
        pg8::Gemm g{(const bf16*)(p.ws + WS_HN), (const bf16*)(p.ws + WS_WOUT), T, D, D}; pg8::StaticOrder S; S.init(T, D, G, bx);
        EpiOut E{p.x, p.out, (bf16*)(p.ws + WS_X1B), (float*)(p.ws + WS_PART), p.ws + WS_XF8};
        pg8::gemm_phase<EpiOut, pg8::StaticOrder, true, true>(lds, g, S, E);
    }
    SEAM(4);
    if (IN(5)) {
        pg8::Gemm g{(const bf16*)(p.ws + WS_XF8), (const bf16*)(p.ws + WS_WQK8), T, 2048, D / 2}; pg8::StaticOrder S; S.init(T, 2048, G, bx);
        EpiTopk E{(float*)(p.ws + WS_SC)};
        pg8::gemm_phase<EpiTopk, pg8::StaticOrder, true, true, true>(lds, g, S, E);
    }
    SEAM(5);
    if (IN(6)) topk_phase(p, lds, vcu, G, tid);
    SEAM(6);
    if (IN(7)) {
        __syncthreads();
        peer_dots(p, lds, bx, G, wave, lane);
        if (args.probe == 1) peer_dots(p, lds, bx, G, wave, lane);
        xcd_barrier(bar);
        peer_coef(p, gw, NGW, lane);
        if (args.probe == 2) peer_coef(p, gw, NGW, lane);
        xcd_barrier(bar);
        if (args.probe == 3) { xcd_barrier(bar); xcd_barrier(bar); xcd_barrier(bar); xcd_barrier(bar); xcd_barrier(bar); xcd_barrier(bar); xcd_barrier(bar); xcd_barrier(bar); xcd_barrier(bar); xcd_barrier(bar); }
        __syncthreads();
        peer_axpy(p, lds, bx, G, wave, lane);
        if (args.probe == 5) peer_axpy(p, lds, bx, G, wave, lane);
    }
#undef IN
#undef SEAM
}

extern "C" void kernel_launch(void* const* d_in, const int* in_sizes, int n_in, void* d_out, int out_size, void* d_ws, size_t ws_size, hipStream_t stream) {
    static int grid = 0;
    if (grid == 0) {
        if (n_in != 17 || in_sizes[0] != T * D || out_size != T * D || ws_size < WS_END) { fprintf(stderr, "kernel_launch: unexpected shapes (n_in %d, in0 %d, out %d, ws %zu); nothing launched\n", n_in, n_in > 0 ? in_sizes[0] : -1, out_size, ws_size); grid = -1; return; }
        int dev = 0, cus = 0, per_cu = 0;
        if (hipGetDevice(&dev) != hipSuccess || hipDeviceGetAttribute(&cus, hipDeviceAttributeMultiprocessorCount, dev) != hipSuccess) { grid = -1; return; }
        if (hipFuncSetAttribute((const void*)hymba_fwd, hipFuncAttributeMaxDynamicSharedMemorySize, LDS_BYTES) != hipSuccess) { fprintf(stderr, "kernel_launch: hipFuncSetAttribute failed\n"); grid = -1; return; }
        if (hipOccupancyMaxActiveBlocksPerMultiprocessor(&per_cu, (const void*)hymba_fwd, NTHR, LDS_BYTES) != hipSuccess || per_cu < 1) fprintf(stderr, "kernel_launch: occupancy query reports %d\n", per_cu);
        (void)hipGetLastError();
        grid = cus;
    }
    if (grid < 0) return;
    Args a{};
    const float** pp = (const float**)&a.p;
    for (int i = 0; i < 17; ++i) pp[i] = (const float*)d_in[i];
    a.p.out = (float*)d_out; a.p.ws = (unsigned char*)d_ws;
    if (hipMemsetAsync((char*)d_ws + WS_CTL, 0, CTL_ZERO_BYTES, stream) != hipSuccess) { fprintf(stderr, "kernel_launch: hipMemsetAsync failed\n"); return; }
    a.ph_lo = 0; a.ph_hi = N_PHASES; a.probe = PROBE;
    hipLaunchKernelGGL(hymba_fwd, dim3(grid), dim3(NTHR), LDS_BYTES, stream, a);
}
```
